# Optimizing an MI355X kernel written in HIP

```python
import math
import jax, jax.numpy as jnp
from jax import lax
import numpy as np

D_MODEL = 1024
BATCH = 1
SEQ = 16384
DEPTH = 1
DEC_BATCH = 128
DEC_SEQ = 4
PAST_LEN = 8192
PAGE_SIZE = 128

ATT_HEADS = 12
HEAD_DIM = 64
ATT_W = ATT_HEADS * HEAD_DIM
DILATED_BRANCHES = ((128, 1), (512, 4), (2048, 16))
WIN_MAX = 2048
QBLK = 128
N_BUCKETS = 32
MAX_EXACT = N_BUCKETS // 2
MAX_DIST = WIN_MAX
SSD_HEADS = 20
SSD_HEAD_DIM = 64
SSD_W = SSD_HEADS * SSD_HEAD_DIM
N_GROUPS = 4
D_STATE = 128
CONV_W = 4
CONV_DIM = SSD_W + 2 * N_GROUPS * D_STATE
SSD_CHUNK = 128
MIX_W = ATT_W + SSD_W
SPLITS = (ATT_W, 2 * ATT_W, 3 * ATT_W, 3 * ATT_W + SSD_W, 3 * ATT_W + SSD_W + CONV_DIM)
D_IN_PROJ = 3 * ATT_W + SSD_W + CONV_DIM + SSD_HEADS
D_FF = ((8 * D_MODEL // 3 + 255) // 256) * 256
EPS = 1e-6

kernel_name = 'dilated_ssd_hybrid_step'


def rmsnorm(x, g):
    xf = x.astype(jnp.float32)
    y = xf * lax.rsqrt(jnp.mean(xf * xf, axis=-1, keepdims=True) + EPS)
    return (y * g.astype(jnp.float32)).astype(x.dtype)


def rel_bucket(dist):
    n = jnp.maximum(dist, 0)
    nf = jnp.maximum(n, 1).astype(jnp.float32)
    large = MAX_EXACT + (jnp.log(nf / MAX_EXACT) / math.log(MAX_DIST / MAX_EXACT)
                         * (N_BUCKETS - MAX_EXACT)).astype(jnp.int32)
    return jnp.where(n < MAX_EXACT, n, jnp.minimum(large, N_BUCKETS - 1))


def merge_branches(parts):
    mx = jnp.stack([p[0] for p in parts])
    den = jnp.stack([p[1] for p in parts])
    num = jnp.stack([p[2] for p in parts])
    wts = jnp.exp(mx - jnp.max(mx, axis=0))
    return jnp.sum(wts[..., None] * num, axis=0) / jnp.sum(wts * den, axis=0)[..., None]


def dilated_branch_prompt(q, k, v, rel_bias, window, dilation):
    b, s, h, hd = q.shape
    w_sub = window // dilation
    m = s // dilation
    nb = -(-m // QBLK)
    m_pad = nb * QBLK

    def to_sub(t):
        t = t.reshape(b, m, dilation, h, hd).transpose(0, 2, 1, 3, 4)
        return jnp.pad(t, ((0, 0), (0, 0), (0, m_pad - m), (0, 0), (0, 0)))

    def band(t):
        tp = jnp.pad(t, ((0, 0), (0, 0), (QBLK, 0), (0, 0), (0, 0)))
        prev = tp[:, :, :m_pad].reshape(b, dilation, nb, QBLK, h, hd)
        cur = t.reshape(b, dilation, nb, QBLK, h, hd)
        return jnp.concatenate([prev, cur], axis=3)

    qb = to_sub(q).reshape(b, dilation, nb, QBLK, h, hd)
    kb = band(to_sub(k))
    vb = band(to_sub(v))
    scores = jnp.einsum('brnqhd,brnkhd->brnhqk', qb, kb,
                        preferred_element_type=jnp.float32) * (hd ** -0.5)
    qi = jnp.arange(QBLK)[:, None] + QBLK
    kk = jnp.arange(2 * QBLK)[None, :]
    dist = qi - kk
    bias = rel_bias[rel_bucket(dist * dilation)].transpose(2, 0, 1).astype(jnp.float32)
    key_idx = (jnp.arange(nb) * QBLK - QBLK)[:, None] + kk
    valid = ((dist >= 0) & (dist <= w_sub))[None] & (key_idx[:, None, :] >= 0)
    scores = jnp.where(valid[None, None, :, None], scores + bias, -jnp.inf)
    mx = jnp.max(scores, axis=-1)
    p = jnp.exp(scores - mx[..., None])
    den = jnp.sum(p, axis=-1)
    num = jnp.einsum('brnhqk,brnkhd->brnqhd', p.astype(v.dtype), vb,
                     preferred_element_type=jnp.float32)

    def from_sub(t):
        t = t.reshape(b, dilation, m_pad, *t.shape[4:])[:, :, :m]
        t = jnp.moveaxis(t, 1, 2)
        return t.reshape(b, s, *t.shape[3:])

    return (from_sub(jnp.moveaxis(mx, 3, 4)), from_sub(jnp.moveaxis(den, 3, 4)), from_sub(num))


def dilated_attention_prompt(q, k, v, rel_bias):
    return merge_branches([dilated_branch_prompt(q, k, v, rel_bias, w, d) for (w, d) in DILATED_BRANCHES])


def dilated_branch_sample(q, kcat, vcat, rel_bias, window, dilation):
    t = q.shape[1]
    wb = kcat.shape[1] - t
    n_keys = window // dilation + 1
    steps = jnp.arange(n_keys) * dilation
    idx = wb + jnp.arange(t)[:, None] - steps[None, :]
    valid = idx >= 0
    idx_c = jnp.maximum(idx, 0)
    kg = kcat[:, idx_c]
    vg = vcat[:, idx_c]
    scores = jnp.einsum('bthd,btkhd->bhtk', q, kg,
                        preferred_element_type=jnp.float32) * (q.shape[-1] ** -0.5)
    bias = rel_bias[rel_bucket(steps)].T.astype(jnp.float32)
    scores = jnp.where(valid[None, None], scores + bias[None, :, None, :], -jnp.inf)
    mx = jnp.max(scores, axis=-1)
    p = jnp.exp(scores - mx[..., None])
    den = jnp.sum(p, axis=-1)
    num = jnp.einsum('bhtk,btkhd->bthd', p.astype(vg.dtype), vg,
                     preferred_element_type=jnp.float32)
    return (mx.transpose(0, 2, 1), den.transpose(0, 2, 1), num)


def dilated_attention_sample(q, k, v, cache_k, cache_v, rel_bias):
    kcat = jnp.concatenate([cache_k.astype(k.dtype), k], axis=1)
    vcat = jnp.concatenate([cache_v.astype(v.dtype), v], axis=1)
    return merge_branches([dilated_branch_sample(q, kcat, vcat, rel_bias, w, d) for (w, d) in DILATED_BRANCHES])


def causal_conv(xbc, conv_state, conv_w, conv_b):
    L = xbc.shape[1]
    xp = jnp.concatenate([conv_state.astype(xbc.dtype), xbc], axis=1)
    y = sum(xp[:, j:j + L] * conv_w[j] for j in range(CONV_W)) + conv_b
    return jax.nn.silu(y), xp[:, -(CONV_W - 1):]


def ssd_scan(x, dt, a, bm, cm, h0):
    b, L, H, P = x.shape
    G, N = bm.shape[2], bm.shape[3]
    hpg = H // G
    cl = math.gcd(L, SSD_CHUNK)
    nc = L // cl
    xf = x.astype(jnp.float32).reshape(b, nc, cl, G, hpg, P)
    dtc = dt.reshape(b, nc, cl, G, hpg)
    bc = bm.astype(jnp.float32).reshape(b, nc, cl, G, N)
    cc = cm.astype(jnp.float32).reshape(b, nc, cl, G, N)
    acs = jnp.cumsum(dtc * a.reshape(G, hpg), axis=2)
    causal = jnp.tril(jnp.ones((cl, cl), dtype=bool))
    seg = acs[:, :, :, None] - acs[:, :, None, :]
    decay = jnp.exp(jnp.where(causal[None, None, :, :, None, None], seg, -jnp.inf))
    cb = jnp.einsum('bclgn,bcsgn->bclsg', cc, bc)
    w_ls = cb[..., None] * decay * dtc[:, :, None]
    y_diag = jnp.einsum('bclsgh,bcsghp->bclghp', w_ls, xf)
    decay_end = jnp.exp(acs[:, :, -1:] - acs) * dtc
    chunk_states = jnp.einsum('bclgn,bclghp->bcghpn', bc, decay_end[..., None] * xf)
    chunk_decay = jnp.exp(acs[:, :, -1])

    def step(h, inp):
        st, dec = inp
        return h * dec[..., None, None] + st, h

    h0g = h0.astype(jnp.float32).reshape(b, G, hpg, P, N)
    h_last, h_in = lax.scan(step, h0g, (jnp.moveaxis(chunk_states, 1, 0), jnp.moveaxis(chunk_decay, 1, 0)))
    h_in = jnp.moveaxis(h_in, 0, 1)
    y_off = jnp.einsum('bclgn,bcghpn->bclghp', cc, h_in) * jnp.exp(acs)[..., None]
    return (y_diag + y_off).reshape(b, L, H, P), h_last.reshape(b, H, P, N)


def ssd_mixer(z, xbc, dt_raw, conv_state, ssm_state, conv_w, conv_b, dt_bias, a_log, d_skip, g_ssd_out):
    b, L, _ = z.shape
    xbc, new_conv = causal_conv(xbc, conv_state, conv_w, conv_b)
    xs, bm, cm = jnp.split(xbc, (SSD_W, SSD_W + N_GROUPS * D_STATE), axis=-1)
    xs = xs.reshape(b, L, SSD_HEADS, SSD_HEAD_DIM)
    bm = bm.reshape(b, L, N_GROUPS, D_STATE)
    cm = cm.reshape(b, L, N_GROUPS, D_STATE)
    dt = jax.nn.softplus(dt_raw.astype(jnp.float32) + dt_bias.astype(jnp.float32))
    a = -jnp.exp(a_log.astype(jnp.float32))
    y, h_new = ssd_scan(xs, dt, a, bm, cm, ssm_state)
    y = y + d_skip.astype(jnp.float32)[:, None] * xs.astype(jnp.float32)
    y = y.reshape(b, L, SSD_W) * jax.nn.silu(z.astype(jnp.float32))
    yg = y.reshape(b, L, N_GROUPS, SSD_W // N_GROUPS)
    yg = yg * lax.rsqrt(jnp.mean(yg * yg, axis=-1, keepdims=True) + EPS)
    y = yg.reshape(b, L, SSD_W) * g_ssd_out.astype(jnp.float32)
    return y.astype(z.dtype), new_conv, h_new.astype(ssm_state.dtype)


def hybrid_layer(x, attend, conv_state, ssm_state, g_mix, w_in, conv_w, conv_b, dt_bias, a_log, d_skip,
                 g_attn_out, g_ssd_out, w_out, g_ffn, w_gate, w_up, w_down):
    b, L, _ = x.shape
    h = rmsnorm(x, g_mix)
    q, k, v, z, xbc, dt_raw = jnp.split(h @ w_in, SPLITS, axis=-1)
    q = q.reshape(b, L, ATT_HEADS, HEAD_DIM)
    k = k.reshape(b, L, ATT_HEADS, HEAD_DIM)
    v = v.reshape(b, L, ATT_HEADS, HEAD_DIM)
    att = rmsnorm(attend(q, k, v).reshape(b, L, ATT_W).astype(x.dtype), g_attn_out)
    ssd, new_conv, new_ssm = ssd_mixer(z, xbc, dt_raw, conv_state, ssm_state, conv_w, conv_b,
                                       dt_bias, a_log, d_skip, g_ssd_out)
    x = x + jnp.concatenate([att, ssd], axis=-1) @ w_out
    h2 = rmsnorm(x, g_ffn)
    x = x + (jax.nn.silu(h2 @ w_gate) * (h2 @ w_up)) @ w_down
    return x, k, v, new_conv, new_ssm


def setup_inputs(seed: int = 0) -> dict:
    key = jax.random.key(seed)
    ks = jax.random.split(key, 22)
    f32 = jnp.float32

    def nrm(k, shape, scale):
        return jax.random.normal(k, shape, f32) * scale

    def gain(k, shape):
        return 1.0 + 0.05 * jax.random.normal(k, shape, f32)

    wb = min(WIN_MAX, PAST_LEN)
    dt0 = jnp.exp(jax.random.uniform(ks[11], (DEPTH, SSD_HEADS), f32)
                  * (math.log(0.1) - math.log(0.001)) + math.log(0.001))
    return {
        'x_prompt': nrm(ks[0], (BATCH, SEQ, D_MODEL), 1.0),
        'x_sample': nrm(ks[1], (DEC_BATCH, DEC_SEQ, D_MODEL), 1.0),
        'cache_k': nrm(ks[2], (DEPTH, DEC_BATCH, wb, ATT_HEADS, HEAD_DIM), 1.0),
        'cache_v': nrm(ks[3], (DEPTH, DEC_BATCH, wb, ATT_HEADS, HEAD_DIM), 1.0),
        'state_conv': nrm(ks[4], (DEPTH, DEC_BATCH, CONV_W - 1, CONV_DIM), 1.0),
        'state_ssm': nrm(ks[5], (DEPTH, DEC_BATCH, SSD_HEADS, SSD_HEAD_DIM, D_STATE), 0.3),
        'rel_bias': nrm(ks[6], (N_BUCKETS, ATT_HEADS), 0.5),
        'g_mix': gain(ks[7], (DEPTH, D_MODEL)),
        'w_in': nrm(ks[8], (DEPTH, D_MODEL, D_IN_PROJ), D_MODEL ** -0.5),
        'conv_w': nrm(ks[9], (DEPTH, CONV_W, CONV_DIM), 0.5 * CONV_W ** -0.5),
        'conv_b': nrm(ks[10], (DEPTH, CONV_DIM), 0.01),
        'dt_bias': dt0 + jnp.log(-jnp.expm1(-dt0)),
        'a_log': jnp.log(jax.random.uniform(ks[12], (DEPTH, SSD_HEADS), f32, minval=1.0, maxval=16.0)),
        'd_skip': 1.0 + 0.1 * jax.random.normal(ks[13], (DEPTH, SSD_HEADS), f32),
        'g_attn_out': gain(ks[14], (DEPTH, ATT_W)),
        'g_ssd_out': gain(ks[15], (DEPTH, SSD_W)),
        'w_out': nrm(ks[16], (DEPTH, MIX_W, D_MODEL), MIX_W ** -0.5),
        'g_ffn': gain(ks[17], (DEPTH, D_MODEL)),
        'w_gate': nrm(ks[18], (DEPTH, D_MODEL, D_FF), D_MODEL ** -0.5),
        'w_up': nrm(ks[19], (DEPTH, D_MODEL, D_FF), D_MODEL ** -0.5),
        'w_down': nrm(ks[20], (DEPTH, D_FF, D_MODEL), D_FF ** -0.5),
        'g_final': gain(ks[21], (D_MODEL,)),
    }


def reference(x_prompt, x_sample, cache_k, cache_v, state_conv, state_ssm, rel_bias, g_mix, w_in,
              conv_w, conv_b, dt_bias, a_log, d_skip, g_attn_out, g_ssd_out, w_out, g_ffn,
              w_gate, w_up, w_down, g_final):
    xp, xs = x_prompt, x_sample
    kp_l, vp_l, cp_l, sp_l, ks_l, vs_l, cs_l, ss_l = [], [], [], [], [], [], [], []
    for l in range(DEPTH):
        lp = (g_mix[l], w_in[l], conv_w[l], conv_b[l], dt_bias[l], a_log[l], d_skip[l],
              g_attn_out[l], g_ssd_out[l], w_out[l], g_ffn[l], w_gate[l], w_up[l], w_down[l])
        conv0 = jnp.zeros((xp.shape[0], CONV_W - 1, CONV_DIM), xp.dtype)
        ssm0 = jnp.zeros((xp.shape[0], SSD_HEADS, SSD_HEAD_DIM, D_STATE), state_ssm.dtype)
        xp, kp, vp, cp, sp = hybrid_layer(
            xp, lambda q, k, v: dilated_attention_prompt(q, k, v, rel_bias), conv0, ssm0, *lp)
        ck, cv = cache_k[l], cache_v[l]
        xs, kn, vn, cs, ss = hybrid_layer(
            xs, lambda q, k, v, ck=ck, cv=cv: dilated_attention_sample(q, k, v, ck, cv, rel_bias),
            state_conv[l], state_ssm[l], *lp)
        wbp = min(WIN_MAX, kp.shape[1])
        kp_l.append(kp[:, -wbp:])
        vp_l.append(vp[:, -wbp:])
        cp_l.append(cp)
        sp_l.append(sp)
        ks_l.append(kn)
        vs_l.append(vn)
        cs_l.append(cs)
        ss_l.append(ss)
    y_prompt = rmsnorm(xp, g_final)
    y_sample = rmsnorm(xs, g_final)
    win_k_prompt = jnp.stack(kp_l)
    win_v_prompt = jnp.stack(vp_l)
    conv_prompt = jnp.stack(cp_l)
    ssm_prompt = jnp.stack(sp_l)
    win_k_sample = jnp.stack(ks_l)
    win_v_sample = jnp.stack(vs_l)
    conv_sample = jnp.stack(cs_l)
    ssm_sample = jnp.stack(ss_l)
    return (y_prompt, y_sample, win_k_prompt, win_v_prompt, conv_prompt, ssm_prompt,
            win_k_sample, win_v_sample, conv_sample, ssm_sample)
```

```cpp
#include <hip/hip_runtime.h>
#include <cstdio>
#include <cstdint>
namespace pg8 {
#define PG8_LAS __attribute__((address_space(3)))
typedef unsigned short bf16_t;
typedef short bf16x8 __attribute__((ext_vector_type(8)));
typedef float f32x4 __attribute__((ext_vector_type(4)));
typedef unsigned u32x4 __attribute__((ext_vector_type(4)));
constexpr int BM = 256, BK = 64, HALF = 128, HTB = HALF * BK * 2  , STAGE_BYTES = 8 * HTB, NXCD = 8, WGM = 8;

__host__ __device__ __forceinline__ int lds_byte(int r, int c) { const int st = (r >> 4) * 2 + (c >> 5), rr = r & 15, cc = c & 31, ob = rr * 64 + cc * 2; return st * 1024 + (ob ^ (((ob >> 9) & 1) << 5)); }
__host__ __device__ __forceinline__ void stage_rc(int b, int& R, int& C) { const int st = b / 1024, sb = b % 1024, swz = sb ^ (((sb >> 9) & 1) << 5); R = (st >> 1) * 16 + swz / 64; C = (st & 1) * 32 + (swz % 64) / 2; }
__host__ __device__ __forceinline__ int perm32(int rho) { const int n = rho >> 4, i = rho & 15; return 8 * (i >> 2) + 4 * n + (i & 3); }

struct Unit { int pm, pn; };
struct Gemm { const bf16_t* A; const bf16_t* Bt; int M, N, K; };

struct StaticOrder {
    int nM, nN, nwg, G, c;
    __host__ __device__ void init(int M, int N, int G_, int c_) { nM = M / BM; nN = N / BM; nwg = nM * nN; G = G_; c = c_; }
    __host__ __device__ bool next(int i, Unit& u) const {
        const long L = (long)i * G + c; if (L >= nwg) return false;
        int wgid = (int)L; { const int q = nwg / NXCD, r = nwg % NXCD, xcd = wgid % NXCD, off = wgid / NXCD; wgid = (xcd < r ? xcd * (q + 1) : r * (q + 1) + (xcd - r) * q) + off; }
        const int nig = WGM * nN, gid = wgid / nig, fm = gid * WGM, gsz = (nM - fm) < WGM ? (nM - fm) : WGM;
        u.pm = fm + ((wgid % nig) % gsz); u.pn = (wgid % nig) / gsz; return true;
    }
    __device__ __forceinline__ void a_ready(const Unit&) const {}
    __device__ __forceinline__ void done(const Unit&) const {}
};

__device__ __forceinline__ unsigned cvt_pk_bf16(float lo, float hi) { unsigned r; asm volatile("v_cvt_pk_bf16_f32 %0, %1, %2" : "=v"(r) : "v"(lo), "v"(hi)); return r; }
typedef float f32x2 __attribute__((ext_vector_type(2)));

template <class Epi, class Sched, bool ALIGN_EPI = false, bool SP2 = false>
__device__ __forceinline__ void gemm_phase(PG8_LAS unsigned char* lds, const Gemm g, const Sched& S, const Epi& E) {
    const int tid = threadIdx.x, wid = __builtin_amdgcn_readfirstlane(tid >> 6), lane = tid & 63, wr = wid >> 2, wc = wid & 3, fr = lane & 15, fq = lane >> 4;
    const int K = g.K, nt = K / BK;
    unsigned voffA[2], voffB[2];
#pragma unroll
    for (int i = 0; i < 2; ++i) { int R, C; stage_rc(tid * 16 + i * 8192, R, C); const int Rb = Epi::PERM ? ((R & ~31) + perm32(R & 31)) : R;
        voffA[i] = (unsigned)(R * K + C) * 2u; voffB[i] = (unsigned)(Rb * K + C) * 2u; }
    const size_t kstep = (size_t)(BK * 2);
    const size_t hstep = (size_t)HALF * K * 2;
    const size_t tstep = 2 * hstep;
    const unsigned ldsw = (unsigned)wid * 1024u;
    const int aoff = lds_byte(wr * 64 + fr, fq * 8), boff = lds_byte(wc * 32 + fr, fq * 8);
#define PG8_SA(b, h) (((b) * 2 + (h)) * HTB)
#define PG8_SB(b, h) ((4 + (b) * 2 + (h)) * HTB)
#define PG8_STAGE(bufoff, gbase, voff) do { _Pragma("unroll") for (int _i = 0; _i < 2; ++_i) \
        __builtin_amdgcn_global_load_lds((const unsigned*)((const char*)(gbase) + (voff)[_i]), (PG8_LAS unsigned*)(lds + (bufoff) + ldsw + _i * 8192), 16, 0, 0); } while (0)
#define PG8_LDA(dst, b, h) do { _Pragma("unroll") for (int m = 0; m < 4; ++m) _Pragma("unroll") for (int k = 0; k < 2; ++k) dst[m][k] = *(const PG8_LAS bf16x8*)(lds + PG8_SA(b, h) + aoff + m * 2048 + k * 1024); } while (0)
#define PG8_LDB(dst, b, h) do { _Pragma("unroll") for (int n = 0; n < 2; ++n) _Pragma("unroll") for (int k = 0; k < 2; ++k) dst[n][k] = *(const PG8_LAS bf16x8*)(lds + PG8_SB(b, h) + boff + n * 2048 + k * 1024); } while (0)
#define PG8_MMA(ai, bj, At, Bt) do { __builtin_amdgcn_s_setprio(1); _Pragma("unroll") for (int m = 0; m < 4; ++m) _Pragma("unroll") for (int n = 0; n < 2; ++n) _Pragma("unroll") for (int k = 0; k < 2; ++k) \
        acc[ai][bj][m][n] = __builtin_amdgcn_mfma_f32_16x16x32_bf16(Bt[n][k], At[m][k], acc[ai][bj][m][n], 0, 0, 0); __builtin_amdgcn_s_setprio(0); } while (0)
#define PG8_WAIT_V(n) asm volatile("s_waitcnt vmcnt(" #n ")" ::: "memory")
#define PG8_WAIT_L(n) asm volatile("s_waitcnt lgkmcnt(" #n ")" ::: "memory")
#define PG8_BAR __builtin_amdgcn_s_barrier()
#define PG8_SCHED __builtin_amdgcn_sched_barrier(0)
    Unit cur, nxt; int ui = 0;
    if (!S.next(0, cur)) return;
    f32x4 acc[2][2][4][2];
#pragma unroll
    for (int a = 0; a < 2; ++a)
#pragma unroll
        for (int b = 0; b < 2; ++b)
#pragma unroll
            for (int m = 0; m < 4; ++m)
#pragma unroll
                for (int n = 0; n < 2; ++n) acc[a][b][m][n] = (f32x4){0.f, 0.f, 0.f, 0.f};
    bf16x8 At[4][2], B0[2][2], B1[2][2];
    const char* cA = (const char*)g.A + (size_t)cur.pm * tstep; const char* cB = (const char*)g.Bt + (size_t)cur.pn * tstep;
    S.a_ready(cur);
    if constexpr (SP2) {
        PG8_STAGE(PG8_SB(0, 0), cB, voffB); PG8_STAGE(PG8_SB(0, 1), cB + hstep, voffB); PG8_STAGE(PG8_SA(0, 0), cA, voffA); PG8_STAGE(PG8_SA(0, 1), cA + hstep, voffA);
        if (wr == 1) PG8_BAR;
        PG8_WAIT_V(2); PG8_BAR;
        PG8_STAGE(PG8_SB(1, 0), cB + kstep, voffB); PG8_STAGE(PG8_SA(1, 0), cA + kstep, voffA); PG8_STAGE(PG8_SB(1, 1), cB + hstep + kstep, voffB);
        PG8_WAIT_V(6); PG8_BAR;
    } else {
        PG8_STAGE(PG8_SB(0, 0), cB, voffB); PG8_STAGE(PG8_SA(0, 0), cA, voffA); PG8_STAGE(PG8_SB(0, 1), cB + hstep, voffB); PG8_STAGE(PG8_SA(0, 1), cA + hstep, voffA);
        if (wr == 1) PG8_BAR;
        PG8_WAIT_V(4); PG8_BAR;
        PG8_STAGE(PG8_SB(1, 0), cB + kstep, voffB); PG8_STAGE(PG8_SA(1, 0), cA + kstep, voffA); PG8_STAGE(PG8_SB(1, 1), cB + hstep + kstep, voffB);
        PG8_WAIT_V(6); PG8_BAR;
    }
    for (;;) {
        const bool has_next = S.next(ui + 1, nxt);
        const char* nA = has_next ? (const char*)g.A + (size_t)nxt.pm * tstep : cA; const char* nB = has_next ? (const char*)g.Bt + (size_t)nxt.pn * tstep : cB;
        for (int t = 0; t < nt; t += 2) {
            const bool last = (t == nt - 2);
            const char* a1 = cA + (size_t)(t + 1) * kstep;
            const char* a2 = last ? nA : cA + (size_t)(t + 2) * kstep; const char* b2 = last ? nB : cB + (size_t)(t + 2) * kstep;
            const char* a3 = a2 + kstep; const char* b3 = b2 + kstep;
            if (last && has_next) S.a_ready(nxt);
            if constexpr (SP2) {
            PG8_LDB(B0, 0, 0); PG8_LDB(B1, 0, 1); PG8_SCHED; PG8_LDA(At, 0, 0); PG8_STAGE(PG8_SA(1, 1), a1 + hstep, voffA);
            PG8_WAIT_V(8); PG8_WAIT_L(0); PG8_BAR; PG8_MMA(0, 0, At, B0); PG8_MMA(0, 1, At, B1); PG8_BAR; PG8_SCHED;
            PG8_LDA(At, 0, 1); PG8_STAGE(PG8_SB(0, 0), b2, voffB); PG8_STAGE(PG8_SB(0, 1), b2 + hstep, voffB); PG8_STAGE(PG8_SA(0, 0), a2, voffA);
            PG8_WAIT_V(8); PG8_WAIT_L(0); PG8_BAR; PG8_MMA(1, 0, At, B0); PG8_MMA(1, 1, At, B1); PG8_BAR; PG8_SCHED;
            PG8_LDB(B0, 1, 0); PG8_LDB(B1, 1, 1); PG8_SCHED; PG8_LDA(At, 1, 0); PG8_STAGE(PG8_SA(0, 1), a2 + hstep, voffA);
            PG8_WAIT_V(8); PG8_WAIT_L(0); PG8_BAR; PG8_MMA(0, 0, At, B0); PG8_MMA(0, 1, At, B1); PG8_BAR; PG8_SCHED;
            PG8_LDA(At, 1, 1); PG8_STAGE(PG8_SB(1, 0), b3, voffB); PG8_STAGE(PG8_SB(1, 1), b3 + hstep, voffB); PG8_STAGE(PG8_SA(1, 0), a3, voffA);
            PG8_WAIT_V(8); PG8_WAIT_L(0); PG8_BAR; PG8_MMA(1, 0, At, B0); PG8_MMA(1, 1, At, B1); PG8_BAR; PG8_SCHED;
            } else {
            PG8_LDB(B0, 0, 0); PG8_SCHED; PG8_LDA(At, 0, 0); PG8_STAGE(PG8_SA(1, 1), a1 + hstep, voffA);
            PG8_WAIT_L(8); PG8_BAR; PG8_WAIT_L(0); PG8_MMA(0, 0, At, B0); PG8_BAR; PG8_SCHED;
            PG8_LDB(B1, 0, 1); PG8_STAGE(PG8_SB(0, 0), b2, voffB);
            PG8_BAR; PG8_WAIT_L(0); PG8_MMA(0, 1, At, B1); PG8_BAR;
            PG8_LDA(At, 0, 1); PG8_STAGE(PG8_SA(0, 0), a2, voffA);
            PG8_BAR; PG8_WAIT_L(0); PG8_MMA(1, 0, At, B0); PG8_BAR; PG8_SCHED;
            PG8_STAGE(PG8_SB(0, 1), b2 + hstep, voffB);
            PG8_WAIT_V(6); PG8_BAR; PG8_MMA(1, 1, At, B1); PG8_BAR;
            PG8_LDB(B0, 1, 0); PG8_SCHED; PG8_LDA(At, 1, 0); PG8_STAGE(PG8_SA(0, 1), a2 + hstep, voffA);
            PG8_WAIT_L(8); PG8_BAR; PG8_WAIT_L(0); PG8_MMA(0, 0, At, B0); PG8_BAR; PG8_SCHED;
            PG8_LDB(B1, 1, 1); PG8_STAGE(PG8_SB(1, 0), b3, voffB);
            PG8_BAR; PG8_WAIT_L(0); PG8_MMA(0, 1, At, B1); PG8_BAR;
            PG8_LDA(At, 1, 1); PG8_STAGE(PG8_SA(1, 0), a3, voffA);
            PG8_BAR; PG8_WAIT_L(0); PG8_MMA(1, 0, At, B0); PG8_BAR; PG8_SCHED;
            PG8_STAGE(PG8_SB(1, 1), b3 + hstep, voffB);
            PG8_WAIT_V(6); PG8_BAR; PG8_MMA(1, 1, At, B1); PG8_BAR;
            }
        }
        if constexpr (ALIGN_EPI) { if (wr == 0) PG8_BAR; }
        if constexpr (!Epi::AFTER_DRAIN) { E(acc, cur, wr, wc, fr, fq); S.done(cur); }
        if (!has_next) break;
#pragma unroll
        for (int a = 0; a < 2; ++a)
#pragma unroll
            for (int b = 0; b < 2; ++b)
#pragma unroll
                for (int m = 0; m < 4; ++m)
#pragma unroll
                    for (int n = 0; n < 2; ++n) acc[a][b][m][n] = (f32x4){0.f, 0.f, 0.f, 0.f};
        cur = nxt; cA = nA; cB = nB; ++ui;
        if constexpr (ALIGN_EPI) { if (wr == 1) PG8_BAR; }
    }
    PG8_WAIT_V(0);
    if constexpr (!ALIGN_EPI) { if (wr == 0) PG8_BAR; }
    PG8_BAR;
    if constexpr (Epi::AFTER_DRAIN) { E.fused(acc, cur, wr, wc, fr, fq, lds, wid, lane); S.done(cur); }
#undef PG8_SA
#undef PG8_SB
#undef PG8_STAGE
#undef PG8_LDA
#undef PG8_LDB
#undef PG8_MMA
#undef PG8_WAIT_V
#undef PG8_WAIT_L
#undef PG8_BAR
#undef PG8_SCHED
}
}

constexpr int NWAVES = 8, NTHR = 512;
constexpr int DM = 1024, SEQ = 16384, DB = 128, DSEQ = 4, NSAMP = DB * DSEQ, MTOT = SEQ + NSAMP;
constexpr int AH = 12, HD = 64, ATTW = 768, SH = 20, SSW = 1280, NG = 4, DSTATE = 128, CONVD = 2304, MIXW = 2048, DFF = 2816, DINP = 5908;
constexpr int NP = 6144;
constexpr int CQ = 0, CK = 768, CV = 1536, CZ = 2304, CX = 3584, CDT = 5888;
constexpr int WB = 2048;
constexpr int NCHUNK = 128, CL = 128;
constexpr float EPS = 1e-6f;
constexpr size_t O_YP = 0, O_YS = O_YP + (size_t)SEQ * DM, O_WKP = O_YS + (size_t)NSAMP * DM, O_WVP = O_WKP + (size_t)2048 * ATTW, O_CVP = O_WVP + (size_t)2048 * ATTW,
                 O_SSP = O_CVP + 3 * CONVD, O_WKS = O_SSP + (size_t)SH * HD * DSTATE, O_WVS = O_WKS + (size_t)NSAMP * ATTW, O_CVS = O_WVS + (size_t)NSAMP * ATTW,
                 O_SSS = O_CVS + (size_t)DB * 3 * CONVD, O_END = O_SSS + (size_t)DB * SH * HD * DSTATE;
constexpr size_t MiB = 1u << 20;
constexpr size_t WS_CTL = 0, CTL_ZERO_BYTES = 1 * MiB;
constexpr size_t CTL_SS2 = 256 * 1024, CTL_SS3 = 384 * 1024;
constexpr size_t WS_WIN = 2 * MiB;
constexpr size_t WS_WOUT = WS_WIN + (size_t)NP * DM * 2;
constexpr size_t WS_WGU = WS_WOUT + (size_t)DM * MIXW * 2;
constexpr size_t WS_WDN = WS_WGU + (size_t)2 * DFF * DM * 2;
constexpr size_t WS_BKT = WS_WDN + (size_t)DM * DFF * 2;
constexpr size_t WS_RS1 = WS_BKT + 16384;
constexpr size_t WS_ATTSS = WS_RS1 + (size_t)MTOT * 4;
constexpr size_t WS_DTB = WS_ATTSS + (size_t)MTOT * 12 * 4;
constexpr size_t WS_ACS = WS_DTB + (size_t)SEQ * 20 * 4;
constexpr size_t WS_CDEC = WS_ACS + (size_t)SEQ * 20 * 4;
constexpr size_t WS_XB = 64 * MiB;
constexpr size_t WS_PROJ = WS_XB + (size_t)MTOT * DM * 2;
constexpr size_t WS_MIX = WS_PROJ + (size_t)MTOT * NP * 2;
constexpr size_t WS_X1 = WS_MIX + (size_t)MTOT * MIXW * 2;
constexpr size_t WS_X1B = WS_X1 + (size_t)MTOT * DM * 4;
constexpr size_t WS_ACT = WS_X1B + (size_t)MTOT * DM * 2;
constexpr size_t WS_XC = WS_ACT + (size_t)MTOT * DFF * 2;
constexpr size_t WS_ST = WS_XC + (size_t)SEQ * CONVD * 2;
constexpr size_t WS_END = WS_ST + (size_t)NCHUNK * SH * HD * DSTATE * 4;
static_assert(WS_CDEC + 128 * 20 * 4 <= WS_XB, "ws map");
constexpr int CW_BAR = 1024;
constexpr int RING_BYTES = 131072;
constexpr int MISC_OFF = 147456;
constexpr int LDS_BYTES = 147456 + 256;

#define GAS __attribute__((address_space(1)))
#define LAS __attribute__((address_space(3)))
typedef unsigned short bf16;
typedef unsigned v4u __attribute__((ext_vector_type(4)));
typedef float f32x4 __attribute__((ext_vector_type(4)));
typedef short bf16x8 __attribute__((ext_vector_type(8)));
typedef GAS unsigned gu32;
typedef GAS unsigned long long gu64;
#define RLX_AGENT __ATOMIC_RELAXED, __HIP_MEMORY_SCOPE_AGENT
#define LDS_WAIT() asm volatile("s_waitcnt lgkmcnt(0)" ::: "memory")
#define VM_WAIT() asm volatile("s_waitcnt vmcnt(0)" ::: "memory")
__device__ __forceinline__ unsigned long long rt() { return __builtin_amdgcn_s_memrealtime(); }
__device__ __forceinline__ unsigned f2bf(float f) { unsigned u = __builtin_bit_cast(unsigned, f); return (u + 0x7fffu + ((u >> 16) & 1u)) >> 16; }
__device__ __forceinline__ unsigned pk2(float lo, float hi) { return f2bf(lo) | (f2bf(hi) << 16); }

#define XB_TMO      128
#define XB_XCNT(j)  (256  + 64 * (j))
#define XB_XSUB(j)  (1280 + 64 * (j))
#define XB_XGEN(j)  (2304 + 64 * (j))
#define XB_TOP      3328
#define XB_TOPGEN   3392
#define XCD_BAR_WORDS 3456
#define XB_SPIN_CAP (1u << 23)

__device__ __forceinline__ unsigned xb_ld(unsigned* p)              { return __hip_atomic_load(p, __ATOMIC_RELAXED, __HIP_MEMORY_SCOPE_AGENT); }
__device__ __forceinline__ unsigned xb_add(unsigned* p, unsigned v) { return __hip_atomic_fetch_add(p, v, __ATOMIC_RELAXED, __HIP_MEMORY_SCOPE_AGENT); }
__device__ __forceinline__ unsigned xb_xcc_id() { return (unsigned)__builtin_amdgcn_s_getreg((3 << 11) | 20) & 0xFu; }
#define XB_SPIN(cond, bar) do { unsigned _sp = 0; while (cond) { __builtin_amdgcn_s_sleep(1); \
    if ((++_sp & 255u) == 0u) { if (xb_ld(&(bar)[XB_TMO])) break; if (_sp > XB_SPIN_CAP) { atomicAdd(&(bar)[XB_TMO], 1u); break; } } } } while (0)

struct XcdBarrier {
    unsigned* bar; unsigned x;
    volatile LAS unsigned* st;
};

__device__ __forceinline__ XcdBarrier xcd_barrier_post(unsigned* bar, volatile LAS unsigned* st) {
    XcdBarrier b; b.bar = bar; b.x = xb_xcc_id(); b.st = st;
    if (threadIdx.x == 0) (void)xb_add(&bar[XB_XCNT(b.x)], 1u);
    return b;
}
__device__ __forceinline__ void xcd_barrier_complete(unsigned* bar, unsigned x, unsigned& nloc, unsigned& nx) {
    const unsigned G = gridDim.x * gridDim.y * gridDim.z;
    unsigned sum, cnt, mine, sp = 0u;
    for (;;) {
        sum = 0u; cnt = 0u; mine = 0u;
#pragma unroll
        for (unsigned j = 0; j < 16; ++j) { const unsigned c = xb_ld(&bar[XB_XCNT(j)]); sum += c; cnt += (c > 0u) ? 1u : 0u; mine = (j == x) ? c : mine; }
        if (sum == G) break;
        __builtin_amdgcn_s_sleep(1);
        if ((++sp & 255u) == 0u) { if (xb_ld(&bar[XB_TMO])) break; if (sp > XB_SPIN_CAP) { atomicAdd(&bar[XB_TMO], 1u); break; } }
    }
    nloc = mine > 0u ? mine : 1u; nx = cnt > 0u ? cnt : 1u;
}

__device__ __forceinline__ void xcd_barrier(const XcdBarrier& b) {
    asm volatile("s_waitcnt vmcnt(0)" ::: "memory");
    __syncthreads();
    if (threadIdx.x == 0) {
        unsigned* bar = b.bar;
        __builtin_amdgcn_s_waitcnt(0);
        unsigned nloc = b.st[0], nx = b.st[1];
        if (nloc == 0u) { xcd_barrier_complete(bar, b.x, nloc, nx); b.st[0] = nloc; b.st[1] = nx; }
        const unsigned old = xb_add(&bar[XB_XSUB(b.x)], 1u);
        const unsigned gen = old / nloc;
        if (old + 1u == (gen + 1u) * nloc) {
            __builtin_amdgcn_fence(__ATOMIC_RELEASE, "agent");
            asm volatile("s_waitcnt vmcnt(0)" ::: "memory");
            const unsigned og = xb_add(&bar[XB_TOP], 1u);
            const unsigned tg = og / nx;
            if (og + 1u == (tg + 1u) * nx) xb_add(&bar[XB_TOPGEN], 1u);
            else XB_SPIN(xb_ld(&bar[XB_TOPGEN]) == tg, bar);
            __builtin_amdgcn_fence(__ATOMIC_ACQUIRE, "agent");
            xb_add(&bar[XB_XGEN(b.x)], 1u);
            asm volatile("s_waitcnt vmcnt(0)" ::: "memory");
        } else {
            XB_SPIN(xb_ld(&bar[XB_XGEN(b.x)]) == gen, bar);
            __builtin_amdgcn_fence(__ATOMIC_ACQUIRE, "agent");
            asm volatile("s_waitcnt vmcnt(0)" ::: "memory");
        }
    }
    __syncthreads();
}

__device__ __forceinline__ float bf2f(unsigned short u) { return __uint_as_float((unsigned)u << 16); }
__device__ __forceinline__ float wave_sum(float v) {
#pragma unroll
    for (int o = 1; o < 64; o <<= 1) v += __shfl_xor(v, o);
    return v;
}
__device__ __forceinline__ float silu_f(float x) { return x / (1.f + __expf(-x)); }
__device__ __forceinline__ float softplus_f(float x) { return x > 20.f ? x : log1pf(__expf(x)); }
__device__ __forceinline__ int rel_bucket(int n) {
    if (n < 16) return n;
    const float v = logf((float)n / 16.0f) / 4.852030263919617f * 16.0f;
    int b = 16 + (int)v; return b > 31 ? 31 : b;
}
__device__ __forceinline__ int attn_mult(int delta) {
    return (delta <= 128 ? 1 : 0) + (((delta & 3) == 0 && delta <= 512) ? 1 : 0) + (((delta & 15) == 0 && delta <= 2048) ? 1 : 0);
}

struct Frame {
    LAS unsigned char* lds;
    int tid, lane, wave, G;
    const float* in[22]; float* out; unsigned char* ws;
};
#define WSP(T, off) ((T*)(F.ws + (off)))

template <int MODE>
__device__ __forceinline__ void tr_item(const float* W, int K, int N, const float* gain, bf16* WT, LAS float* scr, int kb, int nb, int lane) {
    const int k0 = 64 * kb, n0 = 32 * nb;
    {
        const int n = n0 + (lane & 31);
#pragma unroll 8
        for (int i = 0; i < 32; ++i) { const int kk = 2 * i + (lane >> 5); float v = (n < N) ? W[(size_t)(k0 + kk) * N + n] : 0.f; if (gain) v *= gain[k0 + kk]; scr[kk * 33 + (lane & 31)] = v; }
    }
    LDS_WAIT(); asm volatile("" ::: "memory");
    const int c = lane & 7;
#pragma unroll
    for (int j = 0; j < 4; ++j) { const int nl = (lane >> 3) + 8 * j, n = n0 + nl; const LAS float* s = scr + (8 * c) * 33 + nl;
        v4u o; o.x = pk2(s[0 * 33], s[1 * 33]); o.y = pk2(s[2 * 33], s[3 * 33]); o.z = pk2(s[4 * 33], s[5 * 33]); o.w = pk2(s[6 * 33], s[7 * 33]);
        int drow = n; if (MODE == 1) drow = (n >> 7) * 256 + (n & 127); if (MODE == 2) drow = (n >> 7) * 256 + 128 + (n & 127);
        *(GAS v4u*)(WT + (size_t)drow * K + k0 + 8 * c) = o; }
    LDS_WAIT(); asm volatile("" ::: "memory");
}
__device__ __forceinline__ void p0_prologue(Frame& F) {
    LAS float* scr = (LAS float*)(F.lds + F.wave * 16384);
    const int gw = blockIdx.x * NWAVES + F.wave, NGW = F.G * NWAVES;
    constexpr int I_IN = 16 * 192, I_OUT = 32 * 32, I_G = 16 * 88, I_D = 44 * 32;
    constexpr int NITEMS = I_IN + I_OUT + 2 * I_G + I_D;
    for (int it = gw; it < NITEMS; it += NGW) {
        int r = it;
        if (r < I_IN) { tr_item<0>(F.in[8], DM, DINP, F.in[7], WSP(bf16, WS_WIN), scr, r / 192, r % 192, F.lane); continue; } r -= I_IN;
        if (r < I_OUT) { tr_item<0>(F.in[16], MIXW, DM, nullptr, WSP(bf16, WS_WOUT), scr, r / 32, r % 32, F.lane); continue; } r -= I_OUT;
        if (r < I_G) { tr_item<1>(F.in[18], DM, DFF, F.in[17], WSP(bf16, WS_WGU), scr, r / 88, r % 88, F.lane); continue; } r -= I_G;
        if (r < I_G) { tr_item<2>(F.in[19], DM, DFF, F.in[17], WSP(bf16, WS_WGU), scr, r / 88, r % 88, F.lane); continue; } r -= I_G;
        tr_item<0>(F.in[20], DFF, DM, nullptr, WSP(bf16, WS_WDN), scr, r / 32, r % 32, F.lane);
    }
    bf16* XB = WSP(bf16, WS_XB); float* RS1 = WSP(float, WS_RS1);
    for (int m = gw; m < MTOT; m += NGW) {
        const float* xrow = m < SEQ ? F.in[0] + (size_t)m * DM : F.in[1] + (size_t)(m - SEQ) * DM;
        const GAS f32x4* xr = (const GAS f32x4*)xrow + F.lane;
        f32x4 v[4]; float s = 0.f;
#pragma unroll
        for (int j = 0; j < 4; ++j) { v[j] = xr[64 * j]; s += (v[j].x * v[j].x + v[j].y * v[j].y) + (v[j].z * v[j].z + v[j].w * v[j].w); }
        s = wave_sum(s);
        GAS unsigned long long* o8 = (GAS unsigned long long*)(XB + (size_t)m * DM) + F.lane;
#pragma unroll
        for (int j = 0; j < 4; ++j) o8[64 * j] = (unsigned long long)pk2(v[j].x, v[j].y) | ((unsigned long long)pk2(v[j].z, v[j].w) << 32);
        if (F.lane == 0) RS1[m] = 1.0f / sqrtf(s * (1.0f / DM) + EPS);
    }
    int* BKT = WSP(int, WS_BKT);
    for (int i = blockIdx.x * NTHR + F.tid; i <= 2048; i += F.G * NTHR) BKT[i] = rel_bucket(i);
}

struct EpiProj {
    static constexpr bool PERM = true, AFTER_DRAIN = false;
    bf16* O; const float* rs; float* out;
    __device__ __forceinline__ void operator()(const pg8::f32x4 (&acc)[2][2][4][2], const pg8::Unit& u, int wr, int wc, int fr, int fq) const {
        const int row0 = u.pm * 256 + wr * 64 + fr, col0 = u.pn * 256 + wc * 32 + 8 * fq;
        const bool kv = (u.pm >= 56) && (u.pn >= 3) && (u.pn < 9); const bool is_k = u.pn < 6;
#pragma unroll
        for (int ai = 0; ai < 2; ++ai)
#pragma unroll
            for (int m = 0; m < 4; ++m) { const int row = row0 + ai * 128 + m * 16; const float s = rs[row];
#pragma unroll
                for (int bj = 0; bj < 2; ++bj) { const int col = col0 + bj * 128; const pg8::f32x4 v0 = acc[ai][bj][m][0] * s, v1 = acc[ai][bj][m][1] * s;
                    pg8::u32x4 w; w.x = pg8::cvt_pk_bf16(v0[0], v0[1]); w.y = pg8::cvt_pk_bf16(v0[2], v0[3]); w.z = pg8::cvt_pk_bf16(v1[0], v1[1]); w.w = pg8::cvt_pk_bf16(v1[2], v1[3]);
                    *(pg8::u32x4*)(O + (size_t)row * NP + col) = w;
                    if (kv) { const int cc = col - (is_k ? CK : CV);
                        float* dst = row < SEQ ? out + (is_k ? O_WKP : O_WVP) + (size_t)(row - (SEQ - 2048)) * ATTW + cc : out + (is_k ? O_WKS : O_WVS) + (size_t)(row - SEQ) * ATTW + cc;
                        *(pg8::f32x4*)dst = v0; *(pg8::f32x4*)(dst + 4) = v1; } } }
    }
};
struct EpiOut {
    static constexpr bool PERM = false, AFTER_DRAIN = false;
    const float* xp; const float* xs; float* X1; bf16* X1B; float* SS;
    __device__ __forceinline__ void operator()(const pg8::f32x4 (&acc)[2][2][4][2], const pg8::Unit& u, int wr, int wc, int fr, int fq) const {
        const int row0 = u.pm * 256 + wr * 64 + fr, col0 = u.pn * 256 + wc * 32 + 4 * fq;
#pragma unroll
        for (int ai = 0; ai < 2; ++ai)
#pragma unroll
            for (int m = 0; m < 4; ++m) { const int row = row0 + ai * 128 + m * 16; const float* xr = row < SEQ ? xp + (size_t)row * DM : xs + (size_t)(row - SEQ) * DM; float ss = 0.f;
#pragma unroll
                for (int bj = 0; bj < 2; ++bj)
#pragma unroll
                    for (int n = 0; n < 2; ++n) { const int col = col0 + bj * 128 + n * 16; const pg8::f32x4 v = acc[ai][bj][m][n] + *(const pg8::f32x4*)(xr + col);
                        *(pg8::f32x4*)(X1 + (size_t)row * DM + col) = v; ss += (v[0] * v[0] + v[1] * v[1]) + (v[2] * v[2] + v[3] * v[3]);
                        *(unsigned long long*)(X1B + (size_t)row * DM + col) = (unsigned long long)pg8::cvt_pk_bf16(v[0], v[1]) | ((unsigned long long)pg8::cvt_pk_bf16(v[2], v[3]) << 32); }
                ss += __shfl_xor(ss, 16); ss += __shfl_xor(ss, 32);
                if (fq == 0) atomicAdd(SS + row, ss); }
    }
};
struct EpiGU {
    static constexpr bool PERM = true, AFTER_DRAIN = false;
    bf16* ACT; const float* SS;
    __device__ __forceinline__ void operator()(const pg8::f32x4 (&acc)[2][2][4][2], const pg8::Unit& u, int wr, int wc, int fr, int fq) const {
        const int row0 = u.pm * 256 + wr * 64 + fr, col0 = u.pn * 128 + wc * 32 + 8 * fq;
#pragma unroll
        for (int ai = 0; ai < 2; ++ai)
#pragma unroll
            for (int m = 0; m < 4; ++m) { const int row = row0 + ai * 128 + m * 16; const float s = 1.0f / sqrtf(SS[row] * (1.0f / DM) + EPS);
                float a[8];
#pragma unroll
                for (int n = 0; n < 2; ++n)
#pragma unroll
                    for (int e = 0; e < 4; ++e) { const float g = acc[ai][0][m][n][e] * s, uu = acc[ai][1][m][n][e] * s; a[4 * n + e] = silu_f(g) * uu; }
                pg8::u32x4 w; w.x = pg8::cvt_pk_bf16(a[0], a[1]); w.y = pg8::cvt_pk_bf16(a[2], a[3]); w.z = pg8::cvt_pk_bf16(a[4], a[5]); w.w = pg8::cvt_pk_bf16(a[6], a[7]);
                *(pg8::u32x4*)(ACT + (size_t)row * DFF + col0) = w; }
    }
};
struct EpiDown {
    static constexpr bool PERM = false, AFTER_DRAIN = false;
    const float* X1; float* Y; float* SS;
    __device__ __forceinline__ void operator()(const pg8::f32x4 (&acc)[2][2][4][2], const pg8::Unit& u, int wr, int wc, int fr, int fq) const {
        const int row0 = u.pm * 256 + wr * 64 + fr, col0 = u.pn * 256 + wc * 32 + 4 * fq;
#pragma unroll
        for (int ai = 0; ai < 2; ++ai)
#pragma unroll
            for (int m = 0; m < 4; ++m) { const int row = row0 + ai * 128 + m * 16; float ss = 0.f;
#pragma unroll
                for (int bj = 0; bj < 2; ++bj)
#pragma unroll
                    for (int n = 0; n < 2; ++n) { const int col = col0 + bj * 128 + n * 16; const pg8::f32x4 v = acc[ai][bj][m][n] + *(const pg8::f32x4*)(X1 + (size_t)row * DM + col);
                        *(pg8::f32x4*)(Y + (size_t)row * DM + col) = v; ss += (v[0] * v[0] + v[1] * v[1]) + (v[2] * v[2] + v[3] * v[3]); }
                ss += __shfl_xor(ss, 16); ss += __shfl_xor(ss, 32);
                if (fq == 0) atomicAdd(SS + row, ss); }
    }
};

__device__ __forceinline__ void attn_prompt_simple(Frame& F) {
    const bf16* PROJ = WSP(bf16, WS_PROJ); bf16* MIX = WSP(bf16, WS_MIX); float* ATTSS = WSP(float, WS_ATTSS);
    const int* BKT = WSP(int, WS_BKT); const float* relb = F.in[6];
    const int gw = blockIdx.x * NWAVES + F.wave, NGW = F.G * NWAVES, lane = F.lane;
    for (int t = gw; t < SEQ; t += NGW) {
        for (int h = 0; h < AH; ++h) {
            const float q = bf2f(PROJ[(size_t)t * NP + CQ + h * 64 + lane]) * 0.125f;
            float m = -1e30f, l = 0.f, o = 0.f;
            for (int br = 0; br < 3; ++br) {
                const int d = (br == 0) ? 1 : (br == 1) ? 4 : 16;
                int imax = t / d; if (imax > 128) imax = 128;
                int i = 0;
                for (; i + 3 <= imax; i += 4) {
                    float k[4], v[4], s[4];
#pragma unroll
                    for (int j = 0; j < 4; ++j) { const bf16* kp = PROJ + (size_t)(t - (i + j) * d) * NP + CK + h * 64 + lane; k[j] = bf2f(kp[0]); v[j] = bf2f(kp[CV - CK]); s[j] = q * k[j]; }
#pragma unroll
                    for (int o_ = 1; o_ < 64; o_ <<= 1) {
#pragma unroll
                        for (int j = 0; j < 4; ++j) s[j] += __shfl_xor(s[j], o_); }
#pragma unroll
                    for (int j = 0; j < 4; ++j) s[j] += relb[BKT[(i + j) * d] * AH + h];
                    const float mn = fmaxf(fmaxf(fmaxf(m, s[0]), fmaxf(s[1], s[2])), s[3]);
                    const float a = __expf(m - mn); l *= a; o *= a; m = mn;
#pragma unroll
                    for (int j = 0; j < 4; ++j) { const float p = __expf(s[j] - mn); l += p; o += p * v[j]; }
                }
                for (; i <= imax; ++i) {
                    const bf16* kp = PROJ + (size_t)(t - i * d) * NP + CK + h * 64 + lane;
                    const float kk = bf2f(kp[0]), vv = bf2f(kp[CV - CK]);
                    const float s = wave_sum(q * kk) + relb[BKT[i * d] * AH + h];
                    const float mn = fmaxf(m, s); const float a = __expf(m - mn), p = __expf(s - mn);
                    l = l * a + p; o = o * a + p * vv; m = mn;
                }
            }
            const float r = o / l;
            MIX[(size_t)t * MIXW + h * 64 + lane] = (bf16)f2bf(r);
            const float sq = wave_sum(r * r); if (lane == 0) ATTSS[t * AH + h] = sq;
        }
    }
}

__device__ __forceinline__ void attn_sample(Frame& F) {
    const bf16* PROJ = WSP(bf16, WS_PROJ); bf16* MIX = WSP(bf16, WS_MIX); float* ATTSS = WSP(float, WS_ATTSS);
    const int* BKT = WSP(int, WS_BKT); const float* relb = F.in[6];
    const float* cache_k = F.in[2]; const float* cache_v = F.in[3];
    const int lane = F.lane, wave = F.wave, hl = lane >> 4, d0 = 4 * (lane & 15);
    LAS float* comb = (LAS float*)F.lds;
    for (int unit = blockIdx.x; unit < DB * 3; unit += F.G) {
        const int b = unit / 3, hg = unit % 3, head = hg * 4 + hl;
        float q[4][4];
#pragma unroll
        for (int t = 0; t < 4; ++t) { const bf16* qp = PROJ + (size_t)(SEQ + 4 * b + t) * NP + CQ + head * 64 + d0;
#pragma unroll
            for (int e = 0; e < 4; ++e) q[t][e] = bf2f(qp[e]) * 0.125f; }
        float m[4], l[4], o[4][4];
#pragma unroll
        for (int t = 0; t < 4; ++t) { m[t] = -1e30f; l[t] = 0.f;
#pragma unroll
            for (int e = 0; e < 4; ++e) o[t][e] = 0.f; }
        for (int e = wave; e < 900; e += 8) {
            const int rho = e < 384 ? 16 * (e >> 2) + (e & 3) : (e < 768 ? 1536 + (e - 384) : 1920 + (e - 768));
            f32x4 kk, vv;
            if (rho < WB) { const size_t off = (((size_t)b * WB + rho) * AH + head) * HD + d0; kk = *(const f32x4*)(cache_k + off); vv = *(const f32x4*)(cache_v + off); }
            else { const bf16* kp = PROJ + (size_t)(SEQ + 4 * b + (rho - WB)) * NP + CK + head * 64 + d0;
                kk = (f32x4){bf2f(kp[0]), bf2f(kp[1]), bf2f(kp[2]), bf2f(kp[3])}; vv = (f32x4){bf2f(kp[CV - CK]), bf2f(kp[CV - CK + 1]), bf2f(kp[CV - CK + 2]), bf2f(kp[CV - CK + 3])}; }
#pragma unroll
            for (int t = 0; t < 4; ++t) {
                const int delta = WB + t - rho;
                if (delta < 0) continue;
                const int mu = attn_mult(delta);
                if (mu == 0) continue;
                float s = (q[t][0] * kk[0] + q[t][1] * kk[1]) + (q[t][2] * kk[2] + q[t][3] * kk[3]);
                s += __shfl_xor(s, 1); s += __shfl_xor(s, 2); s += __shfl_xor(s, 4); s += __shfl_xor(s, 8);
                s += relb[BKT[delta] * AH + head];
                const float mn = fmaxf(m[t], s); const float a = __expf(m[t] - mn), p = (float)mu * __expf(s - mn);
                l[t] = l[t] * a + p; m[t] = mn;
#pragma unroll
                for (int e2 = 0; e2 < 4; ++e2) o[t][e2] = o[t][e2] * a + p * vv[e2];
            }
        }
#pragma unroll
        for (int t = 0; t < 4; ++t) { LAS float* c = comb + ((wave * 4 + t) * 64 + lane) * 6; c[0] = m[t]; c[1] = l[t]; c[2] = o[t][0]; c[3] = o[t][1]; c[4] = o[t][2]; c[5] = o[t][3]; }
        __syncthreads();
        if (F.tid < 256) {
            const int t = F.tid >> 6;
            float mm = -1e30f;
#pragma unroll
            for (int w = 0; w < 8; ++w) mm = fmaxf(mm, comb[((w * 4 + t) * 64 + lane) * 6]);
            float ll = 0.f, oo[4] = {0.f, 0.f, 0.f, 0.f};
#pragma unroll
            for (int w = 0; w < 8; ++w) { const LAS float* c = comb + ((w * 4 + t) * 64 + lane) * 6; const float a = __expf(c[0] - mm); ll += c[1] * a;
#pragma unroll
                for (int e2 = 0; e2 < 4; ++e2) oo[e2] += c[2 + e2] * a; }
            const float inv = 1.0f / ll; float sq = 0.f;
#pragma unroll
            for (int e2 = 0; e2 < 4; ++e2) { oo[e2] *= inv; sq += oo[e2] * oo[e2]; }
            const int row = SEQ + 4 * b + t;
            *(unsigned long long*)(MIX + (size_t)row * MIXW + head * 64 + d0) = (unsigned long long)pk2(oo[0], oo[1]) | ((unsigned long long)pk2(oo[2], oo[3]) << 32);
            sq += __shfl_xor(sq, 1); sq += __shfl_xor(sq, 2); sq += __shfl_xor(sq, 4); sq += __shfl_xor(sq, 8);
            if ((lane & 15) == 0) ATTSS[row * AH + head] = sq;
        }
        __syncthreads();
    }
}

__device__ __forceinline__ void ssd_phase_a(Frame& F) {
    const bf16* PROJ = WSP(bf16, WS_PROJ); bf16* XC = WSP(bf16, WS_XC); float* DTB = WSP(float, WS_DTB); float* ACS = WSP(float, WS_ACS); float* CDEC = WSP(float, WS_CDEC); float* ST = WSP(float, WS_ST);
    const float* conv_w = F.in[9]; const float* conv_b = F.in[10]; const float* dt_bias = F.in[11]; const float* a_log = F.in[12];
    LAS bf16* xs = (LAS bf16*)F.lds;
    LAS bf16* Bs = (LAS bf16*)(F.lds + 81920);
    LAS float* dts = (LAS float*)(F.lds + 81920 + 32768);
    LAS float* acsS = dts + 640;
    LAS float* wl = acsS + 640;
    const int tid = F.tid, lane = F.lane, wave = F.wave;
    for (int unit = blockIdx.x; unit < NCHUNK * NG; unit += F.G) {
        const int c = unit >> 2, g = unit & 3, T0 = c * CL;
        for (int task = tid; task < 576 * 8; task += NTHR) {
            const int cj = task % 576, seg = task / 576;
            const int xcol = cj < 320 ? g * 320 + cj : (cj < 448 ? 1280 + g * 128 + (cj - 320) : 1792 + g * 128 + (cj - 448));
            const float w0 = conv_w[xcol], w1 = conv_w[CONVD + xcol], w2 = conv_w[2 * CONVD + xcol], w3 = conv_w[3 * CONVD + xcol], bb = conv_b[xcol];
            const int t0 = T0 + seg * 16;
            float x0 = t0 >= 3 ? bf2f(PROJ[(size_t)(t0 - 3) * NP + CX + xcol]) : 0.f, x1 = t0 >= 2 ? bf2f(PROJ[(size_t)(t0 - 2) * NP + CX + xcol]) : 0.f, x2 = t0 >= 1 ? bf2f(PROJ[(size_t)(t0 - 1) * NP + CX + xcol]) : 0.f;
#pragma unroll 4
            for (int i = 0; i < 16; ++i) { const float x3 = bf2f(PROJ[(size_t)(t0 + i) * NP + CX + xcol]);
                const float y = silu_f(x0 * w0 + x1 * w1 + x2 * w2 + x3 * w3 + bb); const bf16 yb = (bf16)f2bf(y);
                XC[(size_t)(t0 + i) * CONVD + xcol] = yb;
                const int l = seg * 16 + i;
                if (cj < 320) xs[l * 320 + cj] = yb; else if (cj < 448) Bs[l * 128 + (cj - 320)] = yb;
                x0 = x1; x1 = x2; x2 = x3; }
            if (c == NCHUNK - 1 && seg == 7) {
                F.out[O_CVP + 0 * CONVD + xcol] = x0; F.out[O_CVP + 1 * CONVD + xcol] = x1; F.out[O_CVP + 2 * CONVD + xcol] = x2; }
        }
        for (int i = tid; i < 640; i += NTHR) { const int l = i / 5, hl = i % 5, h = g * 5 + hl;
            const float dt = softplus_f(bf2f(PROJ[(size_t)(T0 + l) * NP + CDT + h]) + dt_bias[h]);
            dts[i] = dt; acsS[i] = dt * (-__expf(a_log[h])); DTB[(size_t)(T0 + l) * SH + h] = dt; }
        __syncthreads();
        if (wave < 5) {
            const int hl = wave; const float a0 = acsS[(2 * lane) * 5 + hl], a1 = acsS[(2 * lane + 1) * 5 + hl];
            float s = a0 + a1;
#pragma unroll
            for (int o = 1; o < 64; o <<= 1) { const float u = __shfl_up(s, o); if (lane >= o) s += u; }
            const float e0 = s - a1;
            acsS[(2 * lane) * 5 + hl] = e0; acsS[(2 * lane + 1) * 5 + hl] = s;
            ACS[(size_t)(T0 + 2 * lane) * SH + g * 5 + hl] = e0; ACS[(size_t)(T0 + 2 * lane + 1) * SH + g * 5 + hl] = s;
            if (lane == 63) CDEC[c * SH + g * 5 + hl] = __expf(s);
        }
        __syncthreads();
        const int n = tid & 127, pq = __builtin_amdgcn_readfirstlane(tid >> 7);
        for (int hl = 0; hl < 5; ++hl) {
            if (tid < 128) wl[tid] = __expf(acsS[127 * 5 + hl] - acsS[tid * 5 + hl]) * dts[tid * 5 + hl];
            __syncthreads();
            float acc[16];
#pragma unroll
            for (int j = 0; j < 16; ++j) acc[j] = 0.f;
            for (int l = 0; l < CL; ++l) { const float bw = bf2f(Bs[l * 128 + n]) * wl[l];
                const LAS bf16* xr = xs + l * 320 + hl * 64 + pq * 16;
#pragma unroll
                for (int j = 0; j < 16; ++j) acc[j] += bw * bf2f(xr[j]); }
            float* dst = ST + (((size_t)c * SH + g * 5 + hl) * HD + pq * 16) * DSTATE + n;
#pragma unroll
            for (int j = 0; j < 16; ++j) dst[(size_t)j * DSTATE] = acc[j];
            __syncthreads();
        }
    }
}

__device__ __forceinline__ void ssd_sample(Frame& F) {
    const bf16* PROJ = WSP(bf16, WS_PROJ); bf16* MIX = WSP(bf16, WS_MIX);
    const float* state_conv = F.in[4]; const float* state_ssm = F.in[5];
    const float* conv_w = F.in[9]; const float* conv_b = F.in[10]; const float* dt_bias = F.in[11]; const float* a_log = F.in[12]; const float* d_skip = F.in[13]; const float* g_ssd = F.in[15];
    LAS float* xs = (LAS float*)F.lds;
    LAS float* Bs = xs + 1280;
    LAS float* Cs = Bs + 512;
    LAS float* dts = Cs + 512;
    LAS float* acs = dts + 20;
    LAS float* CBs = acs + 20;
    LAS float* ys = CBs + 16;
    LAS float* red = ys + 1280;
    const int tid = F.tid, lane = F.lane, wave = F.wave;
    for (int unit = blockIdx.x; unit < DB * NG; unit += F.G) {
        const int b = unit >> 2, g = unit & 3; const int r0 = SEQ + 4 * b;
        for (int cj = tid; cj < 576; cj += NTHR) {
            const int xcol = cj < 320 ? g * 320 + cj : (cj < 448 ? 1280 + g * 128 + (cj - 320) : 1792 + g * 128 + (cj - 448));
            const float w0 = conv_w[xcol], w1 = conv_w[CONVD + xcol], w2 = conv_w[2 * CONVD + xcol], w3 = conv_w[3 * CONVD + xcol], bb = conv_b[xcol];
            float xp[7];
#pragma unroll
            for (int j = 0; j < 3; ++j) xp[j] = state_conv[((size_t)b * 3 + j) * CONVD + xcol];
#pragma unroll
            for (int t = 0; t < 4; ++t) xp[3 + t] = bf2f(PROJ[(size_t)(r0 + t) * NP + CX + xcol]);
#pragma unroll
            for (int t = 0; t < 4; ++t) { const float y = silu_f(xp[t] * w0 + xp[t + 1] * w1 + xp[t + 2] * w2 + xp[t + 3] * w3 + bb);
                if (cj < 320) xs[t * 320 + cj] = y; else if (cj < 448) Bs[t * 128 + (cj - 320)] = y; else Cs[t * 128 + (cj - 448)] = y; }
#pragma unroll
            for (int j = 0; j < 3; ++j) F.out[O_CVS + ((size_t)b * 3 + j) * CONVD + xcol] = xp[4 + j];
        }
        if (tid < 20) { const int t = tid / 5, hl = tid % 5, h = g * 5 + hl; dts[tid] = softplus_f(bf2f(PROJ[(size_t)(r0 + t) * NP + CDT + h]) + dt_bias[h]); }
        __syncthreads();
        if (tid < 5) { const float a = -__expf(a_log[g * 5 + tid]); float s = 0.f;
#pragma unroll
            for (int t = 0; t < 4; ++t) { s += dts[t * 5 + tid] * a; acs[t * 5 + tid] = s; } }
        { const int pair = tid >> 5, n4 = tid & 31, t = pair >> 2, s = pair & 3; float v = 0.f;
#pragma unroll
            for (int e = 0; e < 4; ++e) v += Cs[t * 128 + 4 * n4 + e] * Bs[s * 128 + 4 * n4 + e];
            v += __shfl_xor(v, 1); v += __shfl_xor(v, 2); v += __shfl_xor(v, 4); v += __shfl_xor(v, 8); v += __shfl_xor(v, 16);
            if (n4 == 0) CBs[pair] = v; }
        __syncthreads();
        const int n4 = tid & 31, pr = tid >> 5;
        float Bv[4][4], Cv[4][4];
#pragma unroll
        for (int t = 0; t < 4; ++t)
#pragma unroll
            for (int e = 0; e < 4; ++e) { Bv[t][e] = Bs[t * 128 + 4 * n4 + e]; Cv[t][e] = Cs[t * 128 + 4 * n4 + e]; }
        for (int hl = 0; hl < 5; ++hl) {
            const int h = g * 5 + hl;
            float ac[4], dtv[4];
#pragma unroll
            for (int t = 0; t < 4; ++t) { ac[t] = acs[t * 5 + hl]; dtv[t] = dts[t * 5 + hl]; }
            const float dsk = d_skip[h];
#pragma unroll
            for (int j = 0; j < 4; ++j) {
                const int p = pr + 16 * j;
                const size_t soff = (((size_t)b * SH + h) * HD + p) * DSTATE + 4 * n4;
                const f32x4 S = *(const f32x4*)(state_ssm + soff);
                float xv[4];
#pragma unroll
                for (int t = 0; t < 4; ++t) xv[t] = xs[t * 320 + hl * 64 + p];
                f32x4 Hn = S * __expf(ac[3]);
#pragma unroll
                for (int t = 0; t < 4; ++t) { const float wgt = __expf(ac[3] - ac[t]) * dtv[t] * xv[t];
#pragma unroll
                    for (int e = 0; e < 4; ++e) Hn[e] += wgt * Bv[t][e]; }
                *(f32x4*)(F.out + O_SSS + soff) = Hn;
#pragma unroll
                for (int t = 0; t < 4; ++t) {
                    float yo = (Cv[t][0] * S[0] + Cv[t][1] * S[1]) + (Cv[t][2] * S[2] + Cv[t][3] * S[3]);
                    yo += __shfl_xor(yo, 1); yo += __shfl_xor(yo, 2); yo += __shfl_xor(yo, 4); yo += __shfl_xor(yo, 8); yo += __shfl_xor(yo, 16);
                    float y = yo * __expf(ac[t]) + dsk * xv[t];
#pragma unroll
                    for (int s = 0; s < 4; ++s) if (s <= t) y += CBs[t * 4 + s] * __expf(ac[t] - ac[s]) * dtv[s] * xv[s];
                    if (n4 == t) ys[t * 320 + hl * 64 + p] = y;
                }
            }
        }
        __syncthreads();
        float yv[4]; float part[4];
#pragma unroll
        for (int t = 0; t < 4; ++t) { yv[t] = 0.f;
            if (tid < 320) { const float z = bf2f(PROJ[(size_t)(r0 + t) * NP + CZ + g * 320 + tid]); yv[t] = ys[t * 320 + tid] * silu_f(z); }
            part[t] = wave_sum(yv[t] * yv[t]); }
        if (lane == 0) {
#pragma unroll
            for (int t = 0; t < 4; ++t) red[t * 8 + wave] = part[t]; }
        __syncthreads();
        if (tid < 320) {
#pragma unroll
            for (int t = 0; t < 4; ++t) { float ss = 0.f;
#pragma unroll
                for (int w = 0; w < 8; ++w) ss += red[t * 8 + w];
                const float rs = 1.0f / sqrtf(ss * (1.0f / 320.f) + EPS);
                MIX[(size_t)(r0 + t) * MIXW + ATTW + g * 320 + tid] = (bf16)f2bf(yv[t] * rs * g_ssd[g * 320 + tid]); } }
        __syncthreads();
    }
}

__device__ __forceinline__ void scan_and_attnorm(Frame& F) {
    float* ST = WSP(float, WS_ST); const float* CDEC = WSP(float, WS_CDEC);
    const int gt = blockIdx.x * NTHR + F.tid, NGT = F.G * NTHR;
    for (int e4 = gt; e4 < SH * HD * DSTATE / 4; e4 += NGT) {
        const int h = e4 / (HD * DSTATE / 4);
        f32x4 hcur = (f32x4){0.f, 0.f, 0.f, 0.f};
        for (int c0 = 0; c0 < NCHUNK; c0 += 8) {
            f32x4 st[8]; float dc[8];
#pragma unroll
            for (int j = 0; j < 8; ++j) { st[j] = *(const f32x4*)(ST + (size_t)(c0 + j) * (SH * HD * DSTATE) + (size_t)e4 * 4); dc[j] = CDEC[(c0 + j) * SH + h]; }
#pragma unroll
            for (int j = 0; j < 8; ++j) { *(f32x4*)(ST + (size_t)(c0 + j) * (SH * HD * DSTATE) + (size_t)e4 * 4) = hcur; hcur = hcur * dc[j] + st[j]; }
        }
        *(f32x4*)(F.out + O_SSP + (size_t)e4 * 4) = hcur;
    }
    bf16* MIX = WSP(bf16, WS_MIX); const float* ATTSS = WSP(float, WS_ATTSS); const float* g_attn = F.in[14];
    const int gw = blockIdx.x * NWAVES + F.wave, NGW = F.G * NWAVES, lane = F.lane;
    for (int row = gw; row < MTOT; row += NGW) {
        float s = lane < AH ? ATTSS[row * AH + lane] : 0.f; s = wave_sum(s);
        const float rs = 1.0f / sqrtf(s * (1.0f / ATTW) + EPS);
#pragma unroll
        for (int j = 0; j < 3; ++j) { const int col = 4 * lane + 256 * j; unsigned long long* p = (unsigned long long*)(MIX + (size_t)row * MIXW + col);
            const unsigned long long w = *p; const f32x4 gg = *(const f32x4*)(g_attn + col);
            const float v0 = bf2f((unsigned short)w) * rs * gg[0], v1 = bf2f((unsigned short)(w >> 16)) * rs * gg[1], v2 = bf2f((unsigned short)(w >> 32)) * rs * gg[2], v3 = bf2f((unsigned short)(w >> 48)) * rs * gg[3];
            *p = (unsigned long long)pk2(v0, v1) | ((unsigned long long)pk2(v2, v3) << 32); }
    }
}

__device__ __forceinline__ void ssd_phase_b(Frame& F) {
    const bf16* PROJ = WSP(bf16, WS_PROJ); const bf16* XC = WSP(bf16, WS_XC); const float* DTB = WSP(float, WS_DTB); const float* ACS = WSP(float, WS_ACS); const float* ST = WSP(float, WS_ST);
    bf16* MIX = WSP(bf16, WS_MIX); const float* d_skip = F.in[13]; const float* g_ssd = F.in[15];
    LAS float* Wm = (LAS float*)F.lds;
    LAS float* Hs = (LAS float*)(F.lds + 66048);
    LAS bf16* xh = (LAS bf16*)(F.lds + 66048 + 32768);
    LAS float* acsS = (LAS float*)(F.lds + 66048 + 32768 + 16384);
    LAS float* dtS = acsS + 128;
    LAS float* ssq = dtS + 128;
    const int tid = F.tid, lane = F.lane;
    const int l = tid & 127, pq = __builtin_amdgcn_readfirstlane(tid >> 7);
    for (int unit = blockIdx.x; unit < NCHUNK * NG; unit += F.G) {
        const int c = unit >> 2, g = unit & 3, T0 = c * CL;
        float yv[5][16];
        if (tid < 128) ssq[tid] = 0.f;
#pragma unroll
        for (int hl = 0; hl < 5; ++hl) {
            const int h = g * 5 + hl;
            __syncthreads();
            if (tid < 128) { acsS[tid] = ACS[(size_t)(T0 + tid) * SH + h]; dtS[tid] = DTB[(size_t)(T0 + tid) * SH + h]; }
            for (int i = tid; i < 64 * 128 / 4; i += NTHR) ((LAS f32x4*)Hs)[i] = *(const f32x4*)(ST + ((size_t)c * SH + h) * (HD * DSTATE) + (size_t)i * 4);
            for (int i = tid; i < 128 * 64 / 8; i += NTHR) { const int r = i >> 3, ch = i & 7; ((LAS v4u*)xh)[i] = *(const v4u*)(XC + (size_t)(T0 + r) * CONVD + h * 64 + ch * 8); }
            __syncthreads();
            for (int pair = tid; pair < 128 * 128; pair += NTHR) {
                const int ll = pair >> 7, s = pair & 127; float w = 0.f;
                if (s <= ll) { const bf16* cp = XC + (size_t)(T0 + ll) * CONVD + 1792 + g * 128; const bf16* bp = XC + (size_t)(T0 + s) * CONVD + 1280 + g * 128; float d = 0.f;
#pragma unroll 4
                    for (int k8 = 0; k8 < 16; ++k8) { const v4u cw = *(const v4u*)(cp + 8 * k8), bw = *(const v4u*)(bp + 8 * k8);
#pragma unroll
                        for (int e = 0; e < 4; ++e) { d += __uint_as_float(cw[e] << 16) * __uint_as_float(bw[e] << 16) + __uint_as_float(cw[e] & 0xffff0000u) * __uint_as_float(bw[e] & 0xffff0000u); } }
                    w = d * __expf(acsS[ll] - acsS[s]) * dtS[s]; }
                Wm[ll * 129 + s] = w; }
            __syncthreads();
            float acc[16];
#pragma unroll
            for (int j = 0; j < 16; ++j) acc[j] = 0.f;
            for (int s = 0; s < CL; ++s) { const float w = Wm[l * 129 + s]; const LAS bf16* xr = xh + s * 64 + pq * 16;
#pragma unroll
                for (int j = 0; j < 16; ++j) acc[j] += w * bf2f(xr[j]); }
            { const bf16* cp = XC + (size_t)(T0 + l) * CONVD + 1792 + g * 128; const float ea = __expf(acsS[l]);
                float off[16];
#pragma unroll
                for (int j = 0; j < 16; ++j) off[j] = 0.f;
                for (int k8 = 0; k8 < 16; ++k8) { const v4u cw = *(const v4u*)(cp + 8 * k8); float cf[8];
#pragma unroll
                    for (int e = 0; e < 4; ++e) { cf[2 * e] = __uint_as_float(cw[e] << 16); cf[2 * e + 1] = __uint_as_float(cw[e] & 0xffff0000u); }
#pragma unroll
                    for (int j = 0; j < 16; ++j) { const LAS float* hr = Hs + (pq * 16 + j) * 128 + 8 * k8;
#pragma unroll
                        for (int e = 0; e < 8; ++e) off[j] += cf[e] * hr[e]; } }
#pragma unroll
                for (int j = 0; j < 16; ++j) acc[j] += ea * off[j]; }
            { const float dsk = d_skip[h]; const LAS bf16* xr = xh + l * 64 + pq * 16; const bf16* zp = PROJ + (size_t)(T0 + l) * NP + CZ + h * 64 + pq * 16; float sq = 0.f;
#pragma unroll
                for (int j = 0; j < 16; ++j) { const float y = (acc[j] + dsk * bf2f(xr[j])) * silu_f(bf2f(zp[j])); yv[hl][j] = y; sq += y * y; }
                __hip_atomic_fetch_add(&ssq[l], sq, __ATOMIC_RELAXED, __HIP_MEMORY_SCOPE_WORKGROUP); }
        }
        __syncthreads();
        const float rs = 1.0f / sqrtf(ssq[l] * (1.0f / 320.f) + EPS);
#pragma unroll
        for (int hl = 0; hl < 5; ++hl) { const int col = (g * 5 + hl) * 64 + pq * 16; bf16* mp = MIX + (size_t)(T0 + l) * MIXW + ATTW + col;
            v4u w0, w1;
            w0.x = pk2(yv[hl][0] * rs * g_ssd[col + 0], yv[hl][1] * rs * g_ssd[col + 1]); w0.y = pk2(yv[hl][2] * rs * g_ssd[col + 2], yv[hl][3] * rs * g_ssd[col + 3]);
            w0.z = pk2(yv[hl][4] * rs * g_ssd[col + 4], yv[hl][5] * rs * g_ssd[col + 5]); w0.w = pk2(yv[hl][6] * rs * g_ssd[col + 6], yv[hl][7] * rs * g_ssd[col + 7]);
            w1.x = pk2(yv[hl][8] * rs * g_ssd[col + 8], yv[hl][9] * rs * g_ssd[col + 9]); w1.y = pk2(yv[hl][10] * rs * g_ssd[col + 10], yv[hl][11] * rs * g_ssd[col + 11]);
            w1.z = pk2(yv[hl][12] * rs * g_ssd[col + 12], yv[hl][13] * rs * g_ssd[col + 13]); w1.w = pk2(yv[hl][14] * rs * g_ssd[col + 14], yv[hl][15] * rs * g_ssd[col + 15]);
            *(v4u*)mp = w0; *(v4u*)(mp + 8) = w1; }
        __syncthreads();
    }
}

__device__ __forceinline__ void final_norm(Frame& F) {
    const float* SS3 = (const float*)(F.ws + CTL_SS3); const float* gf = F.in[21];
    const int gw = blockIdx.x * NWAVES + F.wave, NGW = F.G * NWAVES, lane = F.lane;
    for (int row = gw; row < MTOT; row += NGW) {
        const float rs = 1.0f / sqrtf(SS3[row] * (1.0f / DM) + EPS);
        f32x4* yr = (f32x4*)(F.out + (size_t)row * DM) + lane;
#pragma unroll
        for (int j = 0; j < 4; ++j) { const f32x4 gg = *((const f32x4*)gf + lane + 64 * j); yr[64 * j] = yr[64 * j] * rs * gg; }
    }
}

#ifndef MK_N_LAUNCHES
#define MK_N_LAUNCHES 1
#endif
constexpr int N_PHASES = 9;
struct Args { const float* in[22]; float* out; unsigned char* ws; int ph_lo, ph_hi; };
__global__ void __launch_bounds__(NTHR, 2) fwd(Args args) {
    extern __shared__ __attribute__((aligned(16))) unsigned char lds[];
    Frame F;
    F.lds = (LAS unsigned char*)lds;
    F.tid = threadIdx.x; F.lane = F.tid & 63; F.wave = __builtin_amdgcn_readfirstlane(F.tid >> 6); F.G = gridDim.x;
#pragma unroll
    for (int i = 0; i < 22; ++i) F.in[i] = args.in[i];
    F.out = args.out; F.ws = args.ws;
    volatile LAS unsigned* MISC = (volatile LAS unsigned*)(F.lds + MISC_OFF);
    if (F.tid < 64) MISC[F.tid] = 0u;
    __syncthreads();
    unsigned* barw = (unsigned*)(F.ws + WS_CTL) + CW_BAR;
    XcdBarrier bar; bar.bar = barw; bar.x = 0; bar.st = nullptr;
    if (MK_N_LAUNCHES == 1) bar = xcd_barrier_post(barw, MISC + 8);
    const int lo = args.ph_lo, hi = args.ph_hi;
#define IN(k) (lo <= (k) && (k) < hi)
#define SEAM(k) do { if (IN(k) && IN((k) + 1)) xcd_barrier(bar); } while (0)

    if (IN(0)) { p0_prologue(F); __syncthreads(); }
    SEAM(0);
    if (IN(1)) {
        pg8::Gemm g{WSP(const pg8::bf16_t, WS_XB), WSP(const pg8::bf16_t, WS_WIN), MTOT, NP, DM}; pg8::StaticOrder S; S.init(MTOT, NP, F.G, (int)blockIdx.x);
        EpiProj E{WSP(bf16, WS_PROJ), WSP(const float, WS_RS1), F.out};
        pg8::gemm_phase<EpiProj, pg8::StaticOrder, true, true>(F.lds, g, S, E);
    }
    SEAM(1);
    if (IN(2)) { attn_sample(F); __syncthreads(); ssd_sample(F); __syncthreads(); ssd_phase_a(F); __syncthreads(); attn_prompt_simple(F); }
    SEAM(2);
    if (IN(3)) { scan_and_attnorm(F); }
    SEAM(3);
    if (IN(4)) { ssd_phase_b(F); }
    SEAM(4);
    if (IN(5)) {
        pg8::Gemm g{WSP(const pg8::bf16_t, WS_MIX), WSP(const pg8::bf16_t, WS_WOUT), MTOT, DM, MIXW}; pg8::StaticOrder S; S.init(MTOT, DM, F.G, (int)blockIdx.x);
        EpiOut E{F.in[0], F.in[1], WSP(float, WS_X1), WSP(bf16, WS_X1B), (float*)(F.ws + CTL_SS2)};
        pg8::gemm_phase<EpiOut, pg8::StaticOrder, true, true>(F.lds, g, S, E);
    }
    SEAM(5);
    if (IN(6)) {
        pg8::Gemm g{WSP(const pg8::bf16_t, WS_X1B), WSP(const pg8::bf16_t, WS_WGU), MTOT, 2 * DFF, DM}; pg8::StaticOrder S; S.init(MTOT, 2 * DFF, F.G, (int)blockIdx.x);
        EpiGU E{WSP(bf16, WS_ACT), (const float*)(F.ws + CTL_SS2)};
        pg8::gemm_phase<EpiGU, pg8::StaticOrder, true, true>(F.lds, g, S, E);
    }
    SEAM(6);
    if (IN(7)) {
        pg8::Gemm g{WSP(const pg8::bf16_t, WS_ACT), WSP(const pg8::bf16_t, WS_WDN), MTOT, DM, DFF}; pg8::StaticOrder S; S.init(MTOT, DM, F.G, (int)blockIdx.x);
        EpiDown E{WSP(const float, WS_X1), F.out, (float*)(F.ws + CTL_SS3)};
        pg8::gemm_phase<EpiDown, pg8::StaticOrder, true, true>(F.lds, g, S, E);
    }
    SEAM(7);
    if (IN(8)) { final_norm(F); }
#undef IN
#undef SEAM
}

extern "C" void kernel_launch(void* const* d_in, const int* in_sizes, int n_in, void* d_out, int out_size, void* d_ws, size_t ws_size, hipStream_t stream) {
    static int grid = 0;
    if (grid == 0) {
        if (n_in != 22 || (size_t)out_size != O_END || ws_size < WS_END) fprintf(stderr, "kernel_launch: unexpected shapes (n_in %d, out %d, ws %zu)\n", n_in, out_size, ws_size);
        int dev = 0, cus = 0, per_cu = 0;
        if (hipGetDevice(&dev) != hipSuccess || hipDeviceGetAttribute(&cus, hipDeviceAttributeMultiprocessorCount, dev) != hipSuccess) { grid = -1; return; }
        if (hipFuncSetAttribute((const void*)fwd, hipFuncAttributeMaxDynamicSharedMemorySize, LDS_BYTES) != hipSuccess) { fprintf(stderr, "kernel_launch: hipFuncSetAttribute failed\n"); grid = -1; return; }
        if (hipOccupancyMaxActiveBlocksPerMultiprocessor(&per_cu, (const void*)fwd, NTHR, LDS_BYTES) != hipSuccess || per_cu < 1) fprintf(stderr, "kernel_launch: occupancy query says %d\n", per_cu);
        (void)hipGetLastError();
        grid = cus;
    }
    if (grid < 0) return;
    if (hipMemsetAsync((char*)d_ws + WS_CTL, 0, CTL_ZERO_BYTES, stream) != hipSuccess) return;
    Args a{};
    for (int i = 0; i < 22; ++i) a.in[i] = (const float*)d_in[i];
    a.out = (float*)d_out; a.ws = (unsigned char*)d_ws;
    if (MK_N_LAUNCHES == 1) { a.ph_lo = 0; a.ph_hi = N_PHASES; hipLaunchKernelGGL(fwd, dim3(grid), dim3(NTHR), LDS_BYTES, stream, a); }
    else { for (int p = 0; p < N_PHASES; ++p) { a.ph_lo = p; a.ph_hi = p + 1; hipLaunchKernelGGL(fwd, dim3(grid), dim3(NTHR), LDS_BYTES, stream, a); } }
}
```

```cpp
#include <hip/hip_runtime.h>
#include <cstdio>
#include <cstdint>
namespace pg8 {
#define PG8_LAS __attribute__((address_space(3)))
typedef unsigned short bf16_t;
typedef short bf16x8 __attribute__((ext_vector_type(8)));
typedef float f32x4 __attribute__((ext_vector_type(4)));
typedef unsigned u32x4 __attribute__((ext_vector_type(4)));
constexpr int BM = 256, BK = 64, HALF = 128, HTB = HALF * BK * 2  , STAGE_BYTES = 8 * HTB, NXCD = 8, WGM = 8;

__host__ __device__ __forceinline__ int lds_byte(int r, int c) { const int st = (r >> 4) * 2 + (c >> 5), rr = r & 15, cc = c & 31, ob = rr * 64 + cc * 2; return st * 1024 + (ob ^ (((ob >> 9) & 1) << 5)); }
__host__ __device__ __forceinline__ void stage_rc(int b, int& R, int& C) { const int st = b / 1024, sb = b % 1024, swz = sb ^ (((sb >> 9) & 1) << 5); R = (st >> 1) * 16 + swz / 64; C = (st & 1) * 32 + (swz % 64) / 2; }
__host__ __device__ __forceinline__ int perm32(int rho) { const int n = rho >> 4, i = rho & 15; return 8 * (i >> 2) + 4 * n + (i & 3); }

struct Unit { int pm, pn; };
struct Gemm { const bf16_t* A; const bf16_t* Bt; int M, N, K; };

struct StaticOrder {
    int nM, nN, nwg, G, c;
    __host__ __device__ void init(int M, int N, int G_, int c_) { nM = M / BM; nN = N / BM; nwg = nM * nN; G = G_; c = c_; }
    __host__ __device__ bool next(int i, Unit& u) const {
        const long L = (long)i * G + c; if (L >= nwg) return false;
        int wgid = (int)L; { const int q = nwg / NXCD, r = nwg % NXCD, xcd = wgid % NXCD, off = wgid / NXCD; wgid = (xcd < r ? xcd * (q + 1) : r * (q + 1) + (xcd - r) * q) + off; }
        const int nig = WGM * nN, gid = wgid / nig, fm = gid * WGM, gsz = (nM - fm) < WGM ? (nM - fm) : WGM;
        u.pm = fm + ((wgid % nig) % gsz); u.pn = (wgid % nig) / gsz; return true;
    }
    __device__ __forceinline__ void a_ready(const Unit&) const {}
    __device__ __forceinline__ void done(const Unit&) const {}
};

__device__ __forceinline__ unsigned cvt_pk_bf16(float lo, float hi) { unsigned r; asm volatile("v_cvt_pk_bf16_f32 %0, %1, %2" : "=v"(r) : "v"(lo), "v"(hi)); return r; }
typedef float f32x2 __attribute__((ext_vector_type(2)));

template <class Epi, class Sched, bool ALIGN_EPI = false, bool SP2 = false>
__device__ __forceinline__ void gemm_phase(PG8_LAS unsigned char* lds, const Gemm g, const Sched& S, const Epi& E) {
    const int tid = threadIdx.x, wid = __builtin_amdgcn_readfirstlane(tid >> 6), lane = tid & 63, wr = wid >> 2, wc = wid & 3, fr = lane & 15, fq = lane >> 4;
    const int K = g.K, nt = K / BK;
    unsigned voffA[2], voffB[2];
#pragma unroll
    for (int i = 0; i < 2; ++i) { int R, C; stage_rc(tid * 16 + i * 8192, R, C); const int Rb = Epi::PERM ? ((R & ~31) + perm32(R & 31)) : R;
        voffA[i] = (unsigned)(R * K + C) * 2u; voffB[i] = (unsigned)(Rb * K + C) * 2u; }
    const size_t kstep = (size_t)(BK * 2);
    const size_t hstep = (size_t)HALF * K * 2;
    const size_t tstep = 2 * hstep;
    const unsigned ldsw = (unsigned)wid * 1024u;
    const int aoff = lds_byte(wr * 64 + fr, fq * 8), boff = lds_byte(wc * 32 + fr, fq * 8);
#define PG8_SA(b, h) (((b) * 2 + (h)) * HTB)
#define PG8_SB(b, h) ((4 + (b) * 2 + (h)) * HTB)
#define PG8_STAGE(bufoff, gbase, voff) do { _Pragma("unroll") for (int _i = 0; _i < 2; ++_i) \
        __builtin_amdgcn_global_load_lds((const unsigned*)((const char*)(gbase) + (voff)[_i]), (PG8_LAS unsigned*)(lds + (bufoff) + ldsw + _i * 8192), 16, 0, 0); } while (0)
#define PG8_LDA(dst, b, h) do { _Pragma("unroll") for (int m = 0; m < 4; ++m) _Pragma("unroll") for (int k = 0; k < 2; ++k) dst[m][k] = *(const PG8_LAS bf16x8*)(lds + PG8_SA(b, h) + aoff + m * 2048 + k * 1024); } while (0)
#define PG8_LDB(dst, b, h) do { _Pragma("unroll") for (int n = 0; n < 2; ++n) _Pragma("unroll") for (int k = 0; k < 2; ++k) dst[n][k] = *(const PG8_LAS bf16x8*)(lds + PG8_SB(b, h) + boff + n * 2048 + k * 1024); } while (0)
#define PG8_MMA(ai, bj, At, Bt) do { __builtin_amdgcn_s_setprio(1); _Pragma("unroll") for (int m = 0; m < 4; ++m) _Pragma("unroll") for (int n = 0; n < 2; ++n) _Pragma("unroll") for (int k = 0; k < 2; ++k) \
        acc[ai][bj][m][n] = __builtin_amdgcn_mfma_f32_16x16x32_bf16(Bt[n][k], At[m][k], acc[ai][bj][m][n], 0, 0, 0); __builtin_amdgcn_s_setprio(0); } while (0)
#define PG8_WAIT_V(n) asm volatile("s_waitcnt vmcnt(" #n ")" ::: "memory")
#define PG8_WAIT_L(n) asm volatile("s_waitcnt lgkmcnt(" #n ")" ::: "memory")
#define PG8_BAR __builtin_amdgcn_s_barrier()
#define PG8_SCHED __builtin_amdgcn_sched_barrier(0)
    Unit cur, nxt; int ui = 0;
    if (!S.next(0, cur)) return;
    f32x4 acc[2][2][4][2];
#pragma unroll
    for (int a = 0; a < 2; ++a)
#pragma unroll
        for (int b = 0; b < 2; ++b)
#pragma unroll
            for (int m = 0; m < 4; ++m)
#pragma unroll
                for (int n = 0; n < 2; ++n) acc[a][b][m][n] = (f32x4){0.f, 0.f, 0.f, 0.f};
    bf16x8 At[4][2], B0[2][2], B1[2][2];
    const char* cA = (const char*)g.A + (size_t)cur.pm * tstep; const char* cB = (const char*)g.Bt + (size_t)cur.pn * tstep;
    S.a_ready(cur);
    if constexpr (SP2) {
        PG8_STAGE(PG8_SB(0, 0), cB, voffB); PG8_STAGE(PG8_SB(0, 1), cB + hstep, voffB); PG8_STAGE(PG8_SA(0, 0), cA, voffA); PG8_STAGE(PG8_SA(0, 1), cA + hstep, voffA);
        if (wr == 1) PG8_BAR;
        PG8_WAIT_V(2); PG8_BAR;
        PG8_STAGE(PG8_SB(1, 0), cB + kstep, voffB); PG8_STAGE(PG8_SA(1, 0), cA + kstep, voffA); PG8_STAGE(PG8_SB(1, 1), cB + hstep + kstep, voffB);
        PG8_WAIT_V(6); PG8_BAR;
    } else {
        PG8_STAGE(PG8_SB(0, 0), cB, voffB); PG8_STAGE(PG8_SA(0, 0), cA, voffA); PG8_STAGE(PG8_SB(0, 1), cB + hstep, voffB); PG8_STAGE(PG8_SA(0, 1), cA + hstep, voffA);
        if (wr == 1) PG8_BAR;
        PG8_WAIT_V(4); PG8_BAR;
        PG8_STAGE(PG8_SB(1, 0), cB + kstep, voffB); PG8_STAGE(PG8_SA(1, 0), cA + kstep, voffA); PG8_STAGE(PG8_SB(1, 1), cB + hstep + kstep, voffB);
        PG8_WAIT_V(6); PG8_BAR;
    }
    for (;;) {
        const bool has_next = S.next(ui + 1, nxt);
        const char* nA = has_next ? (const char*)g.A + (size_t)nxt.pm * tstep : cA; const char* nB = has_next ? (const char*)g.Bt + (size_t)nxt.pn * tstep : cB;
        for (int t = 0; t < nt; t += 2) {
            const bool last = (t == nt - 2);
            const char* a1 = cA + (size_t)(t + 1) * kstep;
            const char* a2 = last ? nA : cA + (size_t)(t + 2) * kstep; const char* b2 = last ? nB : cB + (size_t)(t + 2) * kstep;
            const char* a3 = a2 + kstep; const char* b3 = b2 + kstep;
            if (last && has_next) S.a_ready(nxt);
            if constexpr (SP2) {
            PG8_LDB(B0, 0, 0); PG8_LDB(B1, 0, 1); PG8_SCHED; PG8_LDA(At, 0, 0); PG8_STAGE(PG8_SA(1, 1), a1 + hstep, voffA);
            PG8_WAIT_V(8); PG8_WAIT_L(0); PG8_BAR; PG8_MMA(0, 0, At, B0); PG8_MMA(0, 1, At, B1); PG8_BAR; PG8_SCHED;
            PG8_LDA(At, 0, 1); PG8_STAGE(PG8_SB(0, 0), b2, voffB); PG8_STAGE(PG8_SB(0, 1), b2 + hstep, voffB); PG8_STAGE(PG8_SA(0, 0), a2, voffA);
            PG8_WAIT_V(8); PG8_WAIT_L(0); PG8_BAR; PG8_MMA(1, 0, At, B0); PG8_MMA(1, 1, At, B1); PG8_BAR; PG8_SCHED;
            PG8_LDB(B0, 1, 0); PG8_LDB(B1, 1, 1); PG8_SCHED; PG8_LDA(At, 1, 0); PG8_STAGE(PG8_SA(0, 1), a2 + hstep, voffA);
            PG8_WAIT_V(8); PG8_WAIT_L(0); PG8_BAR; PG8_MMA(0, 0, At, B0); PG8_MMA(0, 1, At, B1); PG8_BAR; PG8_SCHED;
            PG8_LDA(At, 1, 1); PG8_STAGE(PG8_SB(1, 0), b3, voffB); PG8_STAGE(PG8_SB(1, 1), b3 + hstep, voffB); PG8_STAGE(PG8_SA(1, 0), a3, voffA);
            PG8_WAIT_V(8); PG8_WAIT_L(0); PG8_BAR; PG8_MMA(1, 0, At, B0); PG8_MMA(1, 1, At, B1); PG8_BAR; PG8_SCHED;
            } else {
            PG8_LDB(B0, 0, 0); PG8_SCHED; PG8_LDA(At, 0, 0); PG8_STAGE(PG8_SA(1, 1), a1 + hstep, voffA);
            PG8_WAIT_L(8); PG8_BAR; PG8_WAIT_L(0); PG8_MMA(0, 0, At, B0); PG8_BAR; PG8_SCHED;
            PG8_LDB(B1, 0, 1); PG8_STAGE(PG8_SB(0, 0), b2, voffB);
            PG8_BAR; PG8_WAIT_L(0); PG8_MMA(0, 1, At, B1); PG8_BAR;
            PG8_LDA(At, 0, 1); PG8_STAGE(PG8_SA(0, 0), a2, voffA);
            PG8_BAR; PG8_WAIT_L(0); PG8_MMA(1, 0, At, B0); PG8_BAR; PG8_SCHED;
            PG8_STAGE(PG8_SB(0, 1), b2 + hstep, voffB);
            PG8_WAIT_V(6); PG8_BAR; PG8_MMA(1, 1, At, B1); PG8_BAR;
            PG8_LDB(B0, 1, 0); PG8_SCHED; PG8_LDA(At, 1, 0); PG8_STAGE(PG8_SA(0, 1), a2 + hstep, voffA);
            PG8_WAIT_L(8); PG8_BAR; PG8_WAIT_L(0); PG8_MMA(0, 0, At, B0); PG8_BAR; PG8_SCHED;
            PG8_LDB(B1, 1, 1); PG8_STAGE(PG8_SB(1, 0), b3, voffB);
            PG8_BAR; PG8_WAIT_L(0); PG8_MMA(0, 1, At, B1); PG8_BAR;
            PG8_LDA(At, 1, 1); PG8_STAGE(PG8_SA(1, 0), a3, voffA);
            PG8_BAR; PG8_WAIT_L(0); PG8_MMA(1, 0, At, B0); PG8_BAR; PG8_SCHED;
            PG8_STAGE(PG8_SB(1, 1), b3 + hstep, voffB);
            PG8_WAIT_V(6); PG8_BAR; PG8_MMA(1, 1, At, B1); PG8_BAR;
            }
        }
        if constexpr (ALIGN_EPI) { if (wr == 0) PG8_BAR; }
        if constexpr (!Epi::AFTER_DRAIN) { E(acc, cur, wr, wc, fr, fq); S.done(cur); }
        if (!has_next) break;
#pragma unroll
        for (int a = 0; a < 2; ++a)
#pragma unroll
            for (int b = 0; b < 2; ++b)
#pragma unroll
                for (int m = 0; m < 4; ++m)
#pragma unroll
                    for (int n = 0; n < 2; ++n) acc[a][b][m][n] = (f32x4){0.f, 0.f, 0.f, 0.f};
        cur = nxt; cA = nA; cB = nB; ++ui;
        if constexpr (ALIGN_EPI) { if (wr == 1) PG8_BAR; }
    }
    PG8_WAIT_V(0);
    if constexpr (!ALIGN_EPI) { if (wr == 0) PG8_BAR; }
    PG8_BAR;
    if constexpr (Epi::AFTER_DRAIN) { E.fused(acc, cur, wr, wc, fr, fq, lds, wid, lane); S.done(cur); }
#undef PG8_SA
#undef PG8_SB
#undef PG8_STAGE
#undef PG8_LDA
#undef PG8_LDB
#undef PG8_MMA
#undef PG8_WAIT_V
#undef PG8_WAIT_L
#undef PG8_BAR
#undef PG8_SCHED
}
}

constexpr int NWAVES = 8, NTHR = 512;
constexpr int DM = 1024, SEQ = 16384, DB = 128, DSEQ = 4, NSAMP = DB * DSEQ, MTOT = SEQ + NSAMP;
constexpr int AH = 12, HD = 64, ATTW = 768, SH = 20, SSW = 1280, NG = 4, DSTATE = 128, CONVD = 2304, MIXW = 2048, DFF = 2816, DINP = 5908;
constexpr int NP = 6144;
constexpr int CQ = 0, CK = 768, CV = 1536, CZ = 2304, CX = 3584, CDT = 5888;
constexpr int WB = 2048;
constexpr int NCHUNK = 128, CL = 128;
constexpr float EPS = 1e-6f;
constexpr size_t O_YP = 0, O_YS = O_YP + (size_t)SEQ * DM, O_WKP = O_YS + (size_t)NSAMP * DM, O_WVP = O_WKP + (size_t)2048 * ATTW, O_CVP = O_WVP + (size_t)2048 * ATTW,
                 O_SSP = O_CVP + 3 * CONVD, O_WKS = O_SSP + (size_t)SH * HD * DSTATE, O_WVS = O_WKS + (size_t)NSAMP * ATTW, O_CVS = O_WVS + (size_t)NSAMP * ATTW,
                 O_SSS = O_CVS + (size_t)DB * 3 * CONVD, O_END = O_SSS + (size_t)DB * SH * HD * DSTATE;
constexpr size_t MiB = 1u << 20;
constexpr size_t WS_CTL = 0, CTL_ZERO_BYTES = 1 * MiB;
constexpr size_t CTL_SS2 = 256 * 1024, CTL_SS3 = 384 * 1024;
constexpr size_t WS_WIN = 2 * MiB;
constexpr size_t WS_WOUT = WS_WIN + (size_t)NP * DM * 2;
constexpr size_t WS_WGU = WS_WOUT + (size_t)DM * MIXW * 2;
constexpr size_t WS_WDN = WS_WGU + (size_t)2 * DFF * DM * 2;
constexpr size_t WS_BKT = WS_WDN + (size_t)DM * DFF * 2;
constexpr size_t WS_RS1 = WS_BKT + 16384;
constexpr size_t WS_ATTSS = WS_RS1 + (size_t)MTOT * 4;
constexpr size_t WS_DTB = WS_ATTSS + (size_t)MTOT * 12 * 4;
constexpr size_t WS_ACS = WS_DTB + (size_t)SEQ * 20 * 4;
constexpr size_t WS_CDEC = WS_ACS + (size_t)SEQ * 20 * 4;
constexpr size_t WS_XB = 64 * MiB;
constexpr size_t WS_PROJ = WS_XB + (size_t)MTOT * DM * 2;
constexpr size_t WS_MIX = WS_PROJ + (size_t)MTOT * NP * 2;
constexpr size_t WS_X1 = WS_MIX + (size_t)MTOT * MIXW * 2;
constexpr size_t WS_X1B = WS_X1 + (size_t)MTOT * DM * 4;
constexpr size_t WS_ACT = WS_X1B + (size_t)MTOT * DM * 2;
constexpr size_t WS_XC = WS_ACT + (size_t)MTOT * DFF * 2;
constexpr size_t WS_ST = WS_XC + (size_t)SEQ * CONVD * 2;
constexpr size_t WS_OPART = WS_ST + (size_t)NCHUNK * SH * HD * DSTATE * 4;
constexpr size_t WS_ML = WS_OPART + (size_t)3 * SEQ * ATTW * 2;
constexpr size_t WS_END = WS_ML + (size_t)3 * SEQ * AH * 2 * 4;
static_assert(WS_CDEC + 128 * 20 * 4 <= WS_XB, "ws map");
constexpr int CW_BAR = 1024;
constexpr int RING_BYTES = 131072;
constexpr int MISC_OFF = 147456;
constexpr int LDS_BYTES = 147456 + 256;

#define GAS __attribute__((address_space(1)))
#define LAS __attribute__((address_space(3)))
typedef unsigned short bf16;
typedef unsigned v4u __attribute__((ext_vector_type(4)));
typedef float f32x4 __attribute__((ext_vector_type(4)));
typedef short bf16x8 __attribute__((ext_vector_type(8)));
typedef GAS unsigned gu32;
typedef GAS unsigned long long gu64;
#define RLX_AGENT __ATOMIC_RELAXED, __HIP_MEMORY_SCOPE_AGENT
#define LDS_WAIT() asm volatile("s_waitcnt lgkmcnt(0)" ::: "memory")
#define VM_WAIT() asm volatile("s_waitcnt vmcnt(0)" ::: "memory")
__device__ __forceinline__ unsigned long long rt() { return __builtin_amdgcn_s_memrealtime(); }
__device__ __forceinline__ unsigned f2bf(float f) { unsigned u = __builtin_bit_cast(unsigned, f); return (u + 0x7fffu + ((u >> 16) & 1u)) >> 16; }
__device__ __forceinline__ unsigned pk2(float lo, float hi) { return f2bf(lo) | (f2bf(hi) << 16); }

#define XB_TMO      128
#define XB_XCNT(j)  (256  + 64 * (j))
#define XB_XSUB(j)  (1280 + 64 * (j))
#define XB_XGEN(j)  (2304 + 64 * (j))
#define XB_TOP      3328
#define XB_TOPGEN   3392
#define XCD_BAR_WORDS 3456
#define XB_SPIN_CAP (1u << 23)

__device__ __forceinline__ unsigned xb_ld(unsigned* p)              { return __hip_atomic_load(p, __ATOMIC_RELAXED, __HIP_MEMORY_SCOPE_AGENT); }
__device__ __forceinline__ unsigned xb_add(unsigned* p, unsigned v) { return __hip_atomic_fetch_add(p, v, __ATOMIC_RELAXED, __HIP_MEMORY_SCOPE_AGENT); }
__device__ __forceinline__ unsigned xb_xcc_id() { return (unsigned)__builtin_amdgcn_s_getreg((3 << 11) | 20) & 0xFu; }
#define XB_SPIN(cond, bar) do { unsigned _sp = 0; while (cond) { __builtin_amdgcn_s_sleep(1); \
    if ((++_sp & 255u) == 0u) { if (xb_ld(&(bar)[XB_TMO])) break; if (_sp > XB_SPIN_CAP) { atomicAdd(&(bar)[XB_TMO], 1u); break; } } } } while (0)

struct XcdBarrier {
    unsigned* bar; unsigned x;
    volatile LAS unsigned* st;
};

__device__ __forceinline__ XcdBarrier xcd_barrier_post(unsigned* bar, volatile LAS unsigned* st) {
    XcdBarrier b; b.bar = bar; b.x = xb_xcc_id(); b.st = st;
    if (threadIdx.x == 0) (void)xb_add(&bar[XB_XCNT(b.x)], 1u);
    return b;
}
__device__ __forceinline__ void xcd_barrier_complete(unsigned* bar, unsigned x, unsigned& nloc, unsigned& nx) {
    const unsigned G = gridDim.x * gridDim.y * gridDim.z;
    unsigned sum, cnt, mine, sp = 0u;
    for (;;) {
        sum = 0u; cnt = 0u; mine = 0u;
#pragma unroll
        for (unsigned j = 0; j < 16; ++j) { const unsigned c = xb_ld(&bar[XB_XCNT(j)]); sum += c; cnt += (c > 0u) ? 1u : 0u; mine = (j == x) ? c : mine; }
        if (sum == G) break;
        __builtin_amdgcn_s_sleep(1);
        if ((++sp & 255u) == 0u) { if (xb_ld(&bar[XB_TMO])) break; if (sp > XB_SPIN_CAP) { atomicAdd(&bar[XB_TMO], 1u); break; } }
    }
    nloc = mine > 0u ? mine : 1u; nx = cnt > 0u ? cnt : 1u;
}

__device__ __forceinline__ void xcd_barrier(const XcdBarrier& b) {
    asm volatile("s_waitcnt vmcnt(0)" ::: "memory");
    __syncthreads();
    if (threadIdx.x == 0) {
        unsigned* bar = b.bar;
        __builtin_amdgcn_s_waitcnt(0);
        unsigned nloc = b.st[0], nx = b.st[1];
        if (nloc == 0u) { xcd_barrier_complete(bar, b.x, nloc, nx); b.st[0] = nloc; b.st[1] = nx; }
        const unsigned old = xb_add(&bar[XB_XSUB(b.x)], 1u);
        const unsigned gen = old / nloc;
        if (old + 1u == (gen + 1u) * nloc) {
            __builtin_amdgcn_fence(__ATOMIC_RELEASE, "agent");
            asm volatile("s_waitcnt vmcnt(0)" ::: "memory");
            const unsigned og = xb_add(&bar[XB_TOP], 1u);
            const unsigned tg = og / nx;
            if (og + 1u == (tg + 1u) * nx) xb_add(&bar[XB_TOPGEN], 1u);
            else XB_SPIN(xb_ld(&bar[XB_TOPGEN]) == tg, bar);
            __builtin_amdgcn_fence(__ATOMIC_ACQUIRE, "agent");
            xb_add(&bar[XB_XGEN(b.x)], 1u);
            asm volatile("s_waitcnt vmcnt(0)" ::: "memory");
        } else {
            XB_SPIN(xb_ld(&bar[XB_XGEN(b.x)]) == gen, bar);
            __builtin_amdgcn_fence(__ATOMIC_ACQUIRE, "agent");
            asm volatile("s_waitcnt vmcnt(0)" ::: "memory");
        }
    }
    __syncthreads();
}

__device__ __forceinline__ float bf2f(unsigned short u) { return __uint_as_float((unsigned)u << 16); }
__device__ __forceinline__ float wave_sum(float v) {
#pragma unroll
    for (int o = 1; o < 64; o <<= 1) v += __shfl_xor(v, o);
    return v;
}
__device__ __forceinline__ float silu_f(float x) { return x / (1.f + __expf(-x)); }
__device__ __forceinline__ float softplus_f(float x) { return x > 20.f ? x : log1pf(__expf(x)); }
__device__ __forceinline__ int rel_bucket(int n) {
    if (n < 16) return n;
    const float v = logf((float)n / 16.0f) / 4.852030263919617f * 16.0f;
    int b = 16 + (int)v; return b > 31 ? 31 : b;
}
__device__ __forceinline__ int attn_mult(int delta) {
    return (delta <= 128 ? 1 : 0) + (((delta & 3) == 0 && delta <= 512) ? 1 : 0) + (((delta & 15) == 0 && delta <= 2048) ? 1 : 0);
}

struct Frame {
    LAS unsigned char* lds;
    int tid, lane, wave, G;
    const float* in[22]; float* out; unsigned char* ws;
};
#define WSP(T, off) ((T*)(F.ws + (off)))

template <int MODE>
__device__ __forceinline__ void tr_item(const float* W, int K, int N, const float* gain, bf16* WT, LAS float* scr, int kb, int nb, int lane) {
    const int k0 = 64 * kb, n0 = 32 * nb;
    {
        const int n = n0 + (lane & 31);
#pragma unroll 8
        for (int i = 0; i < 32; ++i) { const int kk = 2 * i + (lane >> 5); float v = (n < N) ? W[(size_t)(k0 + kk) * N + n] : 0.f; if (gain) v *= gain[k0 + kk]; scr[kk * 33 + (lane & 31)] = v; }
    }
    LDS_WAIT(); asm volatile("" ::: "memory");
    const int c = lane & 7;
#pragma unroll
    for (int j = 0; j < 4; ++j) { const int nl = (lane >> 3) + 8 * j, n = n0 + nl; const LAS float* s = scr + (8 * c) * 33 + nl;
        v4u o; o.x = pk2(s[0 * 33], s[1 * 33]); o.y = pk2(s[2 * 33], s[3 * 33]); o.z = pk2(s[4 * 33], s[5 * 33]); o.w = pk2(s[6 * 33], s[7 * 33]);
        int drow = n; if (MODE == 1) drow = (n >> 7) * 256 + (n & 127); if (MODE == 2) drow = (n >> 7) * 256 + 128 + (n & 127);
        *(GAS v4u*)(WT + (size_t)drow * K + k0 + 8 * c) = o; }
    LDS_WAIT(); asm volatile("" ::: "memory");
}
__device__ __forceinline__ void p0_prologue(Frame& F) {
    LAS float* scr = (LAS float*)(F.lds + F.wave * 16384);
    const int gw = blockIdx.x * NWAVES + F.wave, NGW = F.G * NWAVES;
    constexpr int I_IN = 16 * 192, I_OUT = 32 * 32, I_G = 16 * 88, I_D = 44 * 32;
    constexpr int NITEMS = I_IN + I_OUT + 2 * I_G + I_D;
    for (int it = gw; it < NITEMS; it += NGW) {
        int r = it;
        if (r < I_IN) { tr_item<0>(F.in[8], DM, DINP, F.in[7], WSP(bf16, WS_WIN), scr, r / 192, r % 192, F.lane); continue; } r -= I_IN;
        if (r < I_OUT) { tr_item<0>(F.in[16], MIXW, DM, nullptr, WSP(bf16, WS_WOUT), scr, r / 32, r % 32, F.lane); continue; } r -= I_OUT;
        if (r < I_G) { tr_item<1>(F.in[18], DM, DFF, F.in[17], WSP(bf16, WS_WGU), scr, r / 88, r % 88, F.lane); continue; } r -= I_G;
        if (r < I_G) { tr_item<2>(F.in[19], DM, DFF, F.in[17], WSP(bf16, WS_WGU), scr, r / 88, r % 88, F.lane); continue; } r -= I_G;
        tr_item<0>(F.in[20], DFF, DM, nullptr, WSP(bf16, WS_WDN), scr, r / 32, r % 32, F.lane);
    }
    bf16* XB = WSP(bf16, WS_XB); float* RS1 = WSP(float, WS_RS1);
    for (int m = gw; m < MTOT; m += NGW) {
        const float* xrow = m < SEQ ? F.in[0] + (size_t)m * DM : F.in[1] + (size_t)(m - SEQ) * DM;
        const GAS f32x4* xr = (const GAS f32x4*)xrow + F.lane;
        f32x4 v[4]; float s = 0.f;
#pragma unroll
        for (int j = 0; j < 4; ++j) { v[j] = xr[64 * j]; s += (v[j].x * v[j].x + v[j].y * v[j].y) + (v[j].z * v[j].z + v[j].w * v[j].w); }
        s = wave_sum(s);
        GAS unsigned long long* o8 = (GAS unsigned long long*)(XB + (size_t)m * DM) + F.lane;
#pragma unroll
        for (int j = 0; j < 4; ++j) o8[64 * j] = (unsigned long long)pk2(v[j].x, v[j].y) | ((unsigned long long)pk2(v[j].z, v[j].w) << 32);
        if (F.lane == 0) RS1[m] = 1.0f / sqrtf(s * (1.0f / DM) + EPS);
    }
    int* BKT = WSP(int, WS_BKT);
    for (int i = blockIdx.x * NTHR + F.tid; i <= 2048; i += F.G * NTHR) BKT[i] = rel_bucket(i);
}

struct EpiProj {
    static constexpr bool PERM = true, AFTER_DRAIN = false;
    bf16* O; const float* rs; float* out;
    __device__ __forceinline__ void operator()(const pg8::f32x4 (&acc)[2][2][4][2], const pg8::Unit& u, int wr, int wc, int fr, int fq) const {
        const int row0 = u.pm * 256 + wr * 64 + fr, col0 = u.pn * 256 + wc * 32 + 8 * fq;
        const bool kv = (u.pm >= 56) && (u.pn >= 3) && (u.pn < 9); const bool is_k = u.pn < 6;
#pragma unroll
        for (int ai = 0; ai < 2; ++ai)
#pragma unroll
            for (int m = 0; m < 4; ++m) { const int row = row0 + ai * 128 + m * 16; const float s = rs[row];
#pragma unroll
                for (int bj = 0; bj < 2; ++bj) { const int col = col0 + bj * 128; const pg8::f32x4 v0 = acc[ai][bj][m][0] * s, v1 = acc[ai][bj][m][1] * s;
                    pg8::u32x4 w; w.x = pg8::cvt_pk_bf16(v0[0], v0[1]); w.y = pg8::cvt_pk_bf16(v0[2], v0[3]); w.z = pg8::cvt_pk_bf16(v1[0], v1[1]); w.w = pg8::cvt_pk_bf16(v1[2], v1[3]);
                    *(pg8::u32x4*)(O + (size_t)row * NP + col) = w;
                    if (kv) { const int cc = col - (is_k ? CK : CV);
                        float* dst = row < SEQ ? out + (is_k ? O_WKP : O_WVP) + (size_t)(row - (SEQ - 2048)) * ATTW + cc : out + (is_k ? O_WKS : O_WVS) + (size_t)(row - SEQ) * ATTW + cc;
                        *(pg8::f32x4*)dst = v0; *(pg8::f32x4*)(dst + 4) = v1; } } }
    }
};
struct EpiOut {
    static constexpr bool PERM = false, AFTER_DRAIN = false;
    const float* xp; const float* xs; float* X1; bf16* X1B; float* SS;
    __device__ __forceinline__ void operator()(const pg8::f32x4 (&acc)[2][2][4][2], const pg8::Unit& u, int wr, int wc, int fr, int fq) const {
        const int row0 = u.pm * 256 + wr * 64 + fr, col0 = u.pn * 256 + wc * 32 + 4 * fq;
#pragma unroll
        for (int ai = 0; ai < 2; ++ai)
#pragma unroll
            for (int m = 0; m < 4; ++m) { const int row = row0 + ai * 128 + m * 16; const float* xr = row < SEQ ? xp + (size_t)row * DM : xs + (size_t)(row - SEQ) * DM; float ss = 0.f;
#pragma unroll
                for (int bj = 0; bj < 2; ++bj)
#pragma unroll
                    for (int n = 0; n < 2; ++n) { const int col = col0 + bj * 128 + n * 16; const pg8::f32x4 v = acc[ai][bj][m][n] + *(const pg8::f32x4*)(xr + col);
                        *(pg8::f32x4*)(X1 + (size_t)row * DM + col) = v; ss += (v[0] * v[0] + v[1] * v[1]) + (v[2] * v[2] + v[3] * v[3]);
                        *(unsigned long long*)(X1B + (size_t)row * DM + col) = (unsigned long long)pg8::cvt_pk_bf16(v[0], v[1]) | ((unsigned long long)pg8::cvt_pk_bf16(v[2], v[3]) << 32); }
                ss += __shfl_xor(ss, 16); ss += __shfl_xor(ss, 32);
                if (fq == 0) atomicAdd(SS + row, ss); }
    }
};
struct EpiGU {
    static constexpr bool PERM = true, AFTER_DRAIN = false;
    bf16* ACT; const float* SS;
    __device__ __forceinline__ void operator()(const pg8::f32x4 (&acc)[2][2][4][2], const pg8::Unit& u, int wr, int wc, int fr, int fq) const {
        const int row0 = u.pm * 256 + wr * 64 + fr, col0 = u.pn * 128 + wc * 32 + 8 * fq;
#pragma unroll
        for (int ai = 0; ai < 2; ++ai)
#pragma unroll
            for (int m = 0; m < 4; ++m) { const int row = row0 + ai * 128 + m * 16; const float s = 1.0f / sqrtf(SS[row] * (1.0f / DM) + EPS);
                float a[8];
#pragma unroll
                for (int n = 0; n < 2; ++n)
#pragma unroll
                    for (int e = 0; e < 4; ++e) { const float g = acc[ai][0][m][n][e] * s, uu = acc[ai][1][m][n][e] * s; a[4 * n + e] = silu_f(g) * uu; }
                pg8::u32x4 w; w.x = pg8::cvt_pk_bf16(a[0], a[1]); w.y = pg8::cvt_pk_bf16(a[2], a[3]); w.z = pg8::cvt_pk_bf16(a[4], a[5]); w.w = pg8::cvt_pk_bf16(a[6], a[7]);
                *(pg8::u32x4*)(ACT + (size_t)row * DFF + col0) = w; }
    }
};
struct EpiDown {
    static constexpr bool PERM = false, AFTER_DRAIN = false;
    const float* X1; float* Y; float* SS;
    __device__ __forceinline__ void operator()(const pg8::f32x4 (&acc)[2][2][4][2], const pg8::Unit& u, int wr, int wc, int fr, int fq) const {
        const int row0 = u.pm * 256 + wr * 64 + fr, col0 = u.pn * 256 + wc * 32 + 4 * fq;
#pragma unroll
        for (int ai = 0; ai < 2; ++ai)
#pragma unroll
            for (int m = 0; m < 4; ++m) { const int row = row0 + ai * 128 + m * 16; float ss = 0.f;
#pragma unroll
                for (int bj = 0; bj < 2; ++bj)
#pragma unroll
                    for (int n = 0; n < 2; ++n) { const int col = col0 + bj * 128 + n * 16; const pg8::f32x4 v = acc[ai][bj][m][n] + *(const pg8::f32x4*)(X1 + (size_t)row * DM + col);
                        *(pg8::f32x4*)(Y + (size_t)row * DM + col) = v; ss += (v[0] * v[0] + v[1] * v[1]) + (v[2] * v[2] + v[3] * v[3]); }
                ss += __shfl_xor(ss, 16); ss += __shfl_xor(ss, 32);
                if (fq == 0) atomicAdd(SS + row, ss); }
    }
};

__device__ __forceinline__ void attn_prompt_simple(Frame& F) {
    const bf16* PROJ = WSP(bf16, WS_PROJ); bf16* MIX = WSP(bf16, WS_MIX); float* ATTSS = WSP(float, WS_ATTSS);
    const int* BKT = WSP(int, WS_BKT); const float* relb = F.in[6];
    const int gw = blockIdx.x * NWAVES + F.wave, NGW = F.G * NWAVES, lane = F.lane;
    for (int t = gw; t < SEQ; t += NGW) {
        for (int h = 0; h < AH; ++h) {
            const float q = bf2f(PROJ[(size_t)t * NP + CQ + h * 64 + lane]) * 0.125f;
            float m = -1e30f, l = 0.f, o = 0.f;
            for (int br = 0; br < 3; ++br) {
                const int d = (br == 0) ? 1 : (br == 1) ? 4 : 16;
                int imax = t / d; if (imax > 128) imax = 128;
                int i = 0;
                for (; i + 3 <= imax; i += 4) {
                    float k[4], v[4], s[4];
#pragma unroll
                    for (int j = 0; j < 4; ++j) { const bf16* kp = PROJ + (size_t)(t - (i + j) * d) * NP + CK + h * 64 + lane; k[j] = bf2f(kp[0]); v[j] = bf2f(kp[CV - CK]); s[j] = q * k[j]; }
#pragma unroll
                    for (int o_ = 1; o_ < 64; o_ <<= 1) {
#pragma unroll
                        for (int j = 0; j < 4; ++j) s[j] += __shfl_xor(s[j], o_); }
#pragma unroll
                    for (int j = 0; j < 4; ++j) s[j] += relb[BKT[(i + j) * d] * AH + h];
                    const float mn = fmaxf(fmaxf(fmaxf(m, s[0]), fmaxf(s[1], s[2])), s[3]);
                    const float a = __expf(m - mn); l *= a; o *= a; m = mn;
#pragma unroll
                    for (int j = 0; j < 4; ++j) { const float p = __expf(s[j] - mn); l += p; o += p * v[j]; }
                }
                for (; i <= imax; ++i) {
                    const bf16* kp = PROJ + (size_t)(t - i * d) * NP + CK + h * 64 + lane;
                    const float kk = bf2f(kp[0]), vv = bf2f(kp[CV - CK]);
                    const float s = wave_sum(q * kk) + relb[BKT[i * d] * AH + h];
                    const float mn = fmaxf(m, s); const float a = __expf(m - mn), p = __expf(s - mn);
                    l = l * a + p; o = o * a + p * vv; m = mn;
                }
            }
            const float r = o / l;
            MIX[(size_t)t * MIXW + h * 64 + lane] = (bf16)f2bf(r);
            const float sq = wave_sum(r * r); if (lane == 0) ATTSS[t * AH + h] = sq;
        }
    }
}


typedef short v4i16_t __attribute__((ext_vector_type(4)));
typedef float f32x16 __attribute__((ext_vector_type(16)));
__device__ __forceinline__ void attn_prompt_mfma(Frame& F) {
    const bf16* PROJ = WSP(bf16, WS_PROJ); bf16* OPART = WSP(bf16, WS_OPART); float* ML = WSP(float, WS_ML);
    const int* BKT = WSP(int, WS_BKT); const float* relb = F.in[6];
    LAS unsigned char* Kl = F.lds; LAS unsigned char* Vl = F.lds + 49152; LAS float* btab = (LAS float*)(F.lds + 98304);
    const int tid = F.tid, lane = F.lane, wave = F.wave, q = lane & 31, hi = lane >> 5;
    constexpr float LOG2E = 1.4426950408889634f, C1 = 0.125f * LOG2E, NEG = -1e30f;
    for (int unit = blockIdx.x; unit < 3 * AH * 64; unit += F.G) {
        const int br = unit / 768, rem = unit % 768, h = rem >> 6, blk = rem & 63;
        const int dsh = 2 * br, d = 1 << dsh, r = blk & (d - 1), qb = blk >> dsh, j0 = qb * 256;
        for (int n = wave; n < 48; n += 8) {
            const int row = 8 * n + (lane >> 3), pc = lane & 7; int jj = j0 - 128 + row; if (jj < 0) jj = 0;
            const size_t tok = (size_t)jj * d + r;
            const int lcK = pc ^ ((row >> 1) & 7), lcV = pc ^ (((row >> 1) & 1) << 2);
            __builtin_amdgcn_global_load_lds((const unsigned*)(PROJ + tok * NP + CK + h * 64 + lcK * 8), (LAS unsigned*)(Kl + n * 1024), 16, 0, 0);
            __builtin_amdgcn_global_load_lds((const unsigned*)(PROJ + tok * NP + CV + h * 64 + lcV * 8), (LAS unsigned*)(Vl + n * 1024), 16, 0, 0);
        }
        if (tid < 129) btab[tid] = relb[BKT[tid * d] * AH + h] * LOG2E;
        const size_t tokq = (size_t)(j0 + 32 * wave + q) * d + r;
        bf16x8 qf[4];
#pragma unroll
        for (int s = 0; s < 4; ++s) qf[s] = *(const bf16x8*)(PROJ + tokq * NP + CQ + h * 64 + 16 * s + 8 * hi);
        asm volatile("s_waitcnt vmcnt(0)" ::: "memory");
        __syncthreads();
        f32x16 S[5];
#pragma unroll
        for (int kt = 0; kt < 5; ++kt) {
            const int row0 = 32 * (wave + kt);
            if (j0 - 128 + row0 >= 0) {
                f32x16 acc;
#pragma unroll
                for (int e = 0; e < 16; ++e) acc[e] = 0.f;
                const int krow = row0 + q;
#pragma unroll
                for (int s = 0; s < 4; ++s) { const bf16x8 kf = *(const LAS bf16x8*)(Kl + krow * 128 + (((2 * s + hi) ^ ((krow >> 1) & 7)) << 4));
                    acc = __builtin_amdgcn_mfma_f32_32x32x16_bf16(kf, qf[s], acc, 0, 0, 0); }
#pragma unroll
                for (int e = 0; e < 16; ++e) { const int kl = (e & 3) + 8 * (e >> 2) + 4 * hi; const int i = 128 - 32 * kt + q - kl;
                    const int ic = i < 0 ? 0 : (i > 128 ? 128 : i);
                    const float v = acc[e] * C1 + btab[ic];
                    S[kt][e] = (kt == 0 || kt == 4) ? ((i >= 0 && i <= 128) ? v : NEG) : v; }
            } else {
#pragma unroll
                for (int e = 0; e < 16; ++e) S[kt][e] = NEG;
            }
        }
        float m = NEG;
#pragma unroll
        for (int kt = 0; kt < 5; ++kt)
#pragma unroll
            for (int e = 0; e < 16; ++e) m = fmaxf(m, S[kt][e]);
        m = fmaxf(m, __shfl_xor(m, 32));
        float l = 0.f;
        bf16x8 Pk[5][2];
#pragma unroll
        for (int kt = 0; kt < 5; ++kt) {
#pragma unroll
            for (int e = 0; e < 16; ++e) { const float p = __builtin_amdgcn_exp2f(S[kt][e] - m); S[kt][e] = p; l += p; }
#pragma unroll
            for (int s2 = 0; s2 < 2; ++s2) { v4u w; w.x = pk2(S[kt][8 * s2 + 0], S[kt][8 * s2 + 1]); w.y = pk2(S[kt][8 * s2 + 2], S[kt][8 * s2 + 3]); w.z = pk2(S[kt][8 * s2 + 4], S[kt][8 * s2 + 5]); w.w = pk2(S[kt][8 * s2 + 6], S[kt][8 * s2 + 7]);
                Pk[kt][s2] = __builtin_bit_cast(bf16x8, w); }
        }
        l += __shfl_xor(l, 32);
        f32x16 OT[2];
#pragma unroll
        for (int e = 0; e < 16; ++e) { OT[0][e] = 0.f; OT[1][e] = 0.f; }
        const int g2 = (lane >> 4) & 1, qq = (lane & 15) >> 2, pp = lane & 3;
#pragma unroll
        for (int kt = 0; kt < 5; ++kt) {
            const int row0 = 32 * (wave + kt);
            if (j0 - 128 + row0 >= 0) {
#pragma unroll
                for (int s2 = 0; s2 < 2; ++s2)
#pragma unroll
                    for (int d0 = 0; d0 < 2; ++d0) {
                        const int rlo = row0 + 16 * s2 + 4 * hi + qq, rhi = rlo + 8;
                        const int lc = 4 * d0 + 2 * g2 + (pp >> 1);
                        const LAS unsigned char* alo = Vl + rlo * 128 + ((lc ^ (((rlo >> 1) & 1) << 2)) << 4) + 8 * (pp & 1);
                        const LAS unsigned char* ahi = Vl + rhi * 128 + ((lc ^ (((rhi >> 1) & 1) << 2)) << 4) + 8 * (pp & 1);
                        const v4i16_t lo = __builtin_amdgcn_ds_read_tr16_b64_v4i16((LAS v4i16_t*)alo);
                        const v4i16_t hh = __builtin_amdgcn_ds_read_tr16_b64_v4i16((LAS v4i16_t*)ahi);
                        const bf16x8 vf = (bf16x8){lo[0], lo[1], lo[2], lo[3], hh[0], hh[1], hh[2], hh[3]};
                        OT[d0] = __builtin_amdgcn_mfma_f32_32x32x16_bf16(vf, Pk[kt][s2], OT[d0], 0, 0, 0);
                    }
            }
        }
        const float inv = 1.0f / l;
        bf16* op = OPART + ((size_t)br * SEQ + tokq) * ATTW + h * 64;
#pragma unroll
        for (int d0 = 0; d0 < 2; ++d0)
#pragma unroll
            for (int g = 0; g < 4; ++g) { const int dd = 32 * d0 + 8 * g + 4 * hi;
                *(unsigned long long*)(op + dd) = (unsigned long long)pk2(OT[d0][4 * g] * inv, OT[d0][4 * g + 1] * inv) | ((unsigned long long)pk2(OT[d0][4 * g + 2] * inv, OT[d0][4 * g + 3] * inv) << 32); }
        if (hi == 0) { float* mp = ML + (((size_t)br * SEQ + tokq) * AH + h) * 2; mp[0] = m; mp[1] = l; }
        __syncthreads();
    }
}

__device__ __forceinline__ void attn_sample(Frame& F) {
    const bf16* PROJ = WSP(bf16, WS_PROJ); bf16* MIX = WSP(bf16, WS_MIX); float* ATTSS = WSP(float, WS_ATTSS);
    const int* BKT = WSP(int, WS_BKT); const float* relb = F.in[6];
    const float* cache_k = F.in[2]; const float* cache_v = F.in[3];
    const int lane = F.lane, wave = F.wave, hl = lane >> 4, d0 = 4 * (lane & 15);
    LAS float* comb = (LAS float*)F.lds;
    for (int unit = blockIdx.x; unit < DB * 3; unit += F.G) {
        const int b = unit / 3, hg = unit % 3, head = hg * 4 + hl;
        float q[4][4];
#pragma unroll
        for (int t = 0; t < 4; ++t) { const bf16* qp = PROJ + (size_t)(SEQ + 4 * b + t) * NP + CQ + head * 64 + d0;
#pragma unroll
            for (int e = 0; e < 4; ++e) q[t][e] = bf2f(qp[e]) * 0.125f; }
        float m[4], l[4], o[4][4];
#pragma unroll
        for (int t = 0; t < 4; ++t) { m[t] = -1e30f; l[t] = 0.f;
#pragma unroll
            for (int e = 0; e < 4; ++e) o[t][e] = 0.f; }
        for (int e = wave; e < 900; e += 8) {
            const int rho = e < 384 ? 16 * (e >> 2) + (e & 3) : (e < 768 ? 1536 + (e - 384) : 1920 + (e - 768));
            f32x4 kk, vv;
            if (rho < WB) { const size_t off = (((size_t)b * WB + rho) * AH + head) * HD + d0; kk = *(const f32x4*)(cache_k + off); vv = *(const f32x4*)(cache_v + off); }
            else { const bf16* kp = PROJ + (size_t)(SEQ + 4 * b + (rho - WB)) * NP + CK + head * 64 + d0;
                kk = (f32x4){bf2f(kp[0]), bf2f(kp[1]), bf2f(kp[2]), bf2f(kp[3])}; vv = (f32x4){bf2f(kp[CV - CK]), bf2f(kp[CV - CK + 1]), bf2f(kp[CV - CK + 2]), bf2f(kp[CV - CK + 3])}; }
#pragma unroll
            for (int t = 0; t < 4; ++t) {
                const int delta = WB + t - rho;
                if (delta < 0) continue;
                const int mu = attn_mult(delta);
                if (mu == 0) continue;
                float s = (q[t][0] * kk[0] + q[t][1] * kk[1]) + (q[t][2] * kk[2] + q[t][3] * kk[3]);
                s += __shfl_xor(s, 1); s += __shfl_xor(s, 2); s += __shfl_xor(s, 4); s += __shfl_xor(s, 8);
                s += relb[BKT[delta] * AH + head];
                const float mn = fmaxf(m[t], s); const float a = __expf(m[t] - mn), p = (float)mu * __expf(s - mn);
                l[t] = l[t] * a + p; m[t] = mn;
#pragma unroll
                for (int e2 = 0; e2 < 4; ++e2) o[t][e2] = o[t][e2] * a + p * vv[e2];
            }
        }
#pragma unroll
        for (int t = 0; t < 4; ++t) { LAS float* c = comb + ((wave * 4 + t) * 64 + lane) * 6; c[0] = m[t]; c[1] = l[t]; c[2] = o[t][0]; c[3] = o[t][1]; c[4] = o[t][2]; c[5] = o[t][3]; }
        __syncthreads();
        if (F.tid < 256) {
            const int t = F.tid >> 6;
            float mm = -1e30f;
#pragma unroll
            for (int w = 0; w < 8; ++w) mm = fmaxf(mm, comb[((w * 4 + t) * 64 + lane) * 6]);
            float ll = 0.f, oo[4] = {0.f, 0.f, 0.f, 0.f};
#pragma unroll
            for (int w = 0; w < 8; ++w) { const LAS float* c = comb + ((w * 4 + t) * 64 + lane) * 6; const float a = __expf(c[0] - mm); ll += c[1] * a;
#pragma unroll
                for (int e2 = 0; e2 < 4; ++e2) oo[e2] += c[2 + e2] * a; }
            const float inv = 1.0f / ll; float sq = 0.f;
#pragma unroll
            for (int e2 = 0; e2 < 4; ++e2) { oo[e2] *= inv; sq += oo[e2] * oo[e2]; }
            const int row = SEQ + 4 * b + t;
            *(unsigned long long*)(MIX + (size_t)row * MIXW + head * 64 + d0) = (unsigned long long)pk2(oo[0], oo[1]) | ((unsigned long long)pk2(oo[2], oo[3]) << 32);
            sq += __shfl_xor(sq, 1); sq += __shfl_xor(sq, 2); sq += __shfl_xor(sq, 4); sq += __shfl_xor(sq, 8);
            if ((lane & 15) == 0) ATTSS[row * AH + head] = sq;
        }
        __syncthreads();
    }
}

__device__ __forceinline__ void ssd_phase_a(Frame& F) {
    const bf16* PROJ = WSP(bf16, WS_PROJ); bf16* XC = WSP(bf16, WS_XC); float* DTB = WSP(float, WS_DTB); float* ACS = WSP(float, WS_ACS); float* CDEC = WSP(float, WS_CDEC); float* ST = WSP(float, WS_ST);
    const float* conv_w = F.in[9]; const float* conv_b = F.in[10]; const float* dt_bias = F.in[11]; const float* a_log = F.in[12];
    LAS bf16* xs = (LAS bf16*)F.lds;
    LAS bf16* Bs = (LAS bf16*)(F.lds + 81920);
    LAS float* dts = (LAS float*)(F.lds + 81920 + 32768);
    LAS float* acsS = dts + 640;
    LAS float* wl = acsS + 640;
    const int tid = F.tid, lane = F.lane, wave = F.wave;
    for (int unit = blockIdx.x; unit < NCHUNK * NG; unit += F.G) {
        const int c = unit >> 2, g = unit & 3, T0 = c * CL;
        for (int task = tid; task < 576 * 8; task += NTHR) {
            const int cj = task % 576, seg = task / 576;
            const int xcol = cj < 320 ? g * 320 + cj : (cj < 448 ? 1280 + g * 128 + (cj - 320) : 1792 + g * 128 + (cj - 448));
            const float w0 = conv_w[xcol], w1 = conv_w[CONVD + xcol], w2 = conv_w[2 * CONVD + xcol], w3 = conv_w[3 * CONVD + xcol], bb = conv_b[xcol];
            const int t0 = T0 + seg * 16;
            float x0 = t0 >= 3 ? bf2f(PROJ[(size_t)(t0 - 3) * NP + CX + xcol]) : 0.f, x1 = t0 >= 2 ? bf2f(PROJ[(size_t)(t0 - 2) * NP + CX + xcol]) : 0.f, x2 = t0 >= 1 ? bf2f(PROJ[(size_t)(t0 - 1) * NP + CX + xcol]) : 0.f;
#pragma unroll 4
            for (int i = 0; i < 16; ++i) { const float x3 = bf2f(PROJ[(size_t)(t0 + i) * NP + CX + xcol]);
                const float y = silu_f(x0 * w0 + x1 * w1 + x2 * w2 + x3 * w3 + bb); const bf16 yb = (bf16)f2bf(y);
                XC[(size_t)(t0 + i) * CONVD + xcol] = yb;
                const int l = seg * 16 + i;
                if (cj < 320) xs[l * 320 + cj] = yb; else if (cj < 448) Bs[l * 128 + (cj - 320)] = yb;
                x0 = x1; x1 = x2; x2 = x3; }
            if (c == NCHUNK - 1 && seg == 7) {
                F.out[O_CVP + 0 * CONVD + xcol] = x0; F.out[O_CVP + 1 * CONVD + xcol] = x1; F.out[O_CVP + 2 * CONVD + xcol] = x2; }
        }
        for (int i = tid; i < 640; i += NTHR) { const int l = i / 5, hl = i % 5, h = g * 5 + hl;
            const float dt = softplus_f(bf2f(PROJ[(size_t)(T0 + l) * NP + CDT + h]) + dt_bias[h]);
            dts[i] = dt; acsS[i] = dt * (-__expf(a_log[h])); DTB[(size_t)(T0 + l) * SH + h] = dt; }
        __syncthreads();
        if (wave < 5) {
            const int hl = wave; const float a0 = acsS[(2 * lane) * 5 + hl], a1 = acsS[(2 * lane + 1) * 5 + hl];
            float s = a0 + a1;
#pragma unroll
            for (int o = 1; o < 64; o <<= 1) { const float u = __shfl_up(s, o); if (lane >= o) s += u; }
            const float e0 = s - a1;
            acsS[(2 * lane) * 5 + hl] = e0; acsS[(2 * lane + 1) * 5 + hl] = s;
            ACS[(size_t)(T0 + 2 * lane) * SH + g * 5 + hl] = e0; ACS[(size_t)(T0 + 2 * lane + 1) * SH + g * 5 + hl] = s;
            if (lane == 63) CDEC[c * SH + g * 5 + hl] = __expf(s);
        }
        __syncthreads();
        const int n = tid & 127, pq = __builtin_amdgcn_readfirstlane(tid >> 7);
        for (int hl = 0; hl < 5; ++hl) {
            if (tid < 128) wl[tid] = __expf(acsS[127 * 5 + hl] - acsS[tid * 5 + hl]) * dts[tid * 5 + hl];
            __syncthreads();
            float acc[16];
#pragma unroll
            for (int j = 0; j < 16; ++j) acc[j] = 0.f;
            for (int l = 0; l < CL; ++l) { const float bw = bf2f(Bs[l * 128 + n]) * wl[l];
                const LAS bf16* xr = xs + l * 320 + hl * 64 + pq * 16;
#pragma unroll
                for (int j = 0; j < 16; ++j) acc[j] += bw * bf2f(xr[j]); }
            float* dst = ST + (((size_t)c * SH + g * 5 + hl) * HD + pq * 16) * DSTATE + n;
#pragma unroll
            for (int j = 0; j < 16; ++j) dst[(size_t)j * DSTATE] = acc[j];
            __syncthreads();
        }
    }
}

__device__ __forceinline__ void ssd_sample(Frame& F) {
    const bf16* PROJ = WSP(bf16, WS_PROJ); bf16* MIX = WSP(bf16, WS_MIX);
    const float* state_conv = F.in[4]; const float* state_ssm = F.in[5];
    const float* conv_w = F.in[9]; const float* conv_b = F.in[10]; const float* dt_bias = F.in[11]; const float* a_log = F.in[12]; const float* d_skip = F.in[13]; const float* g_ssd = F.in[15];
    LAS float* xs = (LAS float*)F.lds;
    LAS float* Bs = xs + 1280;
    LAS float* Cs = Bs + 512;
    LAS float* dts = Cs + 512;
    LAS float* acs = dts + 20;
    LAS float* CBs = acs + 20;
    LAS float* ys = CBs + 16;
    LAS float* red = ys + 1280;
    const int tid = F.tid, lane = F.lane, wave = F.wave;
    for (int unit = blockIdx.x; unit < DB * NG; unit += F.G) {
        const int b = unit >> 2, g = unit & 3; const int r0 = SEQ + 4 * b;
        for (int cj = tid; cj < 576; cj += NTHR) {
            const int xcol = cj < 320 ? g * 320 + cj : (cj < 448 ? 1280 + g * 128 + (cj - 320) : 1792 + g * 128 + (cj - 448));
            const float w0 = conv_w[xcol], w1 = conv_w[CONVD + xcol], w2 = conv_w[2 * CONVD + xcol], w3 = conv_w[3 * CONVD + xcol], bb = conv_b[xcol];
            float xp[7];
#pragma unroll
            for (int j = 0; j < 3; ++j) xp[j] = state_conv[((size_t)b * 3 + j) * CONVD + xcol];
#pragma unroll
            for (int t = 0; t < 4; ++t) xp[3 + t] = bf2f(PROJ[(size_t)(r0 + t) * NP + CX + xcol]);
#pragma unroll
            for (int t = 0; t < 4; ++t) { const float y = silu_f(xp[t] * w0 + xp[t + 1] * w1 + xp[t + 2] * w2 + xp[t + 3] * w3 + bb);
                if (cj < 320) xs[t * 320 + cj] = y; else if (cj < 448) Bs[t * 128 + (cj - 320)] = y; else Cs[t * 128 + (cj - 448)] = y; }
#pragma unroll
            for (int j = 0; j < 3; ++j) F.out[O_CVS + ((size_t)b * 3 + j) * CONVD + xcol] = xp[4 + j];
        }
        if (tid < 20) { const int t = tid / 5, hl = tid % 5, h = g * 5 + hl; dts[tid] = softplus_f(bf2f(PROJ[(size_t)(r0 + t) * NP + CDT + h]) + dt_bias[h]); }
        __syncthreads();
        if (tid < 5) { const float a = -__expf(a_log[g * 5 + tid]); float s = 0.f;
#pragma unroll
            for (int t = 0; t < 4; ++t) { s += dts[t * 5 + tid] * a; acs[t * 5 + tid] = s; } }
        { const int pair = tid >> 5, n4 = tid & 31, t = pair >> 2, s = pair & 3; float v = 0.f;
#pragma unroll
            for (int e = 0; e < 4; ++e) v += Cs[t * 128 + 4 * n4 + e] * Bs[s * 128 + 4 * n4 + e];
            v += __shfl_xor(v, 1); v += __shfl_xor(v, 2); v += __shfl_xor(v, 4); v += __shfl_xor(v, 8); v += __shfl_xor(v, 16);
            if (n4 == 0) CBs[pair] = v; }
        __syncthreads();
        const int n4 = tid & 31, pr = tid >> 5;
        float Bv[4][4], Cv[4][4];
#pragma unroll
        for (int t = 0; t < 4; ++t)
#pragma unroll
            for (int e = 0; e < 4; ++e) { Bv[t][e] = Bs[t * 128 + 4 * n4 + e]; Cv[t][e] = Cs[t * 128 + 4 * n4 + e]; }
        for (int hl = 0; hl < 5; ++hl) {
            const int h = g * 5 + hl;
            float ac[4], dtv[4];
#pragma unroll
            for (int t = 0; t < 4; ++t) { ac[t] = acs[t * 5 + hl]; dtv[t] = dts[t * 5 + hl]; }
            const float dsk = d_skip[h];
#pragma unroll
            for (int j = 0; j < 4; ++j) {
                const int p = pr + 16 * j;
                const size_t soff = (((size_t)b * SH + h) * HD + p) * DSTATE + 4 * n4;
                const f32x4 S = *(const f32x4*)(state_ssm + soff);
                float xv[4];
#pragma unroll
                for (int t = 0; t < 4; ++t) xv[t] = xs[t * 320 + hl * 64 + p];
                f32x4 Hn = S * __expf(ac[3]);
#pragma unroll
                for (int t = 0; t < 4; ++t) { const float wgt = __expf(ac[3] - ac[t]) * dtv[t] * xv[t];
#pragma unroll
                    for (int e = 0; e < 4; ++e) Hn[e] += wgt * Bv[t][e]; }
                *(f32x4*)(F.out + O_SSS + soff) = Hn;
#pragma unroll
                for (int t = 0; t < 4; ++t) {
                    float yo = (Cv[t][0] * S[0] + Cv[t][1] * S[1]) + (Cv[t][2] * S[2] + Cv[t][3] * S[3]);
                    yo += __shfl_xor(yo, 1); yo += __shfl_xor(yo, 2); yo += __shfl_xor(yo, 4); yo += __shfl_xor(yo, 8); yo += __shfl_xor(yo, 16);
                    float y = yo * __expf(ac[t]) + dsk * xv[t];
#pragma unroll
                    for (int s = 0; s < 4; ++s) if (s <= t) y += CBs[t * 4 + s] * __expf(ac[t] - ac[s]) * dtv[s] * xv[s];
                    if (n4 == t) ys[t * 320 + hl * 64 + p] = y;
                }
            }
        }
        __syncthreads();
        float yv[4]; float part[4];
#pragma unroll
        for (int t = 0; t < 4; ++t) { yv[t] = 0.f;
            if (tid < 320) { const float z = bf2f(PROJ[(size_t)(r0 + t) * NP + CZ + g * 320 + tid]); yv[t] = ys[t * 320 + tid] * silu_f(z); }
            part[t] = wave_sum(yv[t] * yv[t]); }
        if (lane == 0) {
#pragma unroll
            for (int t = 0; t < 4; ++t) red[t * 8 + wave] = part[t]; }
        __syncthreads();
        if (tid < 320) {
#pragma unroll
            for (int t = 0; t < 4; ++t) { float ss = 0.f;
#pragma unroll
                for (int w = 0; w < 8; ++w) ss += red[t * 8 + w];
                const float rs = 1.0f / sqrtf(ss * (1.0f / 320.f) + EPS);
                MIX[(size_t)(r0 + t) * MIXW + ATTW + g * 320 + tid] = (bf16)f2bf(yv[t] * rs * g_ssd[g * 320 + tid]); } }
        __syncthreads();
    }
}

__device__ __forceinline__ void scan_and_attnorm(Frame& F) {
    float* ST = WSP(float, WS_ST); const float* CDEC = WSP(float, WS_CDEC);
    const int gt = blockIdx.x * NTHR + F.tid, NGT = F.G * NTHR;
    for (int e4 = gt; e4 < SH * HD * DSTATE / 4; e4 += NGT) {
        const int h = e4 / (HD * DSTATE / 4);
        f32x4 hcur = (f32x4){0.f, 0.f, 0.f, 0.f};
        for (int c0 = 0; c0 < NCHUNK; c0 += 8) {
            f32x4 st[8]; float dc[8];
#pragma unroll
            for (int j = 0; j < 8; ++j) { st[j] = *(const f32x4*)(ST + (size_t)(c0 + j) * (SH * HD * DSTATE) + (size_t)e4 * 4); dc[j] = CDEC[(c0 + j) * SH + h]; }
#pragma unroll
            for (int j = 0; j < 8; ++j) { *(f32x4*)(ST + (size_t)(c0 + j) * (SH * HD * DSTATE) + (size_t)e4 * 4) = hcur; hcur = hcur * dc[j] + st[j]; }
        }
        *(f32x4*)(F.out + O_SSP + (size_t)e4 * 4) = hcur;
    }
    bf16* MIX = WSP(bf16, WS_MIX); const float* ATTSS = WSP(float, WS_ATTSS); const float* g_attn = F.in[14];
    const bf16* OPART = WSP(bf16, WS_OPART); const float* ML = WSP(float, WS_ML);
    const int gw = blockIdx.x * NWAVES + F.wave, NGW = F.G * NWAVES, lane = F.lane;
    for (int row = gw; row < SEQ; row += NGW) {
        float o[3][4]; float sq = 0.f;
#pragma unroll
        for (int j = 0; j < 3; ++j) { const int col = 4 * lane + 256 * j, h = col >> 6;
            float mb[3], lb[3];
#pragma unroll
            for (int b = 0; b < 3; ++b) { const float* mp = ML + (((size_t)b * SEQ + row) * AH + h) * 2; mb[b] = mp[0]; lb[b] = mp[1]; }
            const float M = fmaxf(fmaxf(mb[0], mb[1]), mb[2]);
            float w[3], W = 0.f;
#pragma unroll
            for (int b = 0; b < 3; ++b) { w[b] = __builtin_amdgcn_exp2f(mb[b] - M) * lb[b]; W += w[b]; }
            const float iw = 1.0f / W;
#pragma unroll
            for (int e = 0; e < 4; ++e) o[j][e] = 0.f;
#pragma unroll
            for (int b = 0; b < 3; ++b) { const unsigned long long x = *(const unsigned long long*)(OPART + ((size_t)b * SEQ + row) * ATTW + col); const float wb = w[b] * iw;
                o[j][0] += wb * bf2f((unsigned short)x); o[j][1] += wb * bf2f((unsigned short)(x >> 16)); o[j][2] += wb * bf2f((unsigned short)(x >> 32)); o[j][3] += wb * bf2f((unsigned short)(x >> 48)); }
#pragma unroll
            for (int e = 0; e < 4; ++e) sq += o[j][e] * o[j][e]; }
        sq = wave_sum(sq);
        const float rs = 1.0f / sqrtf(sq * (1.0f / ATTW) + EPS);
#pragma unroll
        for (int j = 0; j < 3; ++j) { const int col = 4 * lane + 256 * j; const f32x4 gg = *(const f32x4*)(g_attn + col);
            *(unsigned long long*)(MIX + (size_t)row * MIXW + col) = (unsigned long long)pk2(o[j][0] * rs * gg[0], o[j][1] * rs * gg[1]) | ((unsigned long long)pk2(o[j][2] * rs * gg[2], o[j][3] * rs * gg[3]) << 32); }
    }
    for (int row = SEQ + gw; row < MTOT; row += NGW) {
        float s = lane < AH ? ATTSS[row * AH + lane] : 0.f; s = wave_sum(s);
        const float rs = 1.0f / sqrtf(s * (1.0f / ATTW) + EPS);
#pragma unroll
        for (int j = 0; j < 3; ++j) { const int col = 4 * lane + 256 * j; unsigned long long* p = (unsigned long long*)(MIX + (size_t)row * MIXW + col);
            const unsigned long long w = *p; const f32x4 gg = *(const f32x4*)(g_attn + col);
            const float v0 = bf2f((unsigned short)w) * rs * gg[0], v1 = bf2f((unsigned short)(w >> 16)) * rs * gg[1], v2 = bf2f((unsigned short)(w >> 32)) * rs * gg[2], v3 = bf2f((unsigned short)(w >> 48)) * rs * gg[3];
            *p = (unsigned long long)pk2(v0, v1) | ((unsigned long long)pk2(v2, v3) << 32); }
    }
}

__device__ __forceinline__ void ssd_phase_b(Frame& F) {
    const bf16* PROJ = WSP(bf16, WS_PROJ); const bf16* XC = WSP(bf16, WS_XC); const float* DTB = WSP(float, WS_DTB); const float* ACS = WSP(float, WS_ACS); const float* ST = WSP(float, WS_ST);
    bf16* MIX = WSP(bf16, WS_MIX); const float* d_skip = F.in[13]; const float* g_ssd = F.in[15];
    LAS float* Wm = (LAS float*)F.lds;
    LAS float* Hs = (LAS float*)(F.lds + 66048);
    LAS bf16* xh = (LAS bf16*)(F.lds + 66048 + 32768);
    LAS float* acsS = (LAS float*)(F.lds + 66048 + 32768 + 16384);
    LAS float* dtS = acsS + 128;
    LAS float* ssq = dtS + 128;
    const int tid = F.tid, lane = F.lane;
    const int l = tid & 127, pq = __builtin_amdgcn_readfirstlane(tid >> 7);
    for (int unit = blockIdx.x; unit < NCHUNK * NG; unit += F.G) {
        const int c = unit >> 2, g = unit & 3, T0 = c * CL;
        float yv[5][16];
        if (tid < 128) ssq[tid] = 0.f;
#pragma unroll
        for (int hl = 0; hl < 5; ++hl) {
            const int h = g * 5 + hl;
            __syncthreads();
            if (tid < 128) { acsS[tid] = ACS[(size_t)(T0 + tid) * SH + h]; dtS[tid] = DTB[(size_t)(T0 + tid) * SH + h]; }
            for (int i = tid; i < 64 * 128 / 4; i += NTHR) ((LAS f32x4*)Hs)[i] = *(const f32x4*)(ST + ((size_t)c * SH + h) * (HD * DSTATE) + (size_t)i * 4);
            for (int i = tid; i < 128 * 64 / 8; i += NTHR) { const int r = i >> 3, ch = i & 7; ((LAS v4u*)xh)[i] = *(const v4u*)(XC + (size_t)(T0 + r) * CONVD + h * 64 + ch * 8); }
            __syncthreads();
            for (int pair = tid; pair < 128 * 128; pair += NTHR) {
                const int ll = pair >> 7, s = pair & 127; float w = 0.f;
                if (s <= ll) { const bf16* cp = XC + (size_t)(T0 + ll) * CONVD + 1792 + g * 128; const bf16* bp = XC + (size_t)(T0 + s) * CONVD + 1280 + g * 128; float d = 0.f;
#pragma unroll 4
                    for (int k8 = 0; k8 < 16; ++k8) { const v4u cw = *(const v4u*)(cp + 8 * k8), bw = *(const v4u*)(bp + 8 * k8);
#pragma unroll
                        for (int e = 0; e < 4; ++e) { d += __uint_as_float(cw[e] << 16) * __uint_as_float(bw[e] << 16) + __uint_as_float(cw[e] & 0xffff0000u) * __uint_as_float(bw[e] & 0xffff0000u); } }
                    w = d * __expf(acsS[ll] - acsS[s]) * dtS[s]; }
                Wm[ll * 129 + s] = w; }
            __syncthreads();
            float acc[16];
#pragma unroll
            for (int j = 0; j < 16; ++j) acc[j] = 0.f;
            for (int s = 0; s < CL; ++s) { const float w = Wm[l * 129 + s]; const LAS bf16* xr = xh + s * 64 + pq * 16;
#pragma unroll
                for (int j = 0; j < 16; ++j) acc[j] += w * bf2f(xr[j]); }
            { const bf16* cp = XC + (size_t)(T0 + l) * CONVD + 1792 + g * 128; const float ea = __expf(acsS[l]);
                float off[16];
#pragma unroll
                for (int j = 0; j < 16; ++j) off[j] = 0.f;
                for (int k8 = 0; k8 < 16; ++k8) { const v4u cw = *(const v4u*)(cp + 8 * k8); float cf[8];
#pragma unroll
                    for (int e = 0; e < 4; ++e) { cf[2 * e] = __uint_as_float(cw[e] << 16); cf[2 * e + 1] = __uint_as_float(cw[e] & 0xffff0000u); }
#pragma unroll
                    for (int j = 0; j < 16; ++j) { const LAS float* hr = Hs + (pq * 16 + j) * 128 + 8 * k8;
#pragma unroll
                        for (int e = 0; e < 8; ++e) off[j] += cf[e] * hr[e]; } }
#pragma unroll
                for (int j = 0; j < 16; ++j) acc[j] += ea * off[j]; }
            { const float dsk = d_skip[h]; const LAS bf16* xr = xh + l * 64 + pq * 16; const bf16* zp = PROJ + (size_t)(T0 + l) * NP + CZ + h * 64 + pq * 16; float sq = 0.f;
#pragma unroll
                for (int j = 0; j < 16; ++j) { const float y = (acc[j] + dsk * bf2f(xr[j])) * silu_f(bf2f(zp[j])); yv[hl][j] = y; sq += y * y; }
                __hip_atomic_fetch_add(&ssq[l], sq, __ATOMIC_RELAXED, __HIP_MEMORY_SCOPE_WORKGROUP); }
        }
        __syncthreads();
        const float rs = 1.0f / sqrtf(ssq[l] * (1.0f / 320.f) + EPS);
#pragma unroll
        for (int hl = 0; hl < 5; ++hl) { const int col = (g * 5 + hl) * 64 + pq * 16; bf16* mp = MIX + (size_t)(T0 + l) * MIXW + ATTW + col;
            v4u w0, w1;
            w0.x = pk2(yv[hl][0] * rs * g_ssd[col + 0], yv[hl][1] * rs * g_ssd[col + 1]); w0.y = pk2(yv[hl][2] * rs * g_ssd[col + 2], yv[hl][3] * rs * g_ssd[col + 3]);
            w0.z = pk2(yv[hl][4] * rs * g_ssd[col + 4], yv[hl][5] * rs * g_ssd[col + 5]); w0.w = pk2(yv[hl][6] * rs * g_ssd[col + 6], yv[hl][7] * rs * g_ssd[col + 7]);
            w1.x = pk2(yv[hl][8] * rs * g_ssd[col + 8], yv[hl][9] * rs * g_ssd[col + 9]); w1.y = pk2(yv[hl][10] * rs * g_ssd[col + 10], yv[hl][11] * rs * g_ssd[col + 11]);
            w1.z = pk2(yv[hl][12] * rs * g_ssd[col + 12], yv[hl][13] * rs * g_ssd[col + 13]); w1.w = pk2(yv[hl][14] * rs * g_ssd[col + 14], yv[hl][15] * rs * g_ssd[col + 15]);
            *(v4u*)mp = w0; *(v4u*)(mp + 8) = w1; }
        __syncthreads();
    }
}

__device__ __forceinline__ void final_norm(Frame& F) {
    const float* SS3 = (const float*)(F.ws + CTL_SS3); const float* gf = F.in[21];
    const int gw = blockIdx.x * NWAVES + F.wave, NGW = F.G * NWAVES, lane = F.lane;
    for (int row = gw; row < MTOT; row += NGW) {
        const float rs = 1.0f / sqrtf(SS3[row] * (1.0f / DM) + EPS);
        f32x4* yr = (f32x4*)(F.out + (size_t)row * DM) + lane;
#pragma unroll
        for (int j = 0; j < 4; ++j) { const f32x4 gg = *((const f32x4*)gf + lane + 64 * j); yr[64 * j] = yr[64 * j] * rs * gg; }
    }
}

#ifndef MK_N_LAUNCHES
#define MK_N_LAUNCHES 1
#endif
constexpr int N_PHASES = 9;
struct Args { const float* in[22]; float* out; unsigned char* ws; int ph_lo, ph_hi; };
__global__ void __launch_bounds__(NTHR, 2) fwd(Args args) {
    extern __shared__ __attribute__((aligned(16))) unsigned char lds[];
    Frame F;
    F.lds = (LAS unsigned char*)lds;
    F.tid = threadIdx.x; F.lane = F.tid & 63; F.wave = __builtin_amdgcn_readfirstlane(F.tid >> 6); F.G = gridDim.x;
#pragma unroll
    for (int i = 0; i < 22; ++i) F.in[i] = args.in[i];
    F.out = args.out; F.ws = args.ws;
    volatile LAS unsigned* MISC = (volatile LAS unsigned*)(F.lds + MISC_OFF);
    if (F.tid < 64) MISC[F.tid] = 0u;
    __syncthreads();
    unsigned* barw = (unsigned*)(F.ws + WS_CTL) + CW_BAR;
    XcdBarrier bar; bar.bar = barw; bar.x = 0; bar.st = nullptr;
    if (MK_N_LAUNCHES == 1) bar = xcd_barrier_post(barw, MISC + 8);
    const int lo = args.ph_lo, hi = args.ph_hi;
#define IN(k) (lo <= (k) && (k) < hi)
#define SEAM(k) do { if (IN(k) && IN((k) + 1)) xcd_barrier(bar); } while (0)

    if (IN(0)) { p0_prologue(F); __syncthreads(); }
    SEAM(0);
    if (IN(1)) {
        pg8::Gemm g{WSP(const pg8::bf16_t, WS_XB), WSP(const pg8::bf16_t, WS_WIN), MTOT, NP, DM}; pg8::StaticOrder S; S.init(MTOT, NP, F.G, (int)blockIdx.x);
        EpiProj E{WSP(bf16, WS_PROJ), WSP(const float, WS_RS1), F.out};
        pg8::gemm_phase<EpiProj, pg8::StaticOrder, true, true>(F.lds, g, S, E);
    }
    SEAM(1);
    if (IN(2)) { attn_sample(F); __syncthreads(); ssd_sample(F); __syncthreads(); ssd_phase_a(F); __syncthreads(); attn_prompt_mfma(F); }
    SEAM(2);
    if (IN(3)) { scan_and_attnorm(F); }
    SEAM(3);
    if (IN(4)) { ssd_phase_b(F); }
    SEAM(4);
    if (IN(5)) {
        pg8::Gemm g{WSP(const pg8::bf16_t, WS_MIX), WSP(const pg8::bf16_t, WS_WOUT), MTOT, DM, MIXW}; pg8::StaticOrder S; S.init(MTOT, DM, F.G, (int)blockIdx.x);
        EpiOut E{F.in[0], F.in[1], WSP(float, WS_X1), WSP(bf16, WS_X1B), (float*)(F.ws + CTL_SS2)};
        pg8::gemm_phase<EpiOut, pg8::StaticOrder, true, true>(F.lds, g, S, E);
    }
    SEAM(5);
    if (IN(6)) {
        pg8::Gemm g{WSP(const pg8::bf16_t, WS_X1B), WSP(const pg8::bf16_t, WS_WGU), MTOT, 2 * DFF, DM}; pg8::StaticOrder S; S.init(MTOT, 2 * DFF, F.G, (int)blockIdx.x);
        EpiGU E{WSP(bf16, WS_ACT), (const float*)(F.ws + CTL_SS2)};
        pg8::gemm_phase<EpiGU, pg8::StaticOrder, true, true>(F.lds, g, S, E);
    }
    SEAM(6);
    if (IN(7)) {
        pg8::Gemm g{WSP(const pg8::bf16_t, WS_ACT), WSP(const pg8::bf16_t, WS_WDN), MTOT, DM, DFF}; pg8::StaticOrder S; S.init(MTOT, DM, F.G, (int)blockIdx.x);
        EpiDown E{WSP(const float, WS_X1), F.out, (float*)(F.ws + CTL_SS3)};
        pg8::gemm_phase<EpiDown, pg8::StaticOrder, true, true>(F.lds, g, S, E);
    }
    SEAM(7);
    if (IN(8)) { final_norm(F); }
#undef IN
#undef SEAM
}

extern "C" void kernel_launch(void* const* d_in, const int* in_sizes, int n_in, void* d_out, int out_size, void* d_ws, size_t ws_size, hipStream_t stream) {
    static int grid = 0;
    if (grid == 0) {
        if (n_in != 22 || (size_t)out_size != O_END || ws_size < WS_END) fprintf(stderr, "kernel_launch: unexpected shapes (n_in %d, out %d, ws %zu)\n", n_in, out_size, ws_size);
        int dev = 0, cus = 0, per_cu = 0;
        if (hipGetDevice(&dev) != hipSuccess || hipDeviceGetAttribute(&cus, hipDeviceAttributeMultiprocessorCount, dev) != hipSuccess) { grid = -1; return; }
        if (hipFuncSetAttribute((const void*)fwd, hipFuncAttributeMaxDynamicSharedMemorySize, LDS_BYTES) != hipSuccess) { fprintf(stderr, "kernel_launch: hipFuncSetAttribute failed\n"); grid = -1; return; }
        if (hipOccupancyMaxActiveBlocksPerMultiprocessor(&per_cu, (const void*)fwd, NTHR, LDS_BYTES) != hipSuccess || per_cu < 1) fprintf(stderr, "kernel_launch: occupancy query says %d\n", per_cu);
        (void)hipGetLastError();
        grid = cus;
    }
    if (grid < 0) return;
    if (hipMemsetAsync((char*)d_ws + WS_CTL, 0, CTL_ZERO_BYTES, stream) != hipSuccess) return;
    Args a{};
    for (int i = 0; i < 22; ++i) a.in[i] = (const float*)d_in[i];
    a.out = (float*)d_out; a.ws = (unsigned char*)d_ws;
    if (MK_N_LAUNCHES == 1) { a.ph_lo = 0; a.ph_hi = N_PHASES; hipLaunchKernelGGL(fwd, dim3(grid), dim3(NTHR), LDS_BYTES, stream, a); }
    else { for (int p = 0; p < N_PHASES; ++p) { a.ph_lo = p; a.ph_hi = p + 1; hipLaunchKernelGGL(fwd, dim3(grid), dim3(NTHR), LDS_BYTES, stream, a); } }
}
```

```cpp
#include <hip/hip_runtime.h>
#include <cstdio>
#include <cstdint>
namespace pg8 {
#define PG8_LAS __attribute__((address_space(3)))
typedef unsigned short bf16_t;
typedef short bf16x8 __attribute__((ext_vector_type(8)));
typedef float f32x4 __attribute__((ext_vector_type(4)));
typedef unsigned u32x4 __attribute__((ext_vector_type(4)));
constexpr int BM = 256, BK = 64, HALF = 128, HTB = HALF * BK * 2  , STAGE_BYTES = 8 * HTB, NXCD = 8, WGM = 8;

__host__ __device__ __forceinline__ int lds_byte(int r, int c) { const int st = (r >> 4) * 2 + (c >> 5), rr = r & 15, cc = c & 31, ob = rr * 64 + cc * 2; return st * 1024 + (ob ^ (((ob >> 9) & 1) << 5)); }
__host__ __device__ __forceinline__ void stage_rc(int b, int& R, int& C) { const int st = b / 1024, sb = b % 1024, swz = sb ^ (((sb >> 9) & 1) << 5); R = (st >> 1) * 16 + swz / 64; C = (st & 1) * 32 + (swz % 64) / 2; }
__host__ __device__ __forceinline__ int perm32(int rho) { const int n = rho >> 4, i = rho & 15; return 8 * (i >> 2) + 4 * n + (i & 3); }

struct Unit { int pm, pn; };
struct Gemm { const bf16_t* A; const bf16_t* Bt; int M, N, K; };

struct StaticOrder {
    int nM, nN, nwg, G, c;
    __host__ __device__ void init(int M, int N, int G_, int c_) { nM = M / BM; nN = N / BM; nwg = nM * nN; G = G_; c = c_; }
    __host__ __device__ bool next(int i, Unit& u) const {
        const long L = (long)i * G + c; if (L >= nwg) return false;
        int wgid = (int)L; { const int q = nwg / NXCD, r = nwg % NXCD, xcd = wgid % NXCD, off = wgid / NXCD; wgid = (xcd < r ? xcd * (q + 1) : r * (q + 1) + (xcd - r) * q) + off; }
        const int nig = WGM * nN, gid = wgid / nig, fm = gid * WGM, gsz = (nM - fm) < WGM ? (nM - fm) : WGM;
        u.pm = fm + ((wgid % nig) % gsz); u.pn = (wgid % nig) / gsz; return true;
    }
    __device__ __forceinline__ void a_ready(const Unit&) const {}
    __device__ __forceinline__ void done(const Unit&) const {}
};

__device__ __forceinline__ unsigned cvt_pk_bf16(float lo, float hi) { unsigned r; asm volatile("v_cvt_pk_bf16_f32 %0, %1, %2" : "=v"(r) : "v"(lo), "v"(hi)); return r; }
typedef float f32x2 __attribute__((ext_vector_type(2)));

template <class Epi, class Sched, bool ALIGN_EPI = false, bool SP2 = false>
__device__ __forceinline__ void gemm_phase(PG8_LAS unsigned char* lds, const Gemm g, const Sched& S, const Epi& E) {
    const int tid = threadIdx.x, wid = __builtin_amdgcn_readfirstlane(tid >> 6), lane = tid & 63, wr = wid >> 2, wc = wid & 3, fr = lane & 15, fq = lane >> 4;
    const int K = g.K, nt = K / BK;
    unsigned voffA[2], voffB[2];
#pragma unroll
    for (int i = 0; i < 2; ++i) { int R, C; stage_rc(tid * 16 + i * 8192, R, C); const int Rb = Epi::PERM ? ((R & ~31) + perm32(R & 31)) : R;
        voffA[i] = (unsigned)(R * K + C) * 2u; voffB[i] = (unsigned)(Rb * K + C) * 2u; }
    const size_t kstep = (size_t)(BK * 2);
    const size_t hstep = (size_t)HALF * K * 2;
    const size_t tstep = 2 * hstep;
    const unsigned ldsw = (unsigned)wid * 1024u;
    const int aoff = lds_byte(wr * 64 + fr, fq * 8), boff = lds_byte(wc * 32 + fr, fq * 8);
#define PG8_SA(b, h) (((b) * 2 + (h)) * HTB)
#define PG8_SB(b, h) ((4 + (b) * 2 + (h)) * HTB)
#define PG8_STAGE(bufoff, gbase, voff) do { _Pragma("unroll") for (int _i = 0; _i < 2; ++_i) \
        __builtin_amdgcn_global_load_lds((const unsigned*)((const char*)(gbase) + (voff)[_i]), (PG8_LAS unsigned*)(lds + (bufoff) + ldsw + _i * 8192), 16, 0, 0); } while (0)
#define PG8_LDA(dst, b, h) do { _Pragma("unroll") for (int m = 0; m < 4; ++m) _Pragma("unroll") for (int k = 0; k < 2; ++k) dst[m][k] = *(const PG8_LAS bf16x8*)(lds + PG8_SA(b, h) + aoff + m * 2048 + k * 1024); } while (0)
#define PG8_LDB(dst, b, h) do { _Pragma("unroll") for (int n = 0; n < 2; ++n) _Pragma("unroll") for (int k = 0; k < 2; ++k) dst[n][k] = *(const PG8_LAS bf16x8*)(lds + PG8_SB(b, h) + boff + n * 2048 + k * 1024); } while (0)
#define PG8_MMA(ai, bj, At, Bt) do { __builtin_amdgcn_s_setprio(1); _Pragma("unroll") for (int m = 0; m < 4; ++m) _Pragma("unroll") for (int n = 0; n < 2; ++n) _Pragma("unroll") for (int k = 0; k < 2; ++k) \
        acc[ai][bj][m][n] = __builtin_amdgcn_mfma_f32_16x16x32_bf16(Bt[n][k], At[m][k], acc[ai][bj][m][n], 0, 0, 0); __builtin_amdgcn_s_setprio(0); } while (0)
#define PG8_WAIT_V(n) asm volatile("s_waitcnt vmcnt(" #n ")" ::: "memory")
#define PG8_WAIT_L(n) asm volatile("s_waitcnt lgkmcnt(" #n ")" ::: "memory")
#define PG8_BAR __builtin_amdgcn_s_barrier()
#define PG8_SCHED __builtin_amdgcn_sched_barrier(0)
    Unit cur, nxt; int ui = 0;
    if (!S.next(0, cur)) return;
    f32x4 acc[2][2][4][2];
#pragma unroll
    for (int a = 0; a < 2; ++a)
#pragma unroll
        for (int b = 0; b < 2; ++b)
#pragma unroll
            for (int m = 0; m < 4; ++m)
#pragma unroll
                for (int n = 0; n < 2; ++n) acc[a][b][m][n] = (f32x4){0.f, 0.f, 0.f, 0.f};
    bf16x8 At[4][2], B0[2][2], B1[2][2];
    const char* cA = (const char*)g.A + (size_t)cur.pm * tstep; const char* cB = (const char*)g.Bt + (size_t)cur.pn * tstep;
    S.a_ready(cur);
    if constexpr (SP2) {
        PG8_STAGE(PG8_SB(0, 0), cB, voffB); PG8_STAGE(PG8_SB(0, 1), cB + hstep, voffB); PG8_STAGE(PG8_SA(0, 0), cA, voffA); PG8_STAGE(PG8_SA(0, 1), cA + hstep, voffA);
        if (wr == 1) PG8_BAR;
        PG8_WAIT_V(2); PG8_BAR;
        PG8_STAGE(PG8_SB(1, 0), cB + kstep, voffB); PG8_STAGE(PG8_SA(1, 0), cA + kstep, voffA); PG8_STAGE(PG8_SB(1, 1), cB + hstep + kstep, voffB);
        PG8_WAIT_V(6); PG8_BAR;
    } else {
        PG8_STAGE(PG8_SB(0, 0), cB, voffB); PG8_STAGE(PG8_SA(0, 0), cA, voffA); PG8_STAGE(PG8_SB(0, 1), cB + hstep, voffB); PG8_STAGE(PG8_SA(0, 1), cA + hstep, voffA);
        if (wr == 1) PG8_BAR;
        PG8_WAIT_V(4); PG8_BAR;
        PG8_STAGE(PG8_SB(1, 0), cB + kstep, voffB); PG8_STAGE(PG8_SA(1, 0), cA + kstep, voffA); PG8_STAGE(PG8_SB(1, 1), cB + hstep + kstep, voffB);
        PG8_WAIT_V(6); PG8_BAR;
    }
    for (;;) {
        const bool has_next = S.next(ui + 1, nxt);
        const char* nA = has_next ? (const char*)g.A + (size_t)nxt.pm * tstep : cA; const char* nB = has_next ? (const char*)g.Bt + (size_t)nxt.pn * tstep : cB;
        for (int t = 0; t < nt; t += 2) {
            const bool last = (t == nt - 2);
            const char* a1 = cA + (size_t)(t + 1) * kstep;
            const char* a2 = last ? nA : cA + (size_t)(t + 2) * kstep; const char* b2 = last ? nB : cB + (size_t)(t + 2) * kstep;
            const char* a3 = a2 + kstep; const char* b3 = b2 + kstep;
            if (last && has_next) S.a_ready(nxt);
            if constexpr (SP2) {
            PG8_LDB(B0, 0, 0); PG8_LDB(B1, 0, 1); PG8_SCHED; PG8_LDA(At, 0, 0); PG8_STAGE(PG8_SA(1, 1), a1 + hstep, voffA);
            PG8_WAIT_V(8); PG8_WAIT_L(0); PG8_BAR; PG8_MMA(0, 0, At, B0); PG8_MMA(0, 1, At, B1); PG8_BAR; PG8_SCHED;
            PG8_LDA(At, 0, 1); PG8_STAGE(PG8_SB(0, 0), b2, voffB); PG8_STAGE(PG8_SB(0, 1), b2 + hstep, voffB); PG8_STAGE(PG8_SA(0, 0), a2, voffA);
            PG8_WAIT_V(8); PG8_WAIT_L(0); PG8_BAR; PG8_MMA(1, 0, At, B0); PG8_MMA(1, 1, At, B1); PG8_BAR; PG8_SCHED;
            PG8_LDB(B0, 1, 0); PG8_LDB(B1, 1, 1); PG8_SCHED; PG8_LDA(At, 1, 0); PG8_STAGE(PG8_SA(0, 1), a2 + hstep, voffA);
            PG8_WAIT_V(8); PG8_WAIT_L(0); PG8_BAR; PG8_MMA(0, 0, At, B0); PG8_MMA(0, 1, At, B1); PG8_BAR; PG8_SCHED;
            PG8_LDA(At, 1, 1); PG8_STAGE(PG8_SB(1, 0), b3, voffB); PG8_STAGE(PG8_SB(1, 1), b3 + hstep, voffB); PG8_STAGE(PG8_SA(1, 0), a3, voffA);
            PG8_WAIT_V(8); PG8_WAIT_L(0); PG8_BAR; PG8_MMA(1, 0, At, B0); PG8_MMA(1, 1, At, B1); PG8_BAR; PG8_SCHED;
            } else {
            PG8_LDB(B0, 0, 0); PG8_SCHED; PG8_LDA(At, 0, 0); PG8_STAGE(PG8_SA(1, 1), a1 + hstep, voffA);
            PG8_WAIT_L(8); PG8_BAR; PG8_WAIT_L(0); PG8_MMA(0, 0, At, B0); PG8_BAR; PG8_SCHED;
            PG8_LDB(B1, 0, 1); PG8_STAGE(PG8_SB(0, 0), b2, voffB);
            PG8_BAR; PG8_WAIT_L(0); PG8_MMA(0, 1, At, B1); PG8_BAR;
            PG8_LDA(At, 0, 1); PG8_STAGE(PG8_SA(0, 0), a2, voffA);
            PG8_BAR; PG8_WAIT_L(0); PG8_MMA(1, 0, At, B0); PG8_BAR; PG8_SCHED;
            PG8_STAGE(PG8_SB(0, 1), b2 + hstep, voffB);
            PG8_WAIT_V(6); PG8_BAR; PG8_MMA(1, 1, At, B1); PG8_BAR;
            PG8_LDB(B0, 1, 0); PG8_SCHED; PG8_LDA(At, 1, 0); PG8_STAGE(PG8_SA(0, 1), a2 + hstep, voffA);
            PG8_WAIT_L(8); PG8_BAR; PG8_WAIT_L(0); PG8_MMA(0, 0, At, B0); PG8_BAR; PG8_SCHED;
            PG8_LDB(B1, 1, 1); PG8_STAGE(PG8_SB(1, 0), b3, voffB);
            PG8_BAR; PG8_WAIT_L(0); PG8_MMA(0, 1, At, B1); PG8_BAR;
            PG8_LDA(At, 1, 1); PG8_STAGE(PG8_SA(1, 0), a3, voffA);
            PG8_BAR; PG8_WAIT_L(0); PG8_MMA(1, 0, At, B0); PG8_BAR; PG8_SCHED;
            PG8_STAGE(PG8_SB(1, 1), b3 + hstep, voffB);
            PG8_WAIT_V(6); PG8_BAR; PG8_MMA(1, 1, At, B1); PG8_BAR;
            }
        }
        if constexpr (ALIGN_EPI) { if (wr == 0) PG8_BAR; }
        if constexpr (!Epi::AFTER_DRAIN) { E(acc, cur, wr, wc, fr, fq); S.done(cur); }
        if (!has_next) break;
#pragma unroll
        for (int a = 0; a < 2; ++a)
#pragma unroll
            for (int b = 0; b < 2; ++b)
#pragma unroll
                for (int m = 0; m < 4; ++m)
#pragma unroll
                    for (int n = 0; n < 2; ++n) acc[a][b][m][n] = (f32x4){0.f, 0.f, 0.f, 0.f};
        cur = nxt; cA = nA; cB = nB; ++ui;
        if constexpr (ALIGN_EPI) { if (wr == 1) PG8_BAR; }
    }
    PG8_WAIT_V(0);
    if constexpr (!ALIGN_EPI) { if (wr == 0) PG8_BAR; }
    PG8_BAR;
    if constexpr (Epi::AFTER_DRAIN) { E.fused(acc, cur, wr, wc, fr, fq, lds, wid, lane); S.done(cur); }
#undef PG8_SA
#undef PG8_SB
#undef PG8_STAGE
#undef PG8_LDA
#undef PG8_LDB
#undef PG8_MMA
#undef PG8_WAIT_V
#undef PG8_WAIT_L
#undef PG8_BAR
#undef PG8_SCHED
}
}

constexpr int NWAVES = 8, NTHR = 512;
constexpr int DM = 1024, SEQ = 16384, DB = 128, DSEQ = 4, NSAMP = DB * DSEQ, MTOT = SEQ + NSAMP;
constexpr int AH = 12, HD = 64, ATTW = 768, SH = 20, SSW = 1280, NG = 4, DSTATE = 128, CONVD = 2304, MIXW = 2048, DFF = 2816, DINP = 5908;
constexpr int NP = 6144;
constexpr int CQ = 0, CK = 768, CV = 1536, CZ = 2304, CX = 3584, CDT = 5888;
constexpr int WB = 2048;
constexpr int NCHUNK = 128, CL = 128;
constexpr float EPS = 1e-6f;
constexpr size_t O_YP = 0, O_YS = O_YP + (size_t)SEQ * DM, O_WKP = O_YS + (size_t)NSAMP * DM, O_WVP = O_WKP + (size_t)2048 * ATTW, O_CVP = O_WVP + (size_t)2048 * ATTW,
                 O_SSP = O_CVP + 3 * CONVD, O_WKS = O_SSP + (size_t)SH * HD * DSTATE, O_WVS = O_WKS + (size_t)NSAMP * ATTW, O_CVS = O_WVS + (size_t)NSAMP * ATTW,
                 O_SSS = O_CVS + (size_t)DB * 3 * CONVD, O_END = O_SSS + (size_t)DB * SH * HD * DSTATE;
constexpr size_t MiB = 1u << 20;
constexpr size_t WS_CTL = 0, CTL_ZERO_BYTES = 1 * MiB;
constexpr size_t CTL_SS2 = 256 * 1024, CTL_SS3 = 384 * 1024;
constexpr size_t WS_WIN = 2 * MiB;
constexpr size_t WS_WOUT = WS_WIN + (size_t)NP * DM * 2;
constexpr size_t WS_WGU = WS_WOUT + (size_t)DM * MIXW * 2;
constexpr size_t WS_WDN = WS_WGU + (size_t)2 * DFF * DM * 2;
constexpr size_t WS_BKT = WS_WDN + (size_t)DM * DFF * 2;
constexpr size_t WS_RS1 = WS_BKT + 16384;
constexpr size_t WS_ATTSS = WS_RS1 + (size_t)MTOT * 4;
constexpr size_t WS_DTB = WS_ATTSS + (size_t)MTOT * 12 * 4;
constexpr size_t WS_ACS = WS_DTB + (size_t)SEQ * 20 * 4;
constexpr size_t WS_CDEC = WS_ACS + (size_t)SEQ * 20 * 4;
constexpr size_t WS_XB = 64 * MiB;
constexpr size_t WS_PROJ = WS_XB + (size_t)MTOT * DM * 2;
constexpr size_t WS_MIX = WS_PROJ + (size_t)MTOT * NP * 2;
constexpr size_t WS_X1 = WS_MIX + (size_t)MTOT * MIXW * 2;
constexpr size_t WS_X1B = WS_X1 + (size_t)MTOT * DM * 4;
constexpr size_t WS_ACT = WS_X1B + (size_t)MTOT * DM * 2;
constexpr size_t WS_XC = WS_ACT + (size_t)MTOT * DFF * 2;
constexpr size_t WS_ST = WS_XC + (size_t)SEQ * CONVD * 2;
constexpr size_t WS_OPART = WS_ST + (size_t)NCHUNK * SH * HD * DSTATE * 4;
constexpr size_t WS_ML = WS_OPART + (size_t)3 * SEQ * ATTW * 2;
constexpr size_t WS_HIN = WS_ML + (size_t)3 * SEQ * AH * 2 * 4;
constexpr size_t WS_END = WS_HIN + (size_t)NCHUNK * SH * HD * DSTATE * 2;
static_assert(WS_CDEC + 128 * 20 * 4 <= WS_XB, "ws map");
constexpr int CW_BAR = 1024;
constexpr int RING_BYTES = 131072;
constexpr int MISC_OFF = 155648;
constexpr int LDS_BYTES = 155648 + 256;

#define GAS __attribute__((address_space(1)))
#define LAS __attribute__((address_space(3)))
typedef unsigned short bf16;
typedef unsigned v4u __attribute__((ext_vector_type(4)));
typedef float f32x4 __attribute__((ext_vector_type(4)));
typedef short bf16x8 __attribute__((ext_vector_type(8)));
typedef GAS unsigned gu32;
typedef GAS unsigned long long gu64;
#define RLX_AGENT __ATOMIC_RELAXED, __HIP_MEMORY_SCOPE_AGENT
#define LDS_WAIT() asm volatile("s_waitcnt lgkmcnt(0)" ::: "memory")
#define VM_WAIT() asm volatile("s_waitcnt vmcnt(0)" ::: "memory")
__device__ __forceinline__ unsigned long long rt() { return __builtin_amdgcn_s_memrealtime(); }
__device__ __forceinline__ unsigned f2bf(float f) { unsigned u = __builtin_bit_cast(unsigned, f); return (u + 0x7fffu + ((u >> 16) & 1u)) >> 16; }
__device__ __forceinline__ unsigned pk2(float lo, float hi) { return f2bf(lo) | (f2bf(hi) << 16); }

#define XB_TMO      128
#define XB_XCNT(j)  (256  + 64 * (j))
#define XB_XSUB(j)  (1280 + 64 * (j))
#define XB_XGEN(j)  (2304 + 64 * (j))
#define XB_TOP      3328
#define XB_TOPGEN   3392
#define XCD_BAR_WORDS 3456
#define XB_SPIN_CAP (1u << 23)

__device__ __forceinline__ unsigned xb_ld(unsigned* p)              { return __hip_atomic_load(p, __ATOMIC_RELAXED, __HIP_MEMORY_SCOPE_AGENT); }
__device__ __forceinline__ unsigned xb_add(unsigned* p, unsigned v) { return __hip_atomic_fetch_add(p, v, __ATOMIC_RELAXED, __HIP_MEMORY_SCOPE_AGENT); }
__device__ __forceinline__ unsigned xb_xcc_id() { return (unsigned)__builtin_amdgcn_s_getreg((3 << 11) | 20) & 0xFu; }
#define XB_SPIN(cond, bar) do { unsigned _sp = 0; while (cond) { __builtin_amdgcn_s_sleep(1); \
    if ((++_sp & 255u) == 0u) { if (xb_ld(&(bar)[XB_TMO])) break; if (_sp > XB_SPIN_CAP) { atomicAdd(&(bar)[XB_TMO], 1u); break; } } } } while (0)

struct XcdBarrier {
    unsigned* bar; unsigned x;
    volatile LAS unsigned* st;
};

__device__ __forceinline__ XcdBarrier xcd_barrier_post(unsigned* bar, volatile LAS unsigned* st) {
    XcdBarrier b; b.bar = bar; b.x = xb_xcc_id(); b.st = st;
    if (threadIdx.x == 0) (void)xb_add(&bar[XB_XCNT(b.x)], 1u);
    return b;
}
__device__ __forceinline__ void xcd_barrier_complete(unsigned* bar, unsigned x, unsigned& nloc, unsigned& nx) {
    const unsigned G = gridDim.x * gridDim.y * gridDim.z;
    unsigned sum, cnt, mine, sp = 0u;
    for (;;) {
        sum = 0u; cnt = 0u; mine = 0u;
#pragma unroll
        for (unsigned j = 0; j < 16; ++j) { const unsigned c = xb_ld(&bar[XB_XCNT(j)]); sum += c; cnt += (c > 0u) ? 1u : 0u; mine = (j == x) ? c : mine; }
        if (sum == G) break;
        __builtin_amdgcn_s_sleep(1);
        if ((++sp & 255u) == 0u) { if (xb_ld(&bar[XB_TMO])) break; if (sp > XB_SPIN_CAP) { atomicAdd(&bar[XB_TMO], 1u); break; } }
    }
    nloc = mine > 0u ? mine : 1u; nx = cnt > 0u ? cnt : 1u;
}

__device__ __forceinline__ void xcd_barrier(const XcdBarrier& b) {
    asm volatile("s_waitcnt vmcnt(0)" ::: "memory");
    __syncthreads();
    if (threadIdx.x == 0) {
        unsigned* bar = b.bar;
        __builtin_amdgcn_s_waitcnt(0);
        unsigned nloc = b.st[0], nx = b.st[1];
        if (nloc == 0u) { xcd_barrier_complete(bar, b.x, nloc, nx); b.st[0] = nloc; b.st[1] = nx; }
        const unsigned old = xb_add(&bar[XB_XSUB(b.x)], 1u);
        const unsigned gen = old / nloc;
        if (old + 1u == (gen + 1u) * nloc) {
            __builtin_amdgcn_fence(__ATOMIC_RELEASE, "agent");
            asm volatile("s_waitcnt vmcnt(0)" ::: "memory");
            const unsigned og = xb_add(&bar[XB_TOP], 1u);
            const unsigned tg = og / nx;
            if (og + 1u == (tg + 1u) * nx) xb_add(&bar[XB_TOPGEN], 1u);
            else XB_SPIN(xb_ld(&bar[XB_TOPGEN]) == tg, bar);
            __builtin_amdgcn_fence(__ATOMIC_ACQUIRE, "agent");
            xb_add(&bar[XB_XGEN(b.x)], 1u);
            asm volatile("s_waitcnt vmcnt(0)" ::: "memory");
        } else {
            XB_SPIN(xb_ld(&bar[XB_XGEN(b.x)]) == gen, bar);
            __builtin_amdgcn_fence(__ATOMIC_ACQUIRE, "agent");
            asm volatile("s_waitcnt vmcnt(0)" ::: "memory");
        }
    }
    __syncthreads();
}

__device__ __forceinline__ float bf2f(unsigned short u) { return __uint_as_float((unsigned)u << 16); }
__device__ __forceinline__ float wave_sum(float v) {
#pragma unroll
    for (int o = 1; o < 64; o <<= 1) v += __shfl_xor(v, o);
    return v;
}
__device__ __forceinline__ float silu_f(float x) { return x / (1.f + __expf(-x)); }
__device__ __forceinline__ float softplus_f(float x) { return x > 20.f ? x : log1pf(__expf(x)); }
__device__ __forceinline__ int rel_bucket(int n) {
    if (n < 16) return n;
    const float v = logf((float)n / 16.0f) / 4.852030263919617f * 16.0f;
    int b = 16 + (int)v; return b > 31 ? 31 : b;
}
__device__ __forceinline__ int attn_mult(int delta) {
    return (delta <= 128 ? 1 : 0) + (((delta & 3) == 0 && delta <= 512) ? 1 : 0) + (((delta & 15) == 0 && delta <= 2048) ? 1 : 0);
}

struct Frame {
    LAS unsigned char* lds;
    int tid, lane, wave, G;
    const float* in[22]; float* out; unsigned char* ws;
};
#define WSP(T, off) ((T*)(F.ws + (off)))

template <int MODE>
__device__ __forceinline__ void tr_item(const float* W, int K, int N, const float* gain, bf16* WT, LAS float* scr, int kb, int nb, int lane) {
    const int k0 = 64 * kb, n0 = 32 * nb;
    {
        const int n = n0 + (lane & 31);
#pragma unroll 8
        for (int i = 0; i < 32; ++i) { const int kk = 2 * i + (lane >> 5); float v = (n < N) ? W[(size_t)(k0 + kk) * N + n] : 0.f; if (gain) v *= gain[k0 + kk]; scr[kk * 33 + (lane & 31)] = v; }
    }
    LDS_WAIT(); asm volatile("" ::: "memory");
    const int c = lane & 7;
#pragma unroll
    for (int j = 0; j < 4; ++j) { const int nl = (lane >> 3) + 8 * j, n = n0 + nl; const LAS float* s = scr + (8 * c) * 33 + nl;
        v4u o; o.x = pk2(s[0 * 33], s[1 * 33]); o.y = pk2(s[2 * 33], s[3 * 33]); o.z = pk2(s[4 * 33], s[5 * 33]); o.w = pk2(s[6 * 33], s[7 * 33]);
        int drow = n; if (MODE == 1) drow = (n >> 7) * 256 + (n & 127); if (MODE == 2) drow = (n >> 7) * 256 + 128 + (n & 127);
        *(GAS v4u*)(WT + (size_t)drow * K + k0 + 8 * c) = o; }
    LDS_WAIT(); asm volatile("" ::: "memory");
}
__device__ __forceinline__ void p0_prologue(Frame& F) {
    LAS float* scr = (LAS float*)(F.lds + F.wave * 16384);
    const int gw = blockIdx.x * NWAVES + F.wave, NGW = F.G * NWAVES;
    constexpr int I_IN = 16 * 192, I_OUT = 32 * 32, I_G = 16 * 88, I_D = 44 * 32;
    constexpr int NITEMS = I_IN + I_OUT + 2 * I_G + I_D;
    for (int it = gw; it < NITEMS; it += NGW) {
        int r = it;
        if (r < I_IN) { tr_item<0>(F.in[8], DM, DINP, F.in[7], WSP(bf16, WS_WIN), scr, r / 192, r % 192, F.lane); continue; } r -= I_IN;
        if (r < I_OUT) { tr_item<0>(F.in[16], MIXW, DM, nullptr, WSP(bf16, WS_WOUT), scr, r / 32, r % 32, F.lane); continue; } r -= I_OUT;
        if (r < I_G) { tr_item<1>(F.in[18], DM, DFF, F.in[17], WSP(bf16, WS_WGU), scr, r / 88, r % 88, F.lane); continue; } r -= I_G;
        if (r < I_G) { tr_item<2>(F.in[19], DM, DFF, F.in[17], WSP(bf16, WS_WGU), scr, r / 88, r % 88, F.lane); continue; } r -= I_G;
        tr_item<0>(F.in[20], DFF, DM, nullptr, WSP(bf16, WS_WDN), scr, r / 32, r % 32, F.lane);
    }
    bf16* XB = WSP(bf16, WS_XB); float* RS1 = WSP(float, WS_RS1);
    for (int m = gw; m < MTOT; m += NGW) {
        const float* xrow = m < SEQ ? F.in[0] + (size_t)m * DM : F.in[1] + (size_t)(m - SEQ) * DM;
        const GAS f32x4* xr = (const GAS f32x4*)xrow + F.lane;
        f32x4 v[4]; float s = 0.f;
#pragma unroll
        for (int j = 0; j < 4; ++j) { v[j] = xr[64 * j]; s += (v[j].x * v[j].x + v[j].y * v[j].y) + (v[j].z * v[j].z + v[j].w * v[j].w); }
        s = wave_sum(s);
        GAS unsigned long long* o8 = (GAS unsigned long long*)(XB + (size_t)m * DM) + F.lane;
#pragma unroll
        for (int j = 0; j < 4; ++j) o8[64 * j] = (unsigned long long)pk2(v[j].x, v[j].y) | ((unsigned long long)pk2(v[j].z, v[j].w) << 32);
        if (F.lane == 0) RS1[m] = 1.0f / sqrtf(s * (1.0f / DM) + EPS);
    }
    int* BKT = WSP(int, WS_BKT);
    for (int i = blockIdx.x * NTHR + F.tid; i <= 2048; i += F.G * NTHR) BKT[i] = rel_bucket(i);
}

struct EpiProj {
    static constexpr bool PERM = true, AFTER_DRAIN = false;
    bf16* O; const float* rs; float* out;
    __device__ __forceinline__ void operator()(const pg8::f32x4 (&acc)[2][2][4][2], const pg8::Unit& u, int wr, int wc, int fr, int fq) const {
        const int row0 = u.pm * 256 + wr * 64 + fr, col0 = u.pn * 256 + wc * 32 + 8 * fq;
        const bool kv = (u.pm >= 56) && (u.pn >= 3) && (u.pn < 9); const bool is_k = u.pn < 6;
#pragma unroll
        for (int ai = 0; ai < 2; ++ai)
#pragma unroll
            for (int m = 0; m < 4; ++m) { const int row = row0 + ai * 128 + m * 16; const float s = rs[row];
#pragma unroll
                for (int bj = 0; bj < 2; ++bj) { const int col = col0 + bj * 128; const pg8::f32x4 v0 = acc[ai][bj][m][0] * s, v1 = acc[ai][bj][m][1] * s;
                    pg8::u32x4 w; w.x = pg8::cvt_pk_bf16(v0[0], v0[1]); w.y = pg8::cvt_pk_bf16(v0[2], v0[3]); w.z = pg8::cvt_pk_bf16(v1[0], v1[1]); w.w = pg8::cvt_pk_bf16(v1[2], v1[3]);
                    *(pg8::u32x4*)(O + (size_t)row * NP + col) = w;
                    if (kv) { const int cc = col - (is_k ? CK : CV);
                        float* dst = row < SEQ ? out + (is_k ? O_WKP : O_WVP) + (size_t)(row - (SEQ - 2048)) * ATTW + cc : out + (is_k ? O_WKS : O_WVS) + (size_t)(row - SEQ) * ATTW + cc;
                        *(pg8::f32x4*)dst = v0; *(pg8::f32x4*)(dst + 4) = v1; } } }
    }
};
struct EpiOut {
    static constexpr bool PERM = false, AFTER_DRAIN = false;
    const float* xp; const float* xs; float* X1; bf16* X1B; float* SS;
    __device__ __forceinline__ void operator()(const pg8::f32x4 (&acc)[2][2][4][2], const pg8::Unit& u, int wr, int wc, int fr, int fq) const {
        const int row0 = u.pm * 256 + wr * 64 + fr, col0 = u.pn * 256 + wc * 32 + 4 * fq;
#pragma unroll
        for (int ai = 0; ai < 2; ++ai)
#pragma unroll
            for (int m = 0; m < 4; ++m) { const int row = row0 + ai * 128 + m * 16; const float* xr = row < SEQ ? xp + (size_t)row * DM : xs + (size_t)(row - SEQ) * DM; float ss = 0.f;
#pragma unroll
                for (int bj = 0; bj < 2; ++bj)
#pragma unroll
                    for (int n = 0; n < 2; ++n) { const int col = col0 + bj * 128 + n * 16; const pg8::f32x4 v = acc[ai][bj][m][n] + *(const pg8::f32x4*)(xr + col);
                        *(pg8::f32x4*)(X1 + (size_t)row * DM + col) = v; ss += (v[0] * v[0] + v[1] * v[1]) + (v[2] * v[2] + v[3] * v[3]);
                        *(unsigned long long*)(X1B + (size_t)row * DM + col) = (unsigned long long)pg8::cvt_pk_bf16(v[0], v[1]) | ((unsigned long long)pg8::cvt_pk_bf16(v[2], v[3]) << 32); }
                ss += __shfl_xor(ss, 16); ss += __shfl_xor(ss, 32);
                if (fq == 0) atomicAdd(SS + row, ss); }
    }
};
struct EpiGU {
    static constexpr bool PERM = true, AFTER_DRAIN = false;
    bf16* ACT; const float* SS;
    __device__ __forceinline__ void operator()(const pg8::f32x4 (&acc)[2][2][4][2], const pg8::Unit& u, int wr, int wc, int fr, int fq) const {
        const int row0 = u.pm * 256 + wr * 64 + fr, col0 = u.pn * 128 + wc * 32 + 8 * fq;
#pragma unroll
        for (int ai = 0; ai < 2; ++ai)
#pragma unroll
            for (int m = 0; m < 4; ++m) { const int row = row0 + ai * 128 + m * 16; const float s = 1.0f / sqrtf(SS[row] * (1.0f / DM) + EPS);
                float a[8];
#pragma unroll
                for (int n = 0; n < 2; ++n)
#pragma unroll
                    for (int e = 0; e < 4; ++e) { const float g = acc[ai][0][m][n][e] * s, uu = acc[ai][1][m][n][e] * s; a[4 * n + e] = silu_f(g) * uu; }
                pg8::u32x4 w; w.x = pg8::cvt_pk_bf16(a[0], a[1]); w.y = pg8::cvt_pk_bf16(a[2], a[3]); w.z = pg8::cvt_pk_bf16(a[4], a[5]); w.w = pg8::cvt_pk_bf16(a[6], a[7]);
                *(pg8::u32x4*)(ACT + (size_t)row * DFF + col0) = w; }
    }
};
struct EpiDown {
    static constexpr bool PERM = false, AFTER_DRAIN = false;
    const float* X1; float* Y; float* SS;
    __device__ __forceinline__ void operator()(const pg8::f32x4 (&acc)[2][2][4][2], const pg8::Unit& u, int wr, int wc, int fr, int fq) const {
        const int row0 = u.pm * 256 + wr * 64 + fr, col0 = u.pn * 256 + wc * 32 + 4 * fq;
#pragma unroll
        for (int ai = 0; ai < 2; ++ai)
#pragma unroll
            for (int m = 0; m < 4; ++m) { const int row = row0 + ai * 128 + m * 16; float ss = 0.f;
#pragma unroll
                for (int bj = 0; bj < 2; ++bj)
#pragma unroll
                    for (int n = 0; n < 2; ++n) { const int col = col0 + bj * 128 + n * 16; const pg8::f32x4 v = acc[ai][bj][m][n] + *(const pg8::f32x4*)(X1 + (size_t)row * DM + col);
                        *(pg8::f32x4*)(Y + (size_t)row * DM + col) = v; ss += (v[0] * v[0] + v[1] * v[1]) + (v[2] * v[2] + v[3] * v[3]); }
                ss += __shfl_xor(ss, 16); ss += __shfl_xor(ss, 32);
                if (fq == 0) atomicAdd(SS + row, ss); }
    }
};

__device__ __forceinline__ void attn_prompt_simple(Frame& F) {
    const bf16* PROJ = WSP(bf16, WS_PROJ); bf16* MIX = WSP(bf16, WS_MIX); float* ATTSS = WSP(float, WS_ATTSS);
    const int* BKT = WSP(int, WS_BKT); const float* relb = F.in[6];
    const int gw = blockIdx.x * NWAVES + F.wave, NGW = F.G * NWAVES, lane = F.lane;
    for (int t = gw; t < SEQ; t += NGW) {
        for (int h = 0; h < AH; ++h) {
            const float q = bf2f(PROJ[(size_t)t * NP + CQ + h * 64 + lane]) * 0.125f;
            float m = -1e30f, l = 0.f, o = 0.f;
            for (int br = 0; br < 3; ++br) {
                const int d = (br == 0) ? 1 : (br == 1) ? 4 : 16;
                int imax = t / d; if (imax > 128) imax = 128;
                int i = 0;
                for (; i + 3 <= imax; i += 4) {
                    float k[4], v[4], s[4];
#pragma unroll
                    for (int j = 0; j < 4; ++j) { const bf16* kp = PROJ + (size_t)(t - (i + j) * d) * NP + CK + h * 64 + lane; k[j] = bf2f(kp[0]); v[j] = bf2f(kp[CV - CK]); s[j] = q * k[j]; }
#pragma unroll
                    for (int o_ = 1; o_ < 64; o_ <<= 1) {
#pragma unroll
                        for (int j = 0; j < 4; ++j) s[j] += __shfl_xor(s[j], o_); }
#pragma unroll
                    for (int j = 0; j < 4; ++j) s[j] += relb[BKT[(i + j) * d] * AH + h];
                    const float mn = fmaxf(fmaxf(fmaxf(m, s[0]), fmaxf(s[1], s[2])), s[3]);
                    const float a = __expf(m - mn); l *= a; o *= a; m = mn;
#pragma unroll
                    for (int j = 0; j < 4; ++j) { const float p = __expf(s[j] - mn); l += p; o += p * v[j]; }
                }
                for (; i <= imax; ++i) {
                    const bf16* kp = PROJ + (size_t)(t - i * d) * NP + CK + h * 64 + lane;
                    const float kk = bf2f(kp[0]), vv = bf2f(kp[CV - CK]);
                    const float s = wave_sum(q * kk) + relb[BKT[i * d] * AH + h];
                    const float mn = fmaxf(m, s); const float a = __expf(m - mn), p = __expf(s - mn);
                    l = l * a + p; o = o * a + p * vv; m = mn;
                }
            }
            const float r = o / l;
            MIX[(size_t)t * MIXW + h * 64 + lane] = (bf16)f2bf(r);
            const float sq = wave_sum(r * r); if (lane == 0) ATTSS[t * AH + h] = sq;
        }
    }
}


typedef short v4i16_t __attribute__((ext_vector_type(4)));
typedef float f32x16 __attribute__((ext_vector_type(16)));
__device__ __forceinline__ void attn_prompt_mfma(Frame& F) {
    const bf16* PROJ = WSP(bf16, WS_PROJ); bf16* OPART = WSP(bf16, WS_OPART); float* ML = WSP(float, WS_ML);
    const int* BKT = WSP(int, WS_BKT); const float* relb = F.in[6];
    LAS unsigned char* Kl = F.lds; LAS unsigned char* Vl = F.lds + 49152; LAS float* btab = (LAS float*)(F.lds + 98304);
    const int tid = F.tid, lane = F.lane, wave = F.wave, q = lane & 31, hi = lane >> 5;
    constexpr float LOG2E = 1.4426950408889634f, C1 = 0.125f * LOG2E, NEG = -1e30f;
    for (int unit = blockIdx.x; unit < 3 * AH * 64; unit += F.G) {
        const int br = unit / 768, rem = unit % 768, h = rem >> 6, blk = rem & 63;
        const int dsh = 2 * br, d = 1 << dsh, r = blk & (d - 1), qb = blk >> dsh, j0 = qb * 256;
        for (int n = wave; n < 48; n += 8) {
            const int row = 8 * n + (lane >> 3), pc = lane & 7; int jj = j0 - 128 + row; if (jj < 0) jj = 0;
            const size_t tok = (size_t)jj * d + r;
            const int lcK = pc ^ ((row >> 1) & 7), lcV = pc ^ (((row >> 1) & 1) << 2);
            __builtin_amdgcn_global_load_lds((const unsigned*)(PROJ + tok * NP + CK + h * 64 + lcK * 8), (LAS unsigned*)(Kl + n * 1024), 16, 0, 0);
            __builtin_amdgcn_global_load_lds((const unsigned*)(PROJ + tok * NP + CV + h * 64 + lcV * 8), (LAS unsigned*)(Vl + n * 1024), 16, 0, 0);
        }
        if (tid < 129) btab[tid] = relb[BKT[tid * d] * AH + h] * LOG2E;
        const size_t tokq = (size_t)(j0 + 32 * wave + q) * d + r;
        bf16x8 qf[4];
#pragma unroll
        for (int s = 0; s < 4; ++s) qf[s] = *(const bf16x8*)(PROJ + tokq * NP + CQ + h * 64 + 16 * s + 8 * hi);
        asm volatile("s_waitcnt vmcnt(0)" ::: "memory");
        __syncthreads();
        f32x16 S[5];
#pragma unroll
        for (int kt = 0; kt < 5; ++kt) {
            const int row0 = 32 * (wave + kt);
            if (j0 - 128 + row0 >= 0) {
                f32x16 acc;
#pragma unroll
                for (int e = 0; e < 16; ++e) acc[e] = 0.f;
                const int krow = row0 + q;
#pragma unroll
                for (int s = 0; s < 4; ++s) { const bf16x8 kf = *(const LAS bf16x8*)(Kl + krow * 128 + (((2 * s + hi) ^ ((krow >> 1) & 7)) << 4));
                    acc = __builtin_amdgcn_mfma_f32_32x32x16_bf16(kf, qf[s], acc, 0, 0, 0); }
#pragma unroll
                for (int e = 0; e < 16; ++e) { const int kl = (e & 3) + 8 * (e >> 2) + 4 * hi; const int i = 128 - 32 * kt + q - kl;
                    const int ic = i < 0 ? 0 : (i > 128 ? 128 : i);
                    const float v = acc[e] * C1 + btab[ic];
                    S[kt][e] = (kt == 0 || kt == 4) ? ((i >= 0 && i <= 128) ? v : NEG) : v; }
            } else {
#pragma unroll
                for (int e = 0; e < 16; ++e) S[kt][e] = NEG;
            }
        }
        float m = NEG;
#pragma unroll
        for (int kt = 0; kt < 5; ++kt)
#pragma unroll
            for (int e = 0; e < 16; ++e) m = fmaxf(m, S[kt][e]);
        m = fmaxf(m, __shfl_xor(m, 32));
        float l = 0.f;
        bf16x8 Pk[5][2];
#pragma unroll
        for (int kt = 0; kt < 5; ++kt) {
#pragma unroll
            for (int e = 0; e < 16; ++e) { const float p = __builtin_amdgcn_exp2f(S[kt][e] - m); S[kt][e] = p; l += p; }
#pragma unroll
            for (int s2 = 0; s2 < 2; ++s2) { v4u w; w.x = pk2(S[kt][8 * s2 + 0], S[kt][8 * s2 + 1]); w.y = pk2(S[kt][8 * s2 + 2], S[kt][8 * s2 + 3]); w.z = pk2(S[kt][8 * s2 + 4], S[kt][8 * s2 + 5]); w.w = pk2(S[kt][8 * s2 + 6], S[kt][8 * s2 + 7]);
                Pk[kt][s2] = __builtin_bit_cast(bf16x8, w); }
        }
        l += __shfl_xor(l, 32);
        f32x16 OT[2];
#pragma unroll
        for (int e = 0; e < 16; ++e) { OT[0][e] = 0.f; OT[1][e] = 0.f; }
        const int g2 = (lane >> 4) & 1, qq = (lane & 15) >> 2, pp = lane & 3;
#pragma unroll
        for (int kt = 0; kt < 5; ++kt) {
            const int row0 = 32 * (wave + kt);
            if (j0 - 128 + row0 >= 0) {
#pragma unroll
                for (int s2 = 0; s2 < 2; ++s2)
#pragma unroll
                    for (int d0 = 0; d0 < 2; ++d0) {
                        const int rlo = row0 + 16 * s2 + 4 * hi + qq, rhi = rlo + 8;
                        const int lc = 4 * d0 + 2 * g2 + (pp >> 1);
                        const LAS unsigned char* alo = Vl + rlo * 128 + ((lc ^ (((rlo >> 1) & 1) << 2)) << 4) + 8 * (pp & 1);
                        const LAS unsigned char* ahi = Vl + rhi * 128 + ((lc ^ (((rhi >> 1) & 1) << 2)) << 4) + 8 * (pp & 1);
                        const v4i16_t lo = __builtin_amdgcn_ds_read_tr16_b64_v4i16((LAS v4i16_t*)alo);
                        const v4i16_t hh = __builtin_amdgcn_ds_read_tr16_b64_v4i16((LAS v4i16_t*)ahi);
                        const bf16x8 vf = (bf16x8){lo[0], lo[1], lo[2], lo[3], hh[0], hh[1], hh[2], hh[3]};
                        OT[d0] = __builtin_amdgcn_mfma_f32_32x32x16_bf16(vf, Pk[kt][s2], OT[d0], 0, 0, 0);
                    }
            }
        }
        const float inv = 1.0f / l;
        bf16* op = OPART + ((size_t)br * SEQ + tokq) * ATTW + h * 64;
#pragma unroll
        for (int d0 = 0; d0 < 2; ++d0)
#pragma unroll
            for (int g = 0; g < 4; ++g) { const int dd = 32 * d0 + 8 * g + 4 * hi;
                *(unsigned long long*)(op + dd) = (unsigned long long)pk2(OT[d0][4 * g] * inv, OT[d0][4 * g + 1] * inv) | ((unsigned long long)pk2(OT[d0][4 * g + 2] * inv, OT[d0][4 * g + 3] * inv) << 32); }
        if (hi == 0) { float* mp = ML + (((size_t)br * SEQ + tokq) * AH + h) * 2; mp[0] = m; mp[1] = l; }
        __syncthreads();
    }
}

__device__ __forceinline__ void attn_sample(Frame& F) {
    const bf16* PROJ = WSP(bf16, WS_PROJ); bf16* MIX = WSP(bf16, WS_MIX); float* ATTSS = WSP(float, WS_ATTSS);
    const int* BKT = WSP(int, WS_BKT); const float* relb = F.in[6];
    const float* cache_k = F.in[2]; const float* cache_v = F.in[3];
    const int lane = F.lane, wave = F.wave, hl = lane >> 4, d0 = 4 * (lane & 15);
    LAS float* comb = (LAS float*)F.lds;
    for (int unit = blockIdx.x; unit < DB * 3; unit += F.G) {
        const int b = unit / 3, hg = unit % 3, head = hg * 4 + hl;
        float q[4][4];
#pragma unroll
        for (int t = 0; t < 4; ++t) { const bf16* qp = PROJ + (size_t)(SEQ + 4 * b + t) * NP + CQ + head * 64 + d0;
#pragma unroll
            for (int e = 0; e < 4; ++e) q[t][e] = bf2f(qp[e]) * 0.125f; }
        float m[4], l[4], o[4][4];
#pragma unroll
        for (int t = 0; t < 4; ++t) { m[t] = -1e30f; l[t] = 0.f;
#pragma unroll
            for (int e = 0; e < 4; ++e) o[t][e] = 0.f; }
        for (int e = wave; e < 900; e += 8) {
            const int rho = e < 384 ? 16 * (e >> 2) + (e & 3) : (e < 768 ? 1536 + (e - 384) : 1920 + (e - 768));
            f32x4 kk, vv;
            if (rho < WB) { const size_t off = (((size_t)b * WB + rho) * AH + head) * HD + d0; kk = *(const f32x4*)(cache_k + off); vv = *(const f32x4*)(cache_v + off); }
            else { const bf16* kp = PROJ + (size_t)(SEQ + 4 * b + (rho - WB)) * NP + CK + head * 64 + d0;
                kk = (f32x4){bf2f(kp[0]), bf2f(kp[1]), bf2f(kp[2]), bf2f(kp[3])}; vv = (f32x4){bf2f(kp[CV - CK]), bf2f(kp[CV - CK + 1]), bf2f(kp[CV - CK + 2]), bf2f(kp[CV - CK + 3])}; }
#pragma unroll
            for (int t = 0; t < 4; ++t) {
                const int delta = WB + t - rho;
                if (delta < 0) continue;
                const int mu = attn_mult(delta);
                if (mu == 0) continue;
                float s = (q[t][0] * kk[0] + q[t][1] * kk[1]) + (q[t][2] * kk[2] + q[t][3] * kk[3]);
                s += __shfl_xor(s, 1); s += __shfl_xor(s, 2); s += __shfl_xor(s, 4); s += __shfl_xor(s, 8);
                s += relb[BKT[delta] * AH + head];
                const float mn = fmaxf(m[t], s); const float a = __expf(m[t] - mn), p = (float)mu * __expf(s - mn);
                l[t] = l[t] * a + p; m[t] = mn;
#pragma unroll
                for (int e2 = 0; e2 < 4; ++e2) o[t][e2] = o[t][e2] * a + p * vv[e2];
            }
        }
#pragma unroll
        for (int t = 0; t < 4; ++t) { LAS float* c = comb + ((wave * 4 + t) * 64 + lane) * 6; c[0] = m[t]; c[1] = l[t]; c[2] = o[t][0]; c[3] = o[t][1]; c[4] = o[t][2]; c[5] = o[t][3]; }
        __syncthreads();
        if (F.tid < 256) {
            const int t = F.tid >> 6;
            float mm = -1e30f;
#pragma unroll
            for (int w = 0; w < 8; ++w) mm = fmaxf(mm, comb[((w * 4 + t) * 64 + lane) * 6]);
            float ll = 0.f, oo[4] = {0.f, 0.f, 0.f, 0.f};
#pragma unroll
            for (int w = 0; w < 8; ++w) { const LAS float* c = comb + ((w * 4 + t) * 64 + lane) * 6; const float a = __expf(c[0] - mm); ll += c[1] * a;
#pragma unroll
                for (int e2 = 0; e2 < 4; ++e2) oo[e2] += c[2 + e2] * a; }
            const float inv = 1.0f / ll; float sq = 0.f;
#pragma unroll
            for (int e2 = 0; e2 < 4; ++e2) { oo[e2] *= inv; sq += oo[e2] * oo[e2]; }
            const int row = SEQ + 4 * b + t;
            *(unsigned long long*)(MIX + (size_t)row * MIXW + head * 64 + d0) = (unsigned long long)pk2(oo[0], oo[1]) | ((unsigned long long)pk2(oo[2], oo[3]) << 32);
            sq += __shfl_xor(sq, 1); sq += __shfl_xor(sq, 2); sq += __shfl_xor(sq, 4); sq += __shfl_xor(sq, 8);
            if ((lane & 15) == 0) ATTSS[row * AH + head] = sq;
        }
        __syncthreads();
    }
}

__device__ __forceinline__ void ssd_phase_a(Frame& F) {
    const bf16* PROJ = WSP(bf16, WS_PROJ); bf16* XC = WSP(bf16, WS_XC); float* DTB = WSP(float, WS_DTB); float* ACS = WSP(float, WS_ACS); float* CDEC = WSP(float, WS_CDEC); float* ST = WSP(float, WS_ST);
    const float* conv_w = F.in[9]; const float* conv_b = F.in[10]; const float* dt_bias = F.in[11]; const float* a_log = F.in[12];
    LAS bf16* xs = (LAS bf16*)F.lds;
    LAS bf16* Bs = (LAS bf16*)(F.lds + 81920);
    LAS float* dts = (LAS float*)(F.lds + 81920 + 32768);
    LAS float* acsS = dts + 640;
    LAS float* wl = acsS + 640;
    const int tid = F.tid, lane = F.lane, wave = F.wave;
    for (int unit = blockIdx.x; unit < NCHUNK * NG; unit += F.G) {
        const int c = unit >> 2, g = unit & 3, T0 = c * CL;
        for (int task = tid; task < 576 * 8; task += NTHR) {
            const int cj = task % 576, seg = task / 576;
            const int xcol = cj < 320 ? g * 320 + cj : (cj < 448 ? 1280 + g * 128 + (cj - 320) : 1792 + g * 128 + (cj - 448));
            const float w0 = conv_w[xcol], w1 = conv_w[CONVD + xcol], w2 = conv_w[2 * CONVD + xcol], w3 = conv_w[3 * CONVD + xcol], bb = conv_b[xcol];
            const int t0 = T0 + seg * 16;
            float x0 = t0 >= 3 ? bf2f(PROJ[(size_t)(t0 - 3) * NP + CX + xcol]) : 0.f, x1 = t0 >= 2 ? bf2f(PROJ[(size_t)(t0 - 2) * NP + CX + xcol]) : 0.f, x2 = t0 >= 1 ? bf2f(PROJ[(size_t)(t0 - 1) * NP + CX + xcol]) : 0.f;
#pragma unroll 4
            for (int i = 0; i < 16; ++i) { const float x3 = bf2f(PROJ[(size_t)(t0 + i) * NP + CX + xcol]);
                const float y = silu_f(x0 * w0 + x1 * w1 + x2 * w2 + x3 * w3 + bb); const bf16 yb = (bf16)f2bf(y);
                XC[(size_t)(t0 + i) * CONVD + xcol] = yb;
                const int l = seg * 16 + i;
                if (cj < 320) xs[l * 320 + cj] = yb; else if (cj < 448) Bs[l * 128 + (cj - 320)] = yb;
                x0 = x1; x1 = x2; x2 = x3; }
            if (c == NCHUNK - 1 && seg == 7) {
                F.out[O_CVP + 0 * CONVD + xcol] = x0; F.out[O_CVP + 1 * CONVD + xcol] = x1; F.out[O_CVP + 2 * CONVD + xcol] = x2; }
        }
        for (int i = tid; i < 640; i += NTHR) { const int l = i / 5, hl = i % 5, h = g * 5 + hl;
            const float dt = softplus_f(bf2f(PROJ[(size_t)(T0 + l) * NP + CDT + h]) + dt_bias[h]);
            dts[i] = dt; acsS[i] = dt * (-__expf(a_log[h])); DTB[(size_t)(T0 + l) * SH + h] = dt; }
        __syncthreads();
        if (wave < 5) {
            const int hl = wave; const float a0 = acsS[(2 * lane) * 5 + hl], a1 = acsS[(2 * lane + 1) * 5 + hl];
            float s = a0 + a1;
#pragma unroll
            for (int o = 1; o < 64; o <<= 1) { const float u = __shfl_up(s, o); if (lane >= o) s += u; }
            const float e0 = s - a1;
            acsS[(2 * lane) * 5 + hl] = e0; acsS[(2 * lane + 1) * 5 + hl] = s;
            ACS[(size_t)(T0 + 2 * lane) * SH + g * 5 + hl] = e0; ACS[(size_t)(T0 + 2 * lane + 1) * SH + g * 5 + hl] = s;
            if (lane == 63) CDEC[c * SH + g * 5 + hl] = __expf(s);
        }
        __syncthreads();
        const int n = tid & 127, pq = __builtin_amdgcn_readfirstlane(tid >> 7);
        for (int hl = 0; hl < 5; ++hl) {
            if (tid < 128) wl[tid] = __expf(acsS[127 * 5 + hl] - acsS[tid * 5 + hl]) * dts[tid * 5 + hl];
            __syncthreads();
            float acc[16];
#pragma unroll
            for (int j = 0; j < 16; ++j) acc[j] = 0.f;
            for (int l = 0; l < CL; ++l) { const float bw = bf2f(Bs[l * 128 + n]) * wl[l];
                const LAS bf16* xr = xs + l * 320 + hl * 64 + pq * 16;
#pragma unroll
                for (int j = 0; j < 16; ++j) acc[j] += bw * bf2f(xr[j]); }
            float* dst = ST + (((size_t)c * SH + g * 5 + hl) * HD + pq * 16) * DSTATE + n;
#pragma unroll
            for (int j = 0; j < 16; ++j) dst[(size_t)j * DSTATE] = acc[j];
            __syncthreads();
        }
    }
}


__device__ __forceinline__ void ssd_phase_a_mfma(Frame& F) {
    const bf16* PROJ = WSP(bf16, WS_PROJ); bf16* XC = WSP(bf16, WS_XC); float* DTB = WSP(float, WS_DTB); float* ACS = WSP(float, WS_ACS); float* CDEC = WSP(float, WS_CDEC); float* ST = WSP(float, WS_ST);
    const float* conv_w = F.in[9]; const float* conv_b = F.in[10]; const float* dt_bias = F.in[11]; const float* a_log = F.in[12];
    LAS unsigned char* xim = F.lds;
    LAS unsigned char* Bim = F.lds + 81920;
    LAS float* dts = (LAS float*)(F.lds + 114688);
    LAS float* acsS = dts + 640;
    LAS float* wls = acsS + 640;
    const int tid = F.tid, lane = F.lane, wave = F.wave;
    for (int unit = blockIdx.x; unit < NCHUNK * NG; unit += F.G) {
        const int c = unit >> 2, g = unit & 3, T0 = c * CL;
        for (int i = tid; i < 640; i += NTHR) { const int l = i / 5, hl = i % 5, h = g * 5 + hl;
            const float dt = softplus_f(bf2f(PROJ[(size_t)(T0 + l) * NP + CDT + h]) + dt_bias[h]);
            dts[i] = dt; acsS[i] = dt * (-__expf(a_log[h])); DTB[(size_t)(T0 + l) * SH + h] = dt; }
        __syncthreads();
        if (wave < 5) {
            const int hl = wave; const float a0 = acsS[(2 * lane) * 5 + hl], a1 = acsS[(2 * lane + 1) * 5 + hl];
            float s = a0 + a1;
#pragma unroll
            for (int o = 1; o < 64; o <<= 1) { const float u = __shfl_up(s, o); if (lane >= o) s += u; }
            const float e0 = s - a1; const float last = __shfl(s, 63);
            acsS[(2 * lane) * 5 + hl] = e0; acsS[(2 * lane + 1) * 5 + hl] = s;
            ACS[(size_t)(T0 + 2 * lane) * SH + g * 5 + hl] = e0; ACS[(size_t)(T0 + 2 * lane + 1) * SH + g * 5 + hl] = s;
            wls[(2 * lane) * 5 + hl] = __expf(last - e0) * dts[(2 * lane) * 5 + hl]; wls[(2 * lane + 1) * 5 + hl] = __expf(last - s) * dts[(2 * lane + 1) * 5 + hl];
            if (lane == 63) CDEC[c * SH + g * 5 + hl] = __expf(s);
        }
        __syncthreads();
        for (int task = tid; task < 144 * 16; task += NTHR) {
            const int cq = task % 144, seg = task / 144, cj0 = 4 * cq;
            const int xcol = cj0 < 320 ? g * 320 + cj0 : (cj0 < 448 ? 1280 + g * 128 + (cj0 - 320) : 1792 + g * 128 + (cj0 - 448));
            const f32x4 w0 = *(const f32x4*)(conv_w + xcol), w1 = *(const f32x4*)(conv_w + CONVD + xcol), w2 = *(const f32x4*)(conv_w + 2 * CONVD + xcol), w3 = *(const f32x4*)(conv_w + 3 * CONVD + xcol), bb = *(const f32x4*)(conv_b + xcol);
            const int l0 = seg * 8, t0 = T0 + l0;
            f32x4 xr[11];
#pragma unroll
            for (int i = 0; i < 11; ++i) { const int t = t0 - 3 + i;
                if (t >= 0) { const unsigned long long u = *(const unsigned long long*)(PROJ + (size_t)t * NP + CX + xcol);
                    xr[i] = (f32x4){bf2f((unsigned short)u), bf2f((unsigned short)(u >> 16)), bf2f((unsigned short)(u >> 32)), bf2f((unsigned short)(u >> 48))}; }
                else xr[i] = (f32x4){0.f, 0.f, 0.f, 0.f}; }
#pragma unroll
            for (int i = 0; i < 8; ++i) { const int l = l0 + i;
                f32x4 y = xr[i] * w0 + xr[i + 1] * w1 + xr[i + 2] * w2 + xr[i + 3] * w3 + bb;
#pragma unroll
                for (int e = 0; e < 4; ++e) y[e] = silu_f(y[e]);
                *(unsigned long long*)(XC + (size_t)(T0 + l) * CONVD + xcol) = (unsigned long long)pk2(y[0], y[1]) | ((unsigned long long)pk2(y[2], y[3]) << 32);
                if (cj0 < 320) { const int hl = cj0 >> 6, p0 = cj0 & 63; const float wv = wls[l * 5 + hl];
                    const int ch = (p0 >> 3) ^ (((l >> 1) & 1) << 2);
                    *(LAS unsigned long long*)(xim + hl * 16384 + l * 128 + ch * 16 + 8 * ((p0 >> 2) & 1)) = (unsigned long long)pk2(y[0] * wv, y[1] * wv) | ((unsigned long long)pk2(y[2] * wv, y[3] * wv) << 32); }
                else if (cj0 < 448) { const int n0 = cj0 - 320; const int ch = (n0 >> 3) ^ ((l & 3) << 2);
                    *(LAS unsigned long long*)(Bim + l * 256 + ch * 16 + 8 * ((n0 >> 2) & 1)) = (unsigned long long)pk2(y[0], y[1]) | ((unsigned long long)pk2(y[2], y[3]) << 32); } }
            if (c == NCHUNK - 1 && seg == 15) {
#pragma unroll
                for (int j = 0; j < 3; ++j) *(f32x4*)(F.out + O_CVP + j * CONVD + xcol) = xr[8 + j]; }
        }
        __syncthreads();
        {
            const int nt = wave & 3, pt = wave >> 2, hi = lane >> 5, g2 = (lane >> 4) & 1, qq = (lane & 15) >> 2, pp = lane & 3;
#pragma unroll 1
            for (int hl = 0; hl < 5; ++hl) {
                f32x16 acc;
#pragma unroll
                for (int e = 0; e < 16; ++e) acc[e] = 0.f;
#pragma unroll
                for (int ks = 0; ks < 8; ++ks) {
                    const int rlo = 16 * ks + 4 * hi + qq, rhi = rlo + 8;
                    const int lcx = 4 * pt + 2 * g2 + (pp >> 1), lcb = 4 * nt + 2 * g2 + (pp >> 1);
                    const LAS unsigned char* xb = xim + hl * 16384;
                    const v4i16_t xlo = __builtin_amdgcn_ds_read_tr16_b64_v4i16((LAS v4i16_t*)(xb + rlo * 128 + ((lcx ^ (((rlo >> 1) & 1) << 2)) << 4) + 8 * (pp & 1)));
                    const v4i16_t xhi = __builtin_amdgcn_ds_read_tr16_b64_v4i16((LAS v4i16_t*)(xb + rhi * 128 + ((lcx ^ (((rhi >> 1) & 1) << 2)) << 4) + 8 * (pp & 1)));
                    const v4i16_t blo = __builtin_amdgcn_ds_read_tr16_b64_v4i16((LAS v4i16_t*)(Bim + rlo * 256 + ((lcb ^ ((rlo & 3) << 2)) << 4) + 8 * (pp & 1)));
                    const v4i16_t bhi = __builtin_amdgcn_ds_read_tr16_b64_v4i16((LAS v4i16_t*)(Bim + rhi * 256 + ((lcb ^ ((rhi & 3) << 2)) << 4) + 8 * (pp & 1)));
                    const bf16x8 af = (bf16x8){xlo[0], xlo[1], xlo[2], xlo[3], xhi[0], xhi[1], xhi[2], xhi[3]};
                    const bf16x8 bfr = (bf16x8){blo[0], blo[1], blo[2], blo[3], bhi[0], bhi[1], bhi[2], bhi[3]};
                    acc = __builtin_amdgcn_mfma_f32_32x32x16_bf16(af, bfr, acc, 0, 0, 0);
                }
                float* dst = ST + (((size_t)c * SH + g * 5 + hl) * HD + 32 * pt) * DSTATE + 32 * nt + (lane & 31);
#pragma unroll
                for (int e = 0; e < 16; ++e) dst[(size_t)((e & 3) + 8 * (e >> 2) + 4 * hi) * DSTATE] = acc[e];
            }
        }
        __syncthreads();
    }
}

__device__ __forceinline__ void ssd_sample(Frame& F) {
    const bf16* PROJ = WSP(bf16, WS_PROJ); bf16* MIX = WSP(bf16, WS_MIX);
    const float* state_conv = F.in[4]; const float* state_ssm = F.in[5];
    const float* conv_w = F.in[9]; const float* conv_b = F.in[10]; const float* dt_bias = F.in[11]; const float* a_log = F.in[12]; const float* d_skip = F.in[13]; const float* g_ssd = F.in[15];
    LAS float* xs = (LAS float*)F.lds;
    LAS float* Bs = xs + 1280;
    LAS float* Cs = Bs + 512;
    LAS float* dts = Cs + 512;
    LAS float* acs = dts + 20;
    LAS float* CBs = acs + 20;
    LAS float* ys = CBs + 16;
    LAS float* red = ys + 1280;
    const int tid = F.tid, lane = F.lane, wave = F.wave;
    for (int unit = blockIdx.x; unit < DB * NG; unit += F.G) {
        const int b = unit >> 2, g = unit & 3; const int r0 = SEQ + 4 * b;
        for (int cj = tid; cj < 576; cj += NTHR) {
            const int xcol = cj < 320 ? g * 320 + cj : (cj < 448 ? 1280 + g * 128 + (cj - 320) : 1792 + g * 128 + (cj - 448));
            const float w0 = conv_w[xcol], w1 = conv_w[CONVD + xcol], w2 = conv_w[2 * CONVD + xcol], w3 = conv_w[3 * CONVD + xcol], bb = conv_b[xcol];
            float xp[7];
#pragma unroll
            for (int j = 0; j < 3; ++j) xp[j] = state_conv[((size_t)b * 3 + j) * CONVD + xcol];
#pragma unroll
            for (int t = 0; t < 4; ++t) xp[3 + t] = bf2f(PROJ[(size_t)(r0 + t) * NP + CX + xcol]);
#pragma unroll
            for (int t = 0; t < 4; ++t) { const float y = silu_f(xp[t] * w0 + xp[t + 1] * w1 + xp[t + 2] * w2 + xp[t + 3] * w3 + bb);
                if (cj < 320) xs[t * 320 + cj] = y; else if (cj < 448) Bs[t * 128 + (cj - 320)] = y; else Cs[t * 128 + (cj - 448)] = y; }
#pragma unroll
            for (int j = 0; j < 3; ++j) F.out[O_CVS + ((size_t)b * 3 + j) * CONVD + xcol] = xp[4 + j];
        }
        if (tid < 20) { const int t = tid / 5, hl = tid % 5, h = g * 5 + hl; dts[tid] = softplus_f(bf2f(PROJ[(size_t)(r0 + t) * NP + CDT + h]) + dt_bias[h]); }
        __syncthreads();
        if (tid < 5) { const float a = -__expf(a_log[g * 5 + tid]); float s = 0.f;
#pragma unroll
            for (int t = 0; t < 4; ++t) { s += dts[t * 5 + tid] * a; acs[t * 5 + tid] = s; } }
        { const int pair = tid >> 5, n4 = tid & 31, t = pair >> 2, s = pair & 3; float v = 0.f;
#pragma unroll
            for (int e = 0; e < 4; ++e) v += Cs[t * 128 + 4 * n4 + e] * Bs[s * 128 + 4 * n4 + e];
            v += __shfl_xor(v, 1); v += __shfl_xor(v, 2); v += __shfl_xor(v, 4); v += __shfl_xor(v, 8); v += __shfl_xor(v, 16);
            if (n4 == 0) CBs[pair] = v; }
        __syncthreads();
        const int n4 = tid & 31, pr = tid >> 5;
        float Bv[4][4], Cv[4][4];
#pragma unroll
        for (int t = 0; t < 4; ++t)
#pragma unroll
            for (int e = 0; e < 4; ++e) { Bv[t][e] = Bs[t * 128 + 4 * n4 + e]; Cv[t][e] = Cs[t * 128 + 4 * n4 + e]; }
        for (int hl = 0; hl < 5; ++hl) {
            const int h = g * 5 + hl;
            float ac[4], dtv[4];
#pragma unroll
            for (int t = 0; t < 4; ++t) { ac[t] = acs[t * 5 + hl]; dtv[t] = dts[t * 5 + hl]; }
            const float dsk = d_skip[h];
#pragma unroll
            for (int j = 0; j < 4; ++j) {
                const int p = pr + 16 * j;
                const size_t soff = (((size_t)b * SH + h) * HD + p) * DSTATE + 4 * n4;
                const f32x4 S = *(const f32x4*)(state_ssm + soff);
                float xv[4];
#pragma unroll
                for (int t = 0; t < 4; ++t) xv[t] = xs[t * 320 + hl * 64 + p];
                f32x4 Hn = S * __expf(ac[3]);
#pragma unroll
                for (int t = 0; t < 4; ++t) { const float wgt = __expf(ac[3] - ac[t]) * dtv[t] * xv[t];
#pragma unroll
                    for (int e = 0; e < 4; ++e) Hn[e] += wgt * Bv[t][e]; }
                *(f32x4*)(F.out + O_SSS + soff) = Hn;
#pragma unroll
                for (int t = 0; t < 4; ++t) {
                    float yo = (Cv[t][0] * S[0] + Cv[t][1] * S[1]) + (Cv[t][2] * S[2] + Cv[t][3] * S[3]);
                    yo += __shfl_xor(yo, 1); yo += __shfl_xor(yo, 2); yo += __shfl_xor(yo, 4); yo += __shfl_xor(yo, 8); yo += __shfl_xor(yo, 16);
                    float y = yo * __expf(ac[t]) + dsk * xv[t];
#pragma unroll
                    for (int s = 0; s < 4; ++s) if (s <= t) y += CBs[t * 4 + s] * __expf(ac[t] - ac[s]) * dtv[s] * xv[s];
                    if (n4 == t) ys[t * 320 + hl * 64 + p] = y;
                }
            }
        }
        __syncthreads();
        float yv[4]; float part[4];
#pragma unroll
        for (int t = 0; t < 4; ++t) { yv[t] = 0.f;
            if (tid < 320) { const float z = bf2f(PROJ[(size_t)(r0 + t) * NP + CZ + g * 320 + tid]); yv[t] = ys[t * 320 + tid] * silu_f(z); }
            part[t] = wave_sum(yv[t] * yv[t]); }
        if (lane == 0) {
#pragma unroll
            for (int t = 0; t < 4; ++t) red[t * 8 + wave] = part[t]; }
        __syncthreads();
        if (tid < 320) {
#pragma unroll
            for (int t = 0; t < 4; ++t) { float ss = 0.f;
#pragma unroll
                for (int w = 0; w < 8; ++w) ss += red[t * 8 + w];
                const float rs = 1.0f / sqrtf(ss * (1.0f / 320.f) + EPS);
                MIX[(size_t)(r0 + t) * MIXW + ATTW + g * 320 + tid] = (bf16)f2bf(yv[t] * rs * g_ssd[g * 320 + tid]); } }
        __syncthreads();
    }
}

__device__ __forceinline__ void scan_and_attnorm(Frame& F) {
    const float* ST = WSP(float, WS_ST); const float* CDEC = WSP(float, WS_CDEC); bf16* HIN = WSP(bf16, WS_HIN);
    const int gt = blockIdx.x * NTHR + F.tid, NGT = F.G * NTHR;
    for (int e4 = gt; e4 < SH * HD * DSTATE / 4; e4 += NGT) {
        const int h = e4 / (HD * DSTATE / 4);
        f32x4 hcur = (f32x4){0.f, 0.f, 0.f, 0.f};
        for (int c0 = 0; c0 < NCHUNK; c0 += 8) {
            f32x4 st[8]; float dc[8];
#pragma unroll
            for (int j = 0; j < 8; ++j) { st[j] = *(const f32x4*)(ST + (size_t)(c0 + j) * (SH * HD * DSTATE) + (size_t)e4 * 4); dc[j] = CDEC[(c0 + j) * SH + h]; }
#pragma unroll
            for (int j = 0; j < 8; ++j) { *(unsigned long long*)(HIN + (size_t)(c0 + j) * (SH * HD * DSTATE) + (size_t)e4 * 4) = (unsigned long long)pk2(hcur[0], hcur[1]) | ((unsigned long long)pk2(hcur[2], hcur[3]) << 32);
                hcur = hcur * dc[j] + st[j]; }
        }
        *(f32x4*)(F.out + O_SSP + (size_t)e4 * 4) = hcur;
    }
    bf16* MIX = WSP(bf16, WS_MIX); const float* ATTSS = WSP(float, WS_ATTSS); const float* g_attn = F.in[14];
    const bf16* OPART = WSP(bf16, WS_OPART); const float* ML = WSP(float, WS_ML);
    const int gw = blockIdx.x * NWAVES + F.wave, NGW = F.G * NWAVES, lane = F.lane;
    for (int row = gw; row < SEQ; row += NGW) {
        float o[3][4]; float sq = 0.f;
#pragma unroll
        for (int j = 0; j < 3; ++j) { const int col = 4 * lane + 256 * j, h = col >> 6;
            float mb[3], lb[3];
#pragma unroll
            for (int b = 0; b < 3; ++b) { const float* mp = ML + (((size_t)b * SEQ + row) * AH + h) * 2; mb[b] = mp[0]; lb[b] = mp[1]; }
            const float M = fmaxf(fmaxf(mb[0], mb[1]), mb[2]);
            float w[3], W = 0.f;
#pragma unroll
            for (int b = 0; b < 3; ++b) { w[b] = __builtin_amdgcn_exp2f(mb[b] - M) * lb[b]; W += w[b]; }
            const float iw = 1.0f / W;
#pragma unroll
            for (int e = 0; e < 4; ++e) o[j][e] = 0.f;
#pragma unroll
            for (int b = 0; b < 3; ++b) { const unsigned long long x = *(const unsigned long long*)(OPART + ((size_t)b * SEQ + row) * ATTW + col); const float wb = w[b] * iw;
                o[j][0] += wb * bf2f((unsigned short)x); o[j][1] += wb * bf2f((unsigned short)(x >> 16)); o[j][2] += wb * bf2f((unsigned short)(x >> 32)); o[j][3] += wb * bf2f((unsigned short)(x >> 48)); }
#pragma unroll
            for (int e = 0; e < 4; ++e) sq += o[j][e] * o[j][e]; }
        sq = wave_sum(sq);
        const float rs = 1.0f / sqrtf(sq * (1.0f / ATTW) + EPS);
#pragma unroll
        for (int j = 0; j < 3; ++j) { const int col = 4 * lane + 256 * j; const f32x4 gg = *(const f32x4*)(g_attn + col);
            *(unsigned long long*)(MIX + (size_t)row * MIXW + col) = (unsigned long long)pk2(o[j][0] * rs * gg[0], o[j][1] * rs * gg[1]) | ((unsigned long long)pk2(o[j][2] * rs * gg[2], o[j][3] * rs * gg[3]) << 32); }
    }
    for (int row = SEQ + gw; row < MTOT; row += NGW) {
        float s = lane < AH ? ATTSS[row * AH + lane] : 0.f; s = wave_sum(s);
        const float rs = 1.0f / sqrtf(s * (1.0f / ATTW) + EPS);
#pragma unroll
        for (int j = 0; j < 3; ++j) { const int col = 4 * lane + 256 * j; unsigned long long* p = (unsigned long long*)(MIX + (size_t)row * MIXW + col);
            const unsigned long long w = *p; const f32x4 gg = *(const f32x4*)(g_attn + col);
            const float v0 = bf2f((unsigned short)w) * rs * gg[0], v1 = bf2f((unsigned short)(w >> 16)) * rs * gg[1], v2 = bf2f((unsigned short)(w >> 32)) * rs * gg[2], v3 = bf2f((unsigned short)(w >> 48)) * rs * gg[3];
            *p = (unsigned long long)pk2(v0, v1) | ((unsigned long long)pk2(v2, v3) << 32); }
    }
}

__device__ __forceinline__ void ssd_phase_b(Frame& F) {
    const bf16* PROJ = WSP(bf16, WS_PROJ); const bf16* XC = WSP(bf16, WS_XC); const float* DTB = WSP(float, WS_DTB); const float* ACS = WSP(float, WS_ACS); const float* ST = WSP(float, WS_ST);
    bf16* MIX = WSP(bf16, WS_MIX); const float* d_skip = F.in[13]; const float* g_ssd = F.in[15];
    LAS float* Wm = (LAS float*)F.lds;
    LAS float* Hs = (LAS float*)(F.lds + 66048);
    LAS bf16* xh = (LAS bf16*)(F.lds + 66048 + 32768);
    LAS float* acsS = (LAS float*)(F.lds + 66048 + 32768 + 16384);
    LAS float* dtS = acsS + 128;
    LAS float* ssq = dtS + 128;
    const int tid = F.tid, lane = F.lane;
    const int l = tid & 127, pq = __builtin_amdgcn_readfirstlane(tid >> 7);
    for (int unit = blockIdx.x; unit < NCHUNK * NG; unit += F.G) {
        const int c = unit >> 2, g = unit & 3, T0 = c * CL;
        float yv[5][16];
        if (tid < 128) ssq[tid] = 0.f;
#pragma unroll
        for (int hl = 0; hl < 5; ++hl) {
            const int h = g * 5 + hl;
            __syncthreads();
            if (tid < 128) { acsS[tid] = ACS[(size_t)(T0 + tid) * SH + h]; dtS[tid] = DTB[(size_t)(T0 + tid) * SH + h]; }
            for (int i = tid; i < 64 * 128 / 4; i += NTHR) ((LAS f32x4*)Hs)[i] = *(const f32x4*)(ST + ((size_t)c * SH + h) * (HD * DSTATE) + (size_t)i * 4);
            for (int i = tid; i < 128 * 64 / 8; i += NTHR) { const int r = i >> 3, ch = i & 7; ((LAS v4u*)xh)[i] = *(const v4u*)(XC + (size_t)(T0 + r) * CONVD + h * 64 + ch * 8); }
            __syncthreads();
            for (int pair = tid; pair < 128 * 128; pair += NTHR) {
                const int ll = pair >> 7, s = pair & 127; float w = 0.f;
                if (s <= ll) { const bf16* cp = XC + (size_t)(T0 + ll) * CONVD + 1792 + g * 128; const bf16* bp = XC + (size_t)(T0 + s) * CONVD + 1280 + g * 128; float d = 0.f;
#pragma unroll 4
                    for (int k8 = 0; k8 < 16; ++k8) { const v4u cw = *(const v4u*)(cp + 8 * k8), bw = *(const v4u*)(bp + 8 * k8);
#pragma unroll
                        for (int e = 0; e < 4; ++e) { d += __uint_as_float(cw[e] << 16) * __uint_as_float(bw[e] << 16) + __uint_as_float(cw[e] & 0xffff0000u) * __uint_as_float(bw[e] & 0xffff0000u); } }
                    w = d * __expf(acsS[ll] - acsS[s]) * dtS[s]; }
                Wm[ll * 129 + s] = w; }
            __syncthreads();
            float acc[16];
#pragma unroll
            for (int j = 0; j < 16; ++j) acc[j] = 0.f;
            for (int s = 0; s < CL; ++s) { const float w = Wm[l * 129 + s]; const LAS bf16* xr = xh + s * 64 + pq * 16;
#pragma unroll
                for (int j = 0; j < 16; ++j) acc[j] += w * bf2f(xr[j]); }
            { const bf16* cp = XC + (size_t)(T0 + l) * CONVD + 1792 + g * 128; const float ea = __expf(acsS[l]);
                float off[16];
#pragma unroll
                for (int j = 0; j < 16; ++j) off[j] = 0.f;
                for (int k8 = 0; k8 < 16; ++k8) { const v4u cw = *(const v4u*)(cp + 8 * k8); float cf[8];
#pragma unroll
                    for (int e = 0; e < 4; ++e) { cf[2 * e] = __uint_as_float(cw[e] << 16); cf[2 * e + 1] = __uint_as_float(cw[e] & 0xffff0000u); }
#pragma unroll
                    for (int j = 0; j < 16; ++j) { const LAS float* hr = Hs + (pq * 16 + j) * 128 + 8 * k8;
#pragma unroll
                        for (int e = 0; e < 8; ++e) off[j] += cf[e] * hr[e]; } }
#pragma unroll
                for (int j = 0; j < 16; ++j) acc[j] += ea * off[j]; }
            { const float dsk = d_skip[h]; const LAS bf16* xr = xh + l * 64 + pq * 16; const bf16* zp = PROJ + (size_t)(T0 + l) * NP + CZ + h * 64 + pq * 16; float sq = 0.f;
#pragma unroll
                for (int j = 0; j < 16; ++j) { const float y = (acc[j] + dsk * bf2f(xr[j])) * silu_f(bf2f(zp[j])); yv[hl][j] = y; sq += y * y; }
                __hip_atomic_fetch_add(&ssq[l], sq, __ATOMIC_RELAXED, __HIP_MEMORY_SCOPE_WORKGROUP); }
        }
        __syncthreads();
        const float rs = 1.0f / sqrtf(ssq[l] * (1.0f / 320.f) + EPS);
#pragma unroll
        for (int hl = 0; hl < 5; ++hl) { const int col = (g * 5 + hl) * 64 + pq * 16; bf16* mp = MIX + (size_t)(T0 + l) * MIXW + ATTW + col;
            v4u w0, w1;
            w0.x = pk2(yv[hl][0] * rs * g_ssd[col + 0], yv[hl][1] * rs * g_ssd[col + 1]); w0.y = pk2(yv[hl][2] * rs * g_ssd[col + 2], yv[hl][3] * rs * g_ssd[col + 3]);
            w0.z = pk2(yv[hl][4] * rs * g_ssd[col + 4], yv[hl][5] * rs * g_ssd[col + 5]); w0.w = pk2(yv[hl][6] * rs * g_ssd[col + 6], yv[hl][7] * rs * g_ssd[col + 7]);
            w1.x = pk2(yv[hl][8] * rs * g_ssd[col + 8], yv[hl][9] * rs * g_ssd[col + 9]); w1.y = pk2(yv[hl][10] * rs * g_ssd[col + 10], yv[hl][11] * rs * g_ssd[col + 11]);
            w1.z = pk2(yv[hl][12] * rs * g_ssd[col + 12], yv[hl][13] * rs * g_ssd[col + 13]); w1.w = pk2(yv[hl][14] * rs * g_ssd[col + 14], yv[hl][15] * rs * g_ssd[col + 15]);
            *(v4u*)mp = w0; *(v4u*)(mp + 8) = w1; }
        __syncthreads();
    }
}


__device__ __forceinline__ void ssd_phase_b_mfma(Frame& F) {
    const bf16* PROJ = WSP(bf16, WS_PROJ); const bf16* XC = WSP(bf16, WS_XC); const float* DTB = WSP(float, WS_DTB); const float* ACS = WSP(float, WS_ACS); const bf16* HIN = WSP(bf16, WS_HIN);
    bf16* MIX = WSP(bf16, WS_MIX); const float* d_skip = F.in[13]; const float* g_ssd = F.in[15];
    constexpr int YP = 656;
    LAS unsigned char* Cim = F.lds;
    LAS unsigned char* Bim = F.lds + 32768;
    LAS unsigned char* yst = F.lds + 32768;
    LAS unsigned char* xim = F.lds + 116736;
    LAS unsigned char* Him = F.lds + 133120;
    LAS float* acsS = (LAS float*)(F.lds + 149504);
    LAS float* dtS = acsS + 128;
    LAS float* ssqp = dtS + 128;
    const int tid = F.tid, lane = F.lane, wave = F.wave;
    const int lt = wave >> 1, pt = wave & 1;
    constexpr float LOG2E = 1.4426950408889634f;
    for (int unit = blockIdx.x; unit < NCHUNK * NG; unit += F.G) {
        const int c = unit >> 2, g = unit & 3, T0 = c * CL;
        int lane_u = lane; asm volatile("" : "+v"(lane_u));
        const int lq = lane_u & 31, hi = lane_u >> 5;
        for (int n = wave; n < 32; n += 8) { const int row = 4 * n + (lane >> 4), pc = lane & 15, lc = pc ^ (row & 15);
            __builtin_amdgcn_global_load_lds((const unsigned*)(XC + (size_t)(T0 + row) * CONVD + 1792 + g * 128 + lc * 8), (LAS unsigned*)(Cim + n * 1024), 16, 0, 0);
            __builtin_amdgcn_global_load_lds((const unsigned*)(XC + (size_t)(T0 + row) * CONVD + 1280 + g * 128 + lc * 8), (LAS unsigned*)(Bim + n * 1024), 16, 0, 0); }
        asm volatile("s_waitcnt vmcnt(0)" ::: "memory");
        __syncthreads();
        const LAS unsigned char* crow_ = Cim + (32 * lt + lq) * 256; const int cx = (32 * lt + lq) & 15;
#define CF(ks) (*(const LAS bf16x8*)(crow_ + (((2 * (ks) + hi) ^ cx) << 4)))
        unsigned GTp[4][8];
#pragma unroll
        for (int st = 0; st < 4; ++st) {
            f32x16 gt;
#pragma unroll
            for (int e = 0; e < 16; ++e) gt[e] = 0.f;
            { const int row = 32 * st + lq;
#pragma unroll
                for (int ks = 0; ks < 8; ++ks) { const bf16x8 bfr = *(const LAS bf16x8*)(Bim + row * 256 + (((2 * ks + hi) ^ (row & 15)) << 4));
                    gt = __builtin_amdgcn_mfma_f32_32x32x16_bf16(bfr, CF(ks), gt, 0, 0, 0); } }
#pragma unroll
            for (int e = 0; e < 8; ++e) GTp[st][e] = pk2(gt[2 * e], gt[2 * e + 1]);
            __builtin_amdgcn_sched_barrier(0);
        }
        float sq = 0.f;
#pragma unroll 1
        for (int hl = 0; hl < 5; ++hl) {
            const int h = g * 5 + hl;
            int lane_h = lane; asm volatile("" : "+v"(lane_h));
            const int lq = lane_h & 31, hi = lane_h >> 5, g2 = (lane_h >> 4) & 1, qq = (lane_h & 15) >> 2, pp = lane_h & 3;
            __syncthreads();
            for (int n = wave; n < 16; n += 8) { const int row = 8 * n + (lane >> 3), pc = lane & 7, lc = pc ^ (((row >> 1) & 1) << 2);
                __builtin_amdgcn_global_load_lds((const unsigned*)(XC + (size_t)(T0 + row) * CONVD + h * 64 + lc * 8), (LAS unsigned*)(xim + n * 1024), 16, 0, 0); }
            for (int n = wave; n < 16; n += 8) { const int row = 4 * n + (lane >> 4), pc = lane & 15, lc = pc ^ (row & 15);
                __builtin_amdgcn_global_load_lds((const unsigned*)(HIN + (((size_t)c * SH + h) * HD + row) * DSTATE + lc * 8), (LAS unsigned*)(Him + n * 1024), 16, 0, 0); }
            if (tid < 128) { acsS[tid] = ACS[(size_t)(T0 + tid) * SH + h] * LOG2E; dtS[tid] = DTB[(size_t)(T0 + tid) * SH + h]; }
            const int lrow = T0 + 32 * lt + lq;
            const float al = ACS[(size_t)lrow * SH + h] * LOG2E;
            asm volatile("s_waitcnt vmcnt(0)" ::: "memory");
            __syncthreads();
            const LAS unsigned char* crow_h = Cim + (32 * lt + lq) * 256; const int cxh = lq & 15;
#define CFH(ks) (*(const LAS bf16x8*)(crow_h + (((2 * (ks) + hi) ^ cxh) << 4)))
            const LAS unsigned char* xtr = xim + (4 * hi + qq) * 128 + (((4 * pt + 2 * g2 + (pp >> 1)) ^ (((qq >> 1) & 1) << 2)) << 4) + 8 * (pp & 1);
            f32x16 yo, yd;
#pragma unroll
            for (int e = 0; e < 16; ++e) { yo[e] = 0.f; yd[e] = 0.f; }
            { const int row = 32 * pt + lq;
#pragma unroll
                for (int ks = 0; ks < 8; ++ks) { const bf16x8 hf = *(const LAS bf16x8*)(Him + row * 256 + (((2 * ks + hi) ^ (row & 15)) << 4));
                    yo = __builtin_amdgcn_mfma_f32_32x32x16_bf16(hf, CFH(ks), yo, 0, 0, 0); } }
#pragma unroll
            for (int st = 0; st < 4; ++st) {
#pragma unroll
                for (int s2 = 0; s2 < 2; ++s2) {
                    float w[8];
#pragma unroll
                    for (int j = 0; j < 8; ++j) { const int e = 8 * s2 + j, s = 32 * st + (e & 3) + 8 * (e >> 2) + 4 * hi;
                        const float gv = (e & 1) ? __uint_as_float(GTp[st][e >> 1] & 0xffff0000u) : __uint_as_float(GTp[st][e >> 1] << 16);
                        const float v = gv * __builtin_amdgcn_exp2f(al - acsS[s]) * dtS[s];
                        w[j] = (s <= 32 * lt + lq) ? v : 0.f; }
                    v4u wp; wp.x = pk2(w[0], w[1]); wp.y = pk2(w[2], w[3]); wp.z = pk2(w[4], w[5]); wp.w = pk2(w[6], w[7]);
                    const v4i16_t xlo = __builtin_amdgcn_ds_read_tr16_b64_v4i16((LAS v4i16_t*)(xtr + (32 * st + 16 * s2) * 128));
                    const v4i16_t xhi = __builtin_amdgcn_ds_read_tr16_b64_v4i16((LAS v4i16_t*)(xtr + (32 * st + 16 * s2 + 8) * 128));
                    const bf16x8 xf = (bf16x8){xlo[0], xlo[1], xlo[2], xlo[3], xhi[0], xhi[1], xhi[2], xhi[3]};
                    yd = __builtin_amdgcn_mfma_f32_32x32x16_bf16(xf, __builtin_bit_cast(bf16x8, wp), yd, 0, 0, 0);
                    __builtin_amdgcn_sched_barrier(0);
                }
            }
            const float ea = __builtin_amdgcn_exp2f(al), dsk = d_skip[h];
#pragma unroll
            for (int gq = 0; gq < 4; ++gq) { const int p = 32 * pt + 8 * gq + 4 * hi;
                const unsigned long long xu = *(const unsigned long long*)(XC + (size_t)lrow * CONVD + h * 64 + p), zu = *(const unsigned long long*)(PROJ + (size_t)lrow * NP + CZ + h * 64 + p);
                float y[4];
#pragma unroll
                for (int e = 0; e < 4; ++e) { const float xv = bf2f((unsigned short)(xu >> (16 * e))), zv = bf2f((unsigned short)(zu >> (16 * e)));
                    y[e] = (yd[4 * gq + e] + ea * yo[4 * gq + e] + dsk * xv) * silu_f(zv); sq += y[e] * y[e]; }
                *(LAS unsigned long long*)(yst + (32 * lt + lq) * YP + (hl * 64 + p) * 2) = (unsigned long long)pk2(y[0], y[1]) | ((unsigned long long)pk2(y[2], y[3]) << 32); }
        }
        sq += __shfl_xor(sq, 32);
        if (lane < 32) ssqp[pt * 128 + 32 * lt + lane] = sq;
        __syncthreads();
        for (int task = tid; task < 128 * 40; task += NTHR) { const int row = task / 40, ch = task % 40, col = g * 320 + 8 * ch;
            const float rs = 1.0f / sqrtf((ssqp[row] + ssqp[128 + row]) * (1.0f / 320.f) + EPS);
            const v4u yv = *(const LAS v4u*)(yst + row * YP + ch * 16); const f32x4 g0 = *(const f32x4*)(g_ssd + col), g1 = *(const f32x4*)(g_ssd + col + 4);
            v4u o;
            o.x = pk2(__uint_as_float(yv.x << 16) * rs * g0[0], __uint_as_float(yv.x & 0xffff0000u) * rs * g0[1]); o.y = pk2(__uint_as_float(yv.y << 16) * rs * g0[2], __uint_as_float(yv.y & 0xffff0000u) * rs * g0[3]);
            o.z = pk2(__uint_as_float(yv.z << 16) * rs * g1[0], __uint_as_float(yv.z & 0xffff0000u) * rs * g1[1]); o.w = pk2(__uint_as_float(yv.w << 16) * rs * g1[2], __uint_as_float(yv.w & 0xffff0000u) * rs * g1[3]);
            *(v4u*)(MIX + (size_t)(T0 + row) * MIXW + ATTW + col) = o; }
        __syncthreads();
    }
#undef CF
#undef CFH
}

__device__ __forceinline__ void final_norm(Frame& F) {
    const float* SS3 = (const float*)(F.ws + CTL_SS3); const float* gf = F.in[21];
    const int gw = blockIdx.x * NWAVES + F.wave, NGW = F.G * NWAVES, lane = F.lane;
    for (int row = gw; row < MTOT; row += NGW) {
        const float rs = 1.0f / sqrtf(SS3[row] * (1.0f / DM) + EPS);
        f32x4* yr = (f32x4*)(F.out + (size_t)row * DM) + lane;
#pragma unroll
        for (int j = 0; j < 4; ++j) { const f32x4 gg = *((const f32x4*)gf + lane + 64 * j); yr[64 * j] = yr[64 * j] * rs * gg; }
    }
}

#ifndef MK_N_LAUNCHES
#define MK_N_LAUNCHES 1
#endif
constexpr int N_PHASES = 9;
struct Args { const float* in[22]; float* out; unsigned char* ws; int ph_lo, ph_hi; };
__global__ void __launch_bounds__(NTHR, 2) fwd(Args args) {
    extern __shared__ __attribute__((aligned(16))) unsigned char lds[];
    Frame F;
    F.lds = (LAS unsigned char*)lds;
    F.tid = threadIdx.x; F.lane = F.tid & 63; F.wave = __builtin_amdgcn_readfirstlane(F.tid >> 6); F.G = gridDim.x;
#pragma unroll
    for (int i = 0; i < 22; ++i) F.in[i] = args.in[i];
    F.out = args.out; F.ws = args.ws;
    volatile LAS unsigned* MISC = (volatile LAS unsigned*)(F.lds + MISC_OFF);
    if (F.tid < 64) MISC[F.tid] = 0u;
    __syncthreads();
    unsigned* barw = (unsigned*)(F.ws + WS_CTL) + CW_BAR;
    XcdBarrier bar; bar.bar = barw; bar.x = 0; bar.st = nullptr;
    if (MK_N_LAUNCHES == 1) bar = xcd_barrier_post(barw, MISC + 8);
    const int lo = args.ph_lo, hi = args.ph_hi;
#define IN(k) (lo <= (k) && (k) < hi)
#define SEAM(k) do { if (IN(k) && IN((k) + 1)) xcd_barrier(bar); } while (0)

    if (IN(0)) { p0_prologue(F); __syncthreads(); }
    SEAM(0);
    if (IN(1)) {
        pg8::Gemm g{WSP(const pg8::bf16_t, WS_XB), WSP(const pg8::bf16_t, WS_WIN), MTOT, NP, DM}; pg8::StaticOrder S; S.init(MTOT, NP, F.G, (int)blockIdx.x);
        EpiProj E{WSP(bf16, WS_PROJ), WSP(const float, WS_RS1), F.out};
        pg8::gemm_phase<EpiProj, pg8::StaticOrder, true, true>(F.lds, g, S, E);
    }
    SEAM(1);
    if (IN(2)) { attn_sample(F); __syncthreads(); ssd_sample(F); __syncthreads(); ssd_phase_a_mfma(F); __syncthreads(); attn_prompt_mfma(F); }
    SEAM(2);
    if (IN(3)) { scan_and_attnorm(F); }
    SEAM(3);
    if (IN(4)) { ssd_phase_b_mfma(F); }
    SEAM(4);
    if (IN(5)) {
        pg8::Gemm g{WSP(const pg8::bf16_t, WS_MIX), WSP(const pg8::bf16_t, WS_WOUT), MTOT, DM, MIXW}; pg8::StaticOrder S; S.init(MTOT, DM, F.G, (int)blockIdx.x);
        EpiOut E{F.in[0], F.in[1], WSP(float, WS_X1), WSP(bf16, WS_X1B), (float*)(F.ws + CTL_SS2)};
        pg8::gemm_phase<EpiOut, pg8::StaticOrder, true, true>(F.lds, g, S, E);
    }
    SEAM(5);
    if (IN(6)) {
        pg8::Gemm g{WSP(const pg8::bf16_t, WS_X1B), WSP(const pg8::bf16_t, WS_WGU), MTOT, 2 * DFF, DM}; pg8::StaticOrder S; S.init(MTOT, 2 * DFF, F.G, (int)blockIdx.x);
        EpiGU E{WSP(bf16, WS_ACT), (const float*)(F.ws + CTL_SS2)};
        pg8::gemm_phase<EpiGU, pg8::StaticOrder, true, true>(F.lds, g, S, E);
    }
    SEAM(6);
    if (IN(7)) {
        pg8::Gemm g{WSP(const pg8::bf16_t, WS_ACT), WSP(const pg8::bf16_t, WS_WDN), MTOT, DM, DFF}; pg8::StaticOrder S; S.init(MTOT, DM, F.G, (int)blockIdx.x);
        EpiDown E{WSP(const float, WS_X1), F.out, (float*)(F.ws + CTL_SS3)};
        pg8::gemm_phase<EpiDown, pg8::StaticOrder, true, true>(F.lds, g, S, E);
    }
    SEAM(7);
    if (IN(8)) { final_norm(F); }
#undef IN
#undef SEAM
}

extern "C" void kernel_launch(void* const* d_in, const int* in_sizes, int n_in, void* d_out, int out_size, void* d_ws, size_t ws_size, hipStream_t stream) {
    static int grid = 0;
    if (grid == 0) {
        if (n_in != 22 || (size_t)out_size != O_END || ws_size < WS_END) fprintf(stderr, "kernel_launch: unexpected shapes (n_in %d, out %d, ws %zu)\n", n_in, out_size, ws_size);
        int dev = 0, cus = 0, per_cu = 0;
        if (hipGetDevice(&dev) != hipSuccess || hipDeviceGetAttribute(&cus, hipDeviceAttributeMultiprocessorCount, dev) != hipSuccess) { grid = -1; return; }
        if (hipFuncSetAttribute((const void*)fwd, hipFuncAttributeMaxDynamicSharedMemorySize, LDS_BYTES) != hipSuccess) { fprintf(stderr, "kernel_launch: hipFuncSetAttribute failed\n"); grid = -1; return; }
        if (hipOccupancyMaxActiveBlocksPerMultiprocessor(&per_cu, (const void*)fwd, NTHR, LDS_BYTES) != hipSuccess || per_cu < 1) fprintf(stderr, "kernel_launch: occupancy query says %d\n", per_cu);
        (void)hipGetLastError();
        grid = cus;
    }
    if (grid < 0) return;
    if (hipMemsetAsync((char*)d_ws + WS_CTL, 0, CTL_ZERO_BYTES, stream) != hipSuccess) return;
    Args a{};
    for (int i = 0; i < 22; ++i) a.in[i] = (const float*)d_in[i];
    a.out = (float*)d_out; a.ws = (unsigned char*)d_ws;
    if (MK_N_LAUNCHES == 1) { a.ph_lo = 0; a.ph_hi = N_PHASES; hipLaunchKernelGGL(fwd, dim3(grid), dim3(NTHR), LDS_BYTES, stream, a); }
    else { for (int p = 0; p < N_PHASES; ++p) { a.ph_lo = p; a.ph_hi = p + 1; hipLaunchKernelGGL(fwd, dim3(grid), dim3(NTHR), LDS_BYTES, stream, a); } }
}
```

```cpp
#include <hip/hip_runtime.h>
#include <cstdio>
#include <cstdint>
namespace pg8 {
#define PG8_LAS __attribute__((address_space(3)))
typedef unsigned short bf16_t;
typedef short bf16x8 __attribute__((ext_vector_type(8)));
typedef float f32x4 __attribute__((ext_vector_type(4)));
typedef unsigned u32x4 __attribute__((ext_vector_type(4)));
constexpr int BM = 256, BK = 64, HALF = 128, HTB = HALF * BK * 2  , STAGE_BYTES = 8 * HTB, NXCD = 8, WGM = 8;

__host__ __device__ __forceinline__ int lds_byte(int r, int c) { const int st = (r >> 4) * 2 + (c >> 5), rr = r & 15, cc = c & 31, ob = rr * 64 + cc * 2; return st * 1024 + (ob ^ (((ob >> 9) & 1) << 5)); }
__host__ __device__ __forceinline__ void stage_rc(int b, int& R, int& C) { const int st = b / 1024, sb = b % 1024, swz = sb ^ (((sb >> 9) & 1) << 5); R = (st >> 1) * 16 + swz / 64; C = (st & 1) * 32 + (swz % 64) / 2; }
__host__ __device__ __forceinline__ int perm32(int rho) { const int n = rho >> 4, i = rho & 15; return 8 * (i >> 2) + 4 * n + (i & 3); }

struct Unit { int pm, pn; };
struct Gemm { const bf16_t* A; const bf16_t* Bt; int M, N, K; };

struct StaticOrder {
    int nM, nN, nwg, G, c;
    __host__ __device__ void init(int M, int N, int G_, int c_) { nM = M / BM; nN = N / BM; nwg = nM * nN; G = G_; c = c_; }
    __host__ __device__ bool next(int i, Unit& u) const {
        const long L = (long)i * G + c; if (L >= nwg) return false;
        int wgid = (int)L; { const int q = nwg / NXCD, r = nwg % NXCD, xcd = wgid % NXCD, off = wgid / NXCD; wgid = (xcd < r ? xcd * (q + 1) : r * (q + 1) + (xcd - r) * q) + off; }
        const int nig = WGM * nN, gid = wgid / nig, fm = gid * WGM, gsz = (nM - fm) < WGM ? (nM - fm) : WGM;
        u.pm = fm + ((wgid % nig) % gsz); u.pn = (wgid % nig) / gsz; return true;
    }
    __device__ __forceinline__ void a_ready(const Unit&) const {}
    __device__ __forceinline__ void done(const Unit&) const {}
};

__device__ __forceinline__ unsigned cvt_pk_bf16(float lo, float hi) { unsigned r; asm volatile("v_cvt_pk_bf16_f32 %0, %1, %2" : "=v"(r) : "v"(lo), "v"(hi)); return r; }
typedef float f32x2 __attribute__((ext_vector_type(2)));

template <class Epi, class Sched, bool ALIGN_EPI = false, bool SP2 = false>
__device__ __forceinline__ void gemm_phase(PG8_LAS unsigned char* lds, const Gemm g, const Sched& S, const Epi& E) {
    const int tid = threadIdx.x, wid = __builtin_amdgcn_readfirstlane(tid >> 6), lane = tid & 63, wr = wid >> 2, wc = wid & 3, fr = lane & 15, fq = lane >> 4;
    const int K = g.K, nt = K / BK;
    unsigned voffA[2], voffB[2];
#pragma unroll
    for (int i = 0; i < 2; ++i) { int R, C; stage_rc(tid * 16 + i * 8192, R, C); const int Rb = Epi::PERM ? ((R & ~31) + perm32(R & 31)) : R;
        voffA[i] = (unsigned)(R * K + C) * 2u; voffB[i] = (unsigned)(Rb * K + C) * 2u; }
    const size_t kstep = (size_t)(BK * 2);
    const size_t hstep = (size_t)HALF * K * 2;
    const size_t tstep = 2 * hstep;
    const unsigned ldsw = (unsigned)wid * 1024u;
    const int aoff = lds_byte(wr * 64 + fr, fq * 8), boff = lds_byte(wc * 32 + fr, fq * 8);
#define PG8_SA(b, h) (((b) * 2 + (h)) * HTB)
#define PG8_SB(b, h) ((4 + (b) * 2 + (h)) * HTB)
#define PG8_STAGE(bufoff, gbase, voff) do { _Pragma("unroll") for (int _i = 0; _i < 2; ++_i) \
        __builtin_amdgcn_global_load_lds((const unsigned*)((const char*)(gbase) + (voff)[_i]), (PG8_LAS unsigned*)(lds + (bufoff) + ldsw + _i * 8192), 16, 0, 0); } while (0)
#define PG8_LDA(dst, b, h) do { _Pragma("unroll") for (int m = 0; m < 4; ++m) _Pragma("unroll") for (int k = 0; k < 2; ++k) dst[m][k] = *(const PG8_LAS bf16x8*)(lds + PG8_SA(b, h) + aoff + m * 2048 + k * 1024); } while (0)
#define PG8_LDB(dst, b, h) do { _Pragma("unroll") for (int n = 0; n < 2; ++n) _Pragma("unroll") for (int k = 0; k < 2; ++k) dst[n][k] = *(const PG8_LAS bf16x8*)(lds + PG8_SB(b, h) + boff + n * 2048 + k * 1024); } while (0)
#define PG8_MMA(ai, bj, At, Bt) do { __builtin_amdgcn_s_setprio(1); _Pragma("unroll") for (int m = 0; m < 4; ++m) _Pragma("unroll") for (int n = 0; n < 2; ++n) _Pragma("unroll") for (int k = 0; k < 2; ++k) \
        acc[ai][bj][m][n] = __builtin_amdgcn_mfma_f32_16x16x32_bf16(Bt[n][k], At[m][k], acc[ai][bj][m][n], 0, 0, 0); __builtin_amdgcn_s_setprio(0); } while (0)
#define PG8_WAIT_V(n) asm volatile("s_waitcnt vmcnt(" #n ")" ::: "memory")
#define PG8_WAIT_L(n) asm volatile("s_waitcnt lgkmcnt(" #n ")" ::: "memory")
#define PG8_BAR __builtin_amdgcn_s_barrier()
#define PG8_SCHED __builtin_amdgcn_sched_barrier(0)
    Unit cur, nxt; int ui = 0;
    if (!S.next(0, cur)) return;
    f32x4 acc[2][2][4][2];
#pragma unroll
    for (int a = 0; a < 2; ++a)
#pragma unroll
        for (int b = 0; b < 2; ++b)
#pragma unroll
            for (int m = 0; m < 4; ++m)
#pragma unroll
                for (int n = 0; n < 2; ++n) acc[a][b][m][n] = (f32x4){0.f, 0.f, 0.f, 0.f};
    bf16x8 At[4][2], B0[2][2], B1[2][2];
    const char* cA = (const char*)g.A + (size_t)cur.pm * tstep; const char* cB = (const char*)g.Bt + (size_t)cur.pn * tstep;
    S.a_ready(cur);
    if constexpr (SP2) {
        PG8_STAGE(PG8_SB(0, 0), cB, voffB); PG8_STAGE(PG8_SB(0, 1), cB + hstep, voffB); PG8_STAGE(PG8_SA(0, 0), cA, voffA); PG8_STAGE(PG8_SA(0, 1), cA + hstep, voffA);
        if (wr == 1) PG8_BAR;
        PG8_WAIT_V(2); PG8_BAR;
        PG8_STAGE(PG8_SB(1, 0), cB + kstep, voffB); PG8_STAGE(PG8_SA(1, 0), cA + kstep, voffA); PG8_STAGE(PG8_SB(1, 1), cB + hstep + kstep, voffB);
        PG8_WAIT_V(6); PG8_BAR;
    } else {
        PG8_STAGE(PG8_SB(0, 0), cB, voffB); PG8_STAGE(PG8_SA(0, 0), cA, voffA); PG8_STAGE(PG8_SB(0, 1), cB + hstep, voffB); PG8_STAGE(PG8_SA(0, 1), cA + hstep, voffA);
        if (wr == 1) PG8_BAR;
        PG8_WAIT_V(4); PG8_BAR;
        PG8_STAGE(PG8_SB(1, 0), cB + kstep, voffB); PG8_STAGE(PG8_SA(1, 0), cA + kstep, voffA); PG8_STAGE(PG8_SB(1, 1), cB + hstep + kstep, voffB);
        PG8_WAIT_V(6); PG8_BAR;
    }
    for (;;) {
        const bool has_next = S.next(ui + 1, nxt);
        const char* nA = has_next ? (const char*)g.A + (size_t)nxt.pm * tstep : cA; const char* nB = has_next ? (const char*)g.Bt + (size_t)nxt.pn * tstep : cB;
        for (int t = 0; t < nt; t += 2) {
            const bool last = (t == nt - 2);
            const char* a1 = cA + (size_t)(t + 1) * kstep;
            const char* a2 = last ? nA : cA + (size_t)(t + 2) * kstep; const char* b2 = last ? nB : cB + (size_t)(t + 2) * kstep;
            const char* a3 = a2 + kstep; const char* b3 = b2 + kstep;
            if (last && has_next) S.a_ready(nxt);
            if constexpr (SP2) {
            PG8_LDB(B0, 0, 0); PG8_LDB(B1, 0, 1); PG8_SCHED; PG8_LDA(At, 0, 0); PG8_STAGE(PG8_SA(1, 1), a1 + hstep, voffA);
            PG8_WAIT_V(8); PG8_WAIT_L(0); PG8_BAR; PG8_MMA(0, 0, At, B0); PG8_MMA(0, 1, At, B1); PG8_BAR; PG8_SCHED;
            PG8_LDA(At, 0, 1); PG8_STAGE(PG8_SB(0, 0), b2, voffB); PG8_STAGE(PG8_SB(0, 1), b2 + hstep, voffB); PG8_STAGE(PG8_SA(0, 0), a2, voffA);
            PG8_WAIT_V(8); PG8_WAIT_L(0); PG8_BAR; PG8_MMA(1, 0, At, B0); PG8_MMA(1, 1, At, B1); PG8_BAR; PG8_SCHED;
            PG8_LDB(B0, 1, 0); PG8_LDB(B1, 1, 1); PG8_SCHED; PG8_LDA(At, 1, 0); PG8_STAGE(PG8_SA(0, 1), a2 + hstep, voffA);
            PG8_WAIT_V(8); PG8_WAIT_L(0); PG8_BAR; PG8_MMA(0, 0, At, B0); PG8_MMA(0, 1, At, B1); PG8_BAR; PG8_SCHED;
            PG8_LDA(At, 1, 1); PG8_STAGE(PG8_SB(1, 0), b3, voffB); PG8_STAGE(PG8_SB(1, 1), b3 + hstep, voffB); PG8_STAGE(PG8_SA(1, 0), a3, voffA);
            PG8_WAIT_V(8); PG8_WAIT_L(0); PG8_BAR; PG8_MMA(1, 0, At, B0); PG8_MMA(1, 1, At, B1); PG8_BAR; PG8_SCHED;
            } else {
            PG8_LDB(B0, 0, 0); PG8_SCHED; PG8_LDA(At, 0, 0); PG8_STAGE(PG8_SA(1, 1), a1 + hstep, voffA);
            PG8_WAIT_L(8); PG8_BAR; PG8_WAIT_L(0); PG8_MMA(0, 0, At, B0); PG8_BAR; PG8_SCHED;
            PG8_LDB(B1, 0, 1); PG8_STAGE(PG8_SB(0, 0), b2, voffB);
            PG8_BAR; PG8_WAIT_L(0); PG8_MMA(0, 1, At, B1); PG8_BAR;
            PG8_LDA(At, 0, 1); PG8_STAGE(PG8_SA(0, 0), a2, voffA);
            PG8_BAR; PG8_WAIT_L(0); PG8_MMA(1, 0, At, B0); PG8_BAR; PG8_SCHED;
            PG8_STAGE(PG8_SB(0, 1), b2 + hstep, voffB);
            PG8_WAIT_V(6); PG8_BAR; PG8_MMA(1, 1, At, B1); PG8_BAR;
            PG8_LDB(B0, 1, 0); PG8_SCHED; PG8_LDA(At, 1, 0); PG8_STAGE(PG8_SA(0, 1), a2 + hstep, voffA);
            PG8_WAIT_L(8); PG8_BAR; PG8_WAIT_L(0); PG8_MMA(0, 0, At, B0); PG8_BAR; PG8_SCHED;
            PG8_LDB(B1, 1, 1); PG8_STAGE(PG8_SB(1, 0), b3, voffB);
            PG8_BAR; PG8_WAIT_L(0); PG8_MMA(0, 1, At, B1); PG8_BAR;
            PG8_LDA(At, 1, 1); PG8_STAGE(PG8_SA(1, 0), a3, voffA);
            PG8_BAR; PG8_WAIT_L(0); PG8_MMA(1, 0, At, B0); PG8_BAR; PG8_SCHED;
            PG8_STAGE(PG8_SB(1, 1), b3 + hstep, voffB);
            PG8_WAIT_V(6); PG8_BAR; PG8_MMA(1, 1, At, B1); PG8_BAR;
            }
        }
        if constexpr (ALIGN_EPI) { if (wr == 0) PG8_BAR; }
        if constexpr (!Epi::AFTER_DRAIN) { E(acc, cur, wr, wc, fr, fq); S.done(cur); }
        if (!has_next) break;
#pragma unroll
        for (int a = 0; a < 2; ++a)
#pragma unroll
            for (int b = 0; b < 2; ++b)
#pragma unroll
                for (int m = 0; m < 4; ++m)
#pragma unroll
                    for (int n = 0; n < 2; ++n) acc[a][b][m][n] = (f32x4){0.f, 0.f, 0.f, 0.f};
        cur = nxt; cA = nA; cB = nB; ++ui;
        if constexpr (ALIGN_EPI) { if (wr == 1) PG8_BAR; }
    }
    PG8_WAIT_V(0);
    if constexpr (!ALIGN_EPI) { if (wr == 0) PG8_BAR; }
    PG8_BAR;
    if constexpr (Epi::AFTER_DRAIN) { E.fused(acc, cur, wr, wc, fr, fq, lds, wid, lane); S.done(cur); }
#undef PG8_SA
#undef PG8_SB
#undef PG8_STAGE
#undef PG8_LDA
#undef PG8_LDB
#undef PG8_MMA
#undef PG8_WAIT_V
#undef PG8_WAIT_L
#undef PG8_BAR
#undef PG8_SCHED
}
}

constexpr int NWAVES = 8, NTHR = 512;
constexpr int DM = 1024, SEQ = 16384, DB = 128, DSEQ = 4, NSAMP = DB * DSEQ, MTOT = SEQ + NSAMP;
constexpr int AH = 12, HD = 64, ATTW = 768, SH = 20, SSW = 1280, NG = 4, DSTATE = 128, CONVD = 2304, MIXW = 2048, DFF = 2816, DINP = 5908;
constexpr int NP = 6144;
constexpr int CQ = 0, CK = 768, CV = 1536, CZ = 2304, CX = 3584, CDT = 5888;
constexpr int WB = 2048;
constexpr int NCHUNK = 128, CL = 128;
constexpr float EPS = 1e-6f;
constexpr size_t O_YP = 0, O_YS = O_YP + (size_t)SEQ * DM, O_WKP = O_YS + (size_t)NSAMP * DM, O_WVP = O_WKP + (size_t)2048 * ATTW, O_CVP = O_WVP + (size_t)2048 * ATTW,
                 O_SSP = O_CVP + 3 * CONVD, O_WKS = O_SSP + (size_t)SH * HD * DSTATE, O_WVS = O_WKS + (size_t)NSAMP * ATTW, O_CVS = O_WVS + (size_t)NSAMP * ATTW,
                 O_SSS = O_CVS + (size_t)DB * 3 * CONVD, O_END = O_SSS + (size_t)DB * SH * HD * DSTATE;
constexpr size_t MiB = 1u << 20;
constexpr size_t WS_CTL = 0, CTL_ZERO_BYTES = 1 * MiB;
constexpr size_t CTL_SS2 = 256 * 1024, CTL_SS3 = 384 * 1024;
constexpr size_t WS_WIN = 2 * MiB;
constexpr size_t WS_WOUT = WS_WIN + (size_t)NP * DM * 2;
constexpr size_t WS_WGU = WS_WOUT + (size_t)DM * MIXW * 2;
constexpr size_t WS_WDN = WS_WGU + (size_t)2 * DFF * DM * 2;
constexpr size_t WS_BKT = WS_WDN + (size_t)DM * DFF * 2;
constexpr size_t WS_RS1 = WS_BKT + 16384;
constexpr size_t WS_ATTSS = WS_RS1 + (size_t)MTOT * 4;
constexpr size_t WS_DTB = WS_ATTSS + (size_t)MTOT * 12 * 4;
constexpr size_t WS_ACS = WS_DTB + (size_t)SEQ * 20 * 4;
constexpr size_t WS_CDEC = WS_ACS + (size_t)SEQ * 20 * 4;
constexpr size_t WS_XB = 64 * MiB;
constexpr size_t WS_PROJ = WS_XB + (size_t)MTOT * DM * 2;
constexpr size_t WS_MIX = WS_PROJ + (size_t)MTOT * NP * 2;
constexpr size_t WS_X1 = WS_MIX + (size_t)MTOT * MIXW * 2;
constexpr size_t WS_X1B = WS_X1 + (size_t)MTOT * DM * 4;
constexpr size_t WS_ACT = WS_X1B + (size_t)MTOT * DM * 2;
constexpr size_t WS_XC = WS_ACT + (size_t)MTOT * DFF * 2;
constexpr size_t WS_ST = WS_XC + (size_t)SEQ * CONVD * 2;
constexpr size_t WS_OPART = WS_ST + (size_t)NCHUNK * SH * HD * DSTATE * 4;
constexpr size_t WS_ML = WS_OPART + (size_t)3 * SEQ * ATTW * 2;
constexpr size_t WS_HIN = WS_ML + (size_t)3 * SEQ * AH * 2 * 4;
constexpr size_t WS_END = WS_HIN + (size_t)NCHUNK * SH * HD * DSTATE * 2;
static_assert(WS_CDEC + 128 * 20 * 4 <= WS_XB, "ws map");
constexpr int CW_BAR = 1024;
constexpr int RING_BYTES = 131072;
constexpr int MISC_OFF = 155648;
constexpr int LDS_BYTES = 155648 + 256;

#define GAS __attribute__((address_space(1)))
#define LAS __attribute__((address_space(3)))
typedef unsigned short bf16;
typedef unsigned v4u __attribute__((ext_vector_type(4)));
typedef float f32x4 __attribute__((ext_vector_type(4)));
typedef short bf16x8 __attribute__((ext_vector_type(8)));
typedef GAS unsigned gu32;
typedef GAS unsigned long long gu64;
#define RLX_AGENT __ATOMIC_RELAXED, __HIP_MEMORY_SCOPE_AGENT
#define LDS_WAIT() asm volatile("s_waitcnt lgkmcnt(0)" ::: "memory")
#define VM_WAIT() asm volatile("s_waitcnt vmcnt(0)" ::: "memory")
__device__ __forceinline__ unsigned long long rt() { return __builtin_amdgcn_s_memrealtime(); }
__device__ __forceinline__ unsigned f2bf(float f) { unsigned u = __builtin_bit_cast(unsigned, f); return (u + 0x7fffu + ((u >> 16) & 1u)) >> 16; }
__device__ __forceinline__ unsigned pk2(float lo, float hi) { return f2bf(lo) | (f2bf(hi) << 16); }

#define XB_TMO      128
#define XB_XCNT(j)  (256  + 64 * (j))
#define XB_XSUB(j)  (1280 + 64 * (j))
#define XB_XGEN(j)  (2304 + 64 * (j))
#define XB_TOP      3328
#define XB_TOPGEN   3392
#define XCD_BAR_WORDS 3456
#define XB_SPIN_CAP (1u << 23)

__device__ __forceinline__ unsigned xb_ld(unsigned* p)              { return __hip_atomic_load(p, __ATOMIC_RELAXED, __HIP_MEMORY_SCOPE_AGENT); }
__device__ __forceinline__ unsigned xb_add(unsigned* p, unsigned v) { return __hip_atomic_fetch_add(p, v, __ATOMIC_RELAXED, __HIP_MEMORY_SCOPE_AGENT); }
__device__ __forceinline__ unsigned xb_xcc_id() { return (unsigned)__builtin_amdgcn_s_getreg((3 << 11) | 20) & 0xFu; }
#define XB_SPIN(cond, bar) do { unsigned _sp = 0; while (cond) { __builtin_amdgcn_s_sleep(1); \
    if ((++_sp & 255u) == 0u) { if (xb_ld(&(bar)[XB_TMO])) break; if (_sp > XB_SPIN_CAP) { atomicAdd(&(bar)[XB_TMO], 1u); break; } } } } while (0)

struct XcdBarrier {
    unsigned* bar; unsigned x;
    volatile LAS unsigned* st;
};

__device__ __forceinline__ XcdBarrier xcd_barrier_post(unsigned* bar, volatile LAS unsigned* st) {
    XcdBarrier b; b.bar = bar; b.x = xb_xcc_id(); b.st = st;
    if (threadIdx.x == 0) (void)xb_add(&bar[XB_XCNT(b.x)], 1u);
    return b;
}
__device__ __forceinline__ void xcd_barrier_complete(unsigned* bar, unsigned x, unsigned& nloc, unsigned& nx) {
    const unsigned G = gridDim.x * gridDim.y * gridDim.z;
    unsigned sum, cnt, mine, sp = 0u;
    for (;;) {
        sum = 0u; cnt = 0u; mine = 0u;
#pragma unroll
        for (unsigned j = 0; j < 16; ++j) { const unsigned c = xb_ld(&bar[XB_XCNT(j)]); sum += c; cnt += (c > 0u) ? 1u : 0u; mine = (j == x) ? c : mine; }
        if (sum == G) break;
        __builtin_amdgcn_s_sleep(1);
        if ((++sp & 255u) == 0u) { if (xb_ld(&bar[XB_TMO])) break; if (sp > XB_SPIN_CAP) { atomicAdd(&bar[XB_TMO], 1u); break; } }
    }
    nloc = mine > 0u ? mine : 1u; nx = cnt > 0u ? cnt : 1u;
}

__device__ __forceinline__ void xcd_barrier(const XcdBarrier& b) {
    asm volatile("s_waitcnt vmcnt(0)" ::: "memory");
    __syncthreads();
    if (threadIdx.x == 0) {
        unsigned* bar = b.bar;
        __builtin_amdgcn_s_waitcnt(0);
        unsigned nloc = b.st[0], nx = b.st[1];
        if (nloc == 0u) { xcd_barrier_complete(bar, b.x, nloc, nx); b.st[0] = nloc; b.st[1] = nx; }
        const unsigned old = xb_add(&bar[XB_XSUB(b.x)], 1u);
        const unsigned gen = old / nloc;
        if (old + 1u == (gen + 1u) * nloc) {
            __builtin_amdgcn_fence(__ATOMIC_RELEASE, "agent");
            asm volatile("s_waitcnt vmcnt(0)" ::: "memory");
            const unsigned og = xb_add(&bar[XB_TOP], 1u);
            const unsigned tg = og / nx;
            if (og + 1u == (tg + 1u) * nx) xb_add(&bar[XB_TOPGEN], 1u);
            else XB_SPIN(xb_ld(&bar[XB_TOPGEN]) == tg, bar);
            __builtin_amdgcn_fence(__ATOMIC_ACQUIRE, "agent");
            xb_add(&bar[XB_XGEN(b.x)], 1u);
            asm volatile("s_waitcnt vmcnt(0)" ::: "memory");
        } else {
            XB_SPIN(xb_ld(&bar[XB_XGEN(b.x)]) == gen, bar);
            __builtin_amdgcn_fence(__ATOMIC_ACQUIRE, "agent");
            asm volatile("s_waitcnt vmcnt(0)" ::: "memory");
        }
    }
    __syncthreads();
}

__device__ __forceinline__ float bf2f(unsigned short u) { return __uint_as_float((unsigned)u << 16); }
__device__ __forceinline__ float wave_sum(float v) {
#pragma unroll
    for (int o = 1; o < 64; o <<= 1) v += __shfl_xor(v, o);
    return v;
}
__device__ __forceinline__ float silu_f(float x) { return x / (1.f + __expf(-x)); }
__device__ __forceinline__ float softplus_f(float x) { return x > 20.f ? x : log1pf(__expf(x)); }
__device__ __forceinline__ int rel_bucket(int n) {
    if (n < 16) return n;
    const float v = logf((float)n / 16.0f) / 4.852030263919617f * 16.0f;
    int b = 16 + (int)v; return b > 31 ? 31 : b;
}
__device__ __forceinline__ int attn_mult(int delta) {
    return (delta <= 128 ? 1 : 0) + (((delta & 3) == 0 && delta <= 512) ? 1 : 0) + (((delta & 15) == 0 && delta <= 2048) ? 1 : 0);
}

__device__ __forceinline__ int lnd(int x) { asm volatile("" : "+v"(x)); return x; }
struct Frame {
    LAS unsigned char* lds;
    int tid, lane, wave, G;
    const float* in[22]; float* out; unsigned char* ws;
};
#define WSP(T, off) ((T*)(F.ws + (off)))

template <int MODE>
__device__ __forceinline__ void tr_item(const float* W, int K, int N, const float* gain, bf16* WT, LAS float* scr, int kb, int nb, int lane) {
    const int k0 = 64 * kb, n0 = 32 * nb;
    {
        const int n = n0 + (lane & 31);
#pragma unroll 8
        for (int i = 0; i < 32; ++i) { const int kk = 2 * i + (lane >> 5); float v = (n < N) ? W[(size_t)(k0 + kk) * N + n] : 0.f; if (gain) v *= gain[k0 + kk]; scr[kk * 33 + (lane & 31)] = v; }
    }
    LDS_WAIT(); asm volatile("" ::: "memory");
    const int c = lane & 7;
#pragma unroll
    for (int j = 0; j < 4; ++j) { const int nl = (lane >> 3) + 8 * j, n = n0 + nl; const LAS float* s = scr + (8 * c) * 33 + nl;
        v4u o; o.x = pk2(s[0 * 33], s[1 * 33]); o.y = pk2(s[2 * 33], s[3 * 33]); o.z = pk2(s[4 * 33], s[5 * 33]); o.w = pk2(s[6 * 33], s[7 * 33]);
        int drow = n; if (MODE == 1) drow = (n >> 7) * 256 + (n & 127); if (MODE == 2) drow = (n >> 7) * 256 + 128 + (n & 127);
        *(GAS v4u*)(WT + (size_t)drow * K + k0 + 8 * c) = o; }
    LDS_WAIT(); asm volatile("" ::: "memory");
}
__device__ __forceinline__ void p0_prologue(Frame& F) {
    LAS float* scr = (LAS float*)(F.lds + F.wave * 16384);
    const int gw = blockIdx.x * NWAVES + F.wave, NGW = F.G * NWAVES;
    constexpr int I_IN = 16 * 192, I_OUT = 32 * 32, I_G = 16 * 88, I_D = 44 * 32;
    constexpr int NITEMS = I_IN + I_OUT + 2 * I_G + I_D;
    for (int it = gw; it < NITEMS; it += NGW) {
        int r = it;
        if (r < I_IN) { tr_item<0>(F.in[8], DM, DINP, F.in[7], WSP(bf16, WS_WIN), scr, r / 192, r % 192, F.lane); continue; } r -= I_IN;
        if (r < I_OUT) { tr_item<0>(F.in[16], MIXW, DM, nullptr, WSP(bf16, WS_WOUT), scr, r / 32, r % 32, F.lane); continue; } r -= I_OUT;
        if (r < I_G) { tr_item<1>(F.in[18], DM, DFF, F.in[17], WSP(bf16, WS_WGU), scr, r / 88, r % 88, F.lane); continue; } r -= I_G;
        if (r < I_G) { tr_item<2>(F.in[19], DM, DFF, F.in[17], WSP(bf16, WS_WGU), scr, r / 88, r % 88, F.lane); continue; } r -= I_G;
        tr_item<0>(F.in[20], DFF, DM, nullptr, WSP(bf16, WS_WDN), scr, r / 32, r % 32, F.lane);
    }
    bf16* XB = WSP(bf16, WS_XB); float* RS1 = WSP(float, WS_RS1);
    for (int m = gw; m < MTOT; m += NGW) {
        const float* xrow = m < SEQ ? F.in[0] + (size_t)m * DM : F.in[1] + (size_t)(m - SEQ) * DM;
        const GAS f32x4* xr = (const GAS f32x4*)xrow + F.lane;
        f32x4 v[4]; float s = 0.f;
#pragma unroll
        for (int j = 0; j < 4; ++j) { v[j] = xr[64 * j]; s += (v[j].x * v[j].x + v[j].y * v[j].y) + (v[j].z * v[j].z + v[j].w * v[j].w); }
        s = wave_sum(s);
        GAS unsigned long long* o8 = (GAS unsigned long long*)(XB + (size_t)m * DM) + F.lane;
#pragma unroll
        for (int j = 0; j < 4; ++j) o8[64 * j] = (unsigned long long)pk2(v[j].x, v[j].y) | ((unsigned long long)pk2(v[j].z, v[j].w) << 32);
        if (F.lane == 0) RS1[m] = 1.0f / sqrtf(s * (1.0f / DM) + EPS);
    }
    int* BKT = WSP(int, WS_BKT);
    for (int i = blockIdx.x * NTHR + F.tid; i <= 2048; i += F.G * NTHR) BKT[i] = rel_bucket(i);
}

struct EpiProj {
    static constexpr bool PERM = true, AFTER_DRAIN = false;
    bf16* O; const float* rs; float* out;
    __device__ __forceinline__ void operator()(const pg8::f32x4 (&acc)[2][2][4][2], const pg8::Unit& u, int wr, int wc, int fr, int fq) const {
        const int row0 = u.pm * 256 + wr * 64 + fr, col0 = u.pn * 256 + wc * 32 + 8 * fq;
        const bool kv = (u.pm >= 56) && (u.pn >= 3) && (u.pn < 9); const bool is_k = u.pn < 6;
#pragma unroll
        for (int ai = 0; ai < 2; ++ai)
#pragma unroll
            for (int m = 0; m < 4; ++m) { const int row = row0 + ai * 128 + m * 16; const float s = rs[row];
#pragma unroll
                for (int bj = 0; bj < 2; ++bj) { const int col = col0 + bj * 128; const pg8::f32x4 v0 = acc[ai][bj][m][0] * s, v1 = acc[ai][bj][m][1] * s;
                    pg8::u32x4 w; w.x = pg8::cvt_pk_bf16(v0[0], v0[1]); w.y = pg8::cvt_pk_bf16(v0[2], v0[3]); w.z = pg8::cvt_pk_bf16(v1[0], v1[1]); w.w = pg8::cvt_pk_bf16(v1[2], v1[3]);
                    *(pg8::u32x4*)(O + (size_t)row * NP + col) = w;
                    if (kv) { const int cc = col - (is_k ? CK : CV);
                        float* dst = row < SEQ ? out + (is_k ? O_WKP : O_WVP) + (size_t)(row - (SEQ - 2048)) * ATTW + cc : out + (is_k ? O_WKS : O_WVS) + (size_t)(row - SEQ) * ATTW + cc;
                        *(pg8::f32x4*)dst = v0; *(pg8::f32x4*)(dst + 4) = v1; } } }
    }
};
struct EpiOut {
    static constexpr bool PERM = false, AFTER_DRAIN = false;
    const float* xp; const float* xs; float* X1; bf16* X1B; float* SS;
    __device__ __forceinline__ void operator()(const pg8::f32x4 (&acc)[2][2][4][2], const pg8::Unit& u, int wr, int wc, int fr, int fq) const {
        const int row0 = u.pm * 256 + wr * 64 + fr, col0 = u.pn * 256 + wc * 32 + 4 * fq;
#pragma unroll
        for (int ai = 0; ai < 2; ++ai)
#pragma unroll
            for (int m = 0; m < 4; ++m) { const int row = row0 + ai * 128 + m * 16; const float* xr = row < SEQ ? xp + (size_t)row * DM : xs + (size_t)(row - SEQ) * DM; float ss = 0.f;
#pragma unroll
                for (int bj = 0; bj < 2; ++bj)
#pragma unroll
                    for (int n = 0; n < 2; ++n) { const int col = col0 + bj * 128 + n * 16; const pg8::f32x4 v = acc[ai][bj][m][n] + *(const pg8::f32x4*)(xr + col);
                        *(pg8::f32x4*)(X1 + (size_t)row * DM + col) = v; ss += (v[0] * v[0] + v[1] * v[1]) + (v[2] * v[2] + v[3] * v[3]);
                        *(unsigned long long*)(X1B + (size_t)row * DM + col) = (unsigned long long)pg8::cvt_pk_bf16(v[0], v[1]) | ((unsigned long long)pg8::cvt_pk_bf16(v[2], v[3]) << 32); }
                ss += __shfl_xor(ss, 16); ss += __shfl_xor(ss, 32);
                if (fq == 0) atomicAdd(SS + row, ss); }
    }
};
struct EpiGU {
    static constexpr bool PERM = true, AFTER_DRAIN = false;
    bf16* ACT; const float* SS;
    __device__ __forceinline__ void operator()(const pg8::f32x4 (&acc)[2][2][4][2], const pg8::Unit& u, int wr, int wc, int fr, int fq) const {
        const int row0 = u.pm * 256 + wr * 64 + fr, col0 = u.pn * 128 + wc * 32 + 8 * fq;
#pragma unroll
        for (int ai = 0; ai < 2; ++ai)
#pragma unroll
            for (int m = 0; m < 4; ++m) { const int row = row0 + ai * 128 + m * 16; const float s = 1.0f / sqrtf(SS[row] * (1.0f / DM) + EPS);
                float a[8];
#pragma unroll
                for (int n = 0; n < 2; ++n)
#pragma unroll
                    for (int e = 0; e < 4; ++e) { const float g = acc[ai][0][m][n][e] * s, uu = acc[ai][1][m][n][e] * s; a[4 * n + e] = silu_f(g) * uu; }
                pg8::u32x4 w; w.x = pg8::cvt_pk_bf16(a[0], a[1]); w.y = pg8::cvt_pk_bf16(a[2], a[3]); w.z = pg8::cvt_pk_bf16(a[4], a[5]); w.w = pg8::cvt_pk_bf16(a[6], a[7]);
                *(pg8::u32x4*)(ACT + (size_t)row * DFF + col0) = w; }
    }
};
struct EpiDown {
    static constexpr bool PERM = false, AFTER_DRAIN = false;
    const float* X1; float* Y; float* SS;
    __device__ __forceinline__ void operator()(const pg8::f32x4 (&acc)[2][2][4][2], const pg8::Unit& u, int wr, int wc, int fr, int fq) const {
        const int row0 = u.pm * 256 + wr * 64 + fr, col0 = u.pn * 256 + wc * 32 + 4 * fq;
#pragma unroll
        for (int ai = 0; ai < 2; ++ai)
#pragma unroll
            for (int m = 0; m < 4; ++m) { const int row = row0 + ai * 128 + m * 16; float ss = 0.f;
#pragma unroll
                for (int bj = 0; bj < 2; ++bj)
#pragma unroll
                    for (int n = 0; n < 2; ++n) { const int col = col0 + bj * 128 + n * 16; const pg8::f32x4 v = acc[ai][bj][m][n] + *(const pg8::f32x4*)(X1 + (size_t)row * DM + col);
                        *(pg8::f32x4*)(Y + (size_t)row * DM + col) = v; ss += (v[0] * v[0] + v[1] * v[1]) + (v[2] * v[2] + v[3] * v[3]); }
                ss += __shfl_xor(ss, 16); ss += __shfl_xor(ss, 32);
                if (fq == 0) atomicAdd(SS + row, ss); }
    }
};

__device__ __forceinline__ void attn_prompt_simple(Frame& F) {
    const bf16* PROJ = WSP(bf16, WS_PROJ); bf16* MIX = WSP(bf16, WS_MIX); float* ATTSS = WSP(float, WS_ATTSS);
    const int* BKT = WSP(int, WS_BKT); const float* relb = F.in[6];
    const int gw = blockIdx.x * NWAVES + F.wave, NGW = F.G * NWAVES, lane = lnd(F.lane);
    for (int t = gw; t < SEQ; t += NGW) {
        for (int h = 0; h < AH; ++h) {
            const float q = bf2f(PROJ[(size_t)t * NP + CQ + h * 64 + lane]) * 0.125f;
            float m = -1e30f, l = 0.f, o = 0.f;
            for (int br = 0; br < 3; ++br) {
                const int d = (br == 0) ? 1 : (br == 1) ? 4 : 16;
                int imax = t / d; if (imax > 128) imax = 128;
                int i = 0;
                for (; i + 3 <= imax; i += 4) {
                    float k[4], v[4], s[4];
#pragma unroll
                    for (int j = 0; j < 4; ++j) { const bf16* kp = PROJ + (size_t)(t - (i + j) * d) * NP + CK + h * 64 + lane; k[j] = bf2f(kp[0]); v[j] = bf2f(kp[CV - CK]); s[j] = q * k[j]; }
#pragma unroll
                    for (int o_ = 1; o_ < 64; o_ <<= 1) {
#pragma unroll
                        for (int j = 0; j < 4; ++j) s[j] += __shfl_xor(s[j], o_); }
#pragma unroll
                    for (int j = 0; j < 4; ++j) s[j] += relb[BKT[(i + j) * d] * AH + h];
                    const float mn = fmaxf(fmaxf(fmaxf(m, s[0]), fmaxf(s[1], s[2])), s[3]);
                    const float a = __expf(m - mn); l *= a; o *= a; m = mn;
#pragma unroll
                    for (int j = 0; j < 4; ++j) { const float p = __expf(s[j] - mn); l += p; o += p * v[j]; }
                }
                for (; i <= imax; ++i) {
                    const bf16* kp = PROJ + (size_t)(t - i * d) * NP + CK + h * 64 + lane;
                    const float kk = bf2f(kp[0]), vv = bf2f(kp[CV - CK]);
                    const float s = wave_sum(q * kk) + relb[BKT[i * d] * AH + h];
                    const float mn = fmaxf(m, s); const float a = __expf(m - mn), p = __expf(s - mn);
                    l = l * a + p; o = o * a + p * vv; m = mn;
                }
            }
            const float r = o / l;
            MIX[(size_t)t * MIXW + h * 64 + lane] = (bf16)f2bf(r);
            const float sq = wave_sum(r * r); if (lane == 0) ATTSS[t * AH + h] = sq;
        }
    }
}


typedef short v4i16_t __attribute__((ext_vector_type(4)));
typedef float f32x16 __attribute__((ext_vector_type(16)));
__device__ __forceinline__ void attn_prompt_mfma(Frame& F) {
    const bf16* PROJ = WSP(bf16, WS_PROJ); bf16* OPART = WSP(bf16, WS_OPART); float* ML = WSP(float, WS_ML);
    const int* BKT = WSP(int, WS_BKT); const float* relb = F.in[6];
    LAS unsigned char* Kl = F.lds; LAS unsigned char* Vl = F.lds + 49152; LAS float* btab = (LAS float*)(F.lds + 98304);
    const int tid = lnd(F.tid), lane = lnd(F.lane), wave = F.wave, q = lane & 31, hi = lane >> 5;
    constexpr float LOG2E = 1.4426950408889634f, C1 = 0.125f * LOG2E, NEG = -1e30f;
    for (int unit = blockIdx.x; unit < 3 * AH * 64; unit += F.G) {
        const int br = unit / 768, rem = unit % 768, h = rem >> 6, blk = rem & 63;
        const int dsh = 2 * br, d = 1 << dsh, r = blk & (d - 1), qb = blk >> dsh, j0 = qb * 256;
        for (int n = wave; n < 48; n += 8) {
            const int row = 8 * n + (lane >> 3), pc = lane & 7; int jj = j0 - 128 + row; if (jj < 0) jj = 0;
            const size_t tok = (size_t)jj * d + r;
            const int lcK = pc ^ ((row >> 1) & 7), lcV = pc ^ (((row >> 1) & 1) << 2);
            __builtin_amdgcn_global_load_lds((const unsigned*)(PROJ + tok * NP + CK + h * 64 + lcK * 8), (LAS unsigned*)(Kl + n * 1024), 16, 0, 0);
            __builtin_amdgcn_global_load_lds((const unsigned*)(PROJ + tok * NP + CV + h * 64 + lcV * 8), (LAS unsigned*)(Vl + n * 1024), 16, 0, 0);
        }
        if (tid < 129) btab[tid] = relb[BKT[tid * d] * AH + h] * LOG2E;
        const size_t tokq = (size_t)(j0 + 32 * wave + q) * d + r;
        bf16x8 qf[4];
#pragma unroll
        for (int s = 0; s < 4; ++s) qf[s] = *(const bf16x8*)(PROJ + tokq * NP + CQ + h * 64 + 16 * s + 8 * hi);
        asm volatile("s_waitcnt vmcnt(0)" ::: "memory");
        __syncthreads();
        f32x16 S[5];
#pragma unroll
        for (int kt = 0; kt < 5; ++kt) {
            const int row0 = 32 * (wave + kt);
            if (j0 - 128 + row0 >= 0) {
                f32x16 acc;
#pragma unroll
                for (int e = 0; e < 16; ++e) acc[e] = 0.f;
                const int krow = row0 + q;
#pragma unroll
                for (int s = 0; s < 4; ++s) { const bf16x8 kf = *(const LAS bf16x8*)(Kl + krow * 128 + (((2 * s + hi) ^ ((krow >> 1) & 7)) << 4));
                    acc = __builtin_amdgcn_mfma_f32_32x32x16_bf16(kf, qf[s], acc, 0, 0, 0); }
#pragma unroll
                for (int e = 0; e < 16; ++e) { const int kl = (e & 3) + 8 * (e >> 2) + 4 * hi; const int i = 128 - 32 * kt + q - kl;
                    const int ic = i < 0 ? 0 : (i > 128 ? 128 : i);
                    const float v = acc[e] * C1 + btab[ic];
                    S[kt][e] = (kt == 0 || kt == 4) ? ((i >= 0 && i <= 128) ? v : NEG) : v; }
            } else {
#pragma unroll
                for (int e = 0; e < 16; ++e) S[kt][e] = NEG;
            }
        }
        float m = NEG;
#pragma unroll
        for (int kt = 0; kt < 5; ++kt)
#pragma unroll
            for (int e = 0; e < 16; ++e) m = fmaxf(m, S[kt][e]);
        m = fmaxf(m, __shfl_xor(m, 32));
        float l = 0.f;
        bf16x8 Pk[5][2];
#pragma unroll
        for (int kt = 0; kt < 5; ++kt) {
#pragma unroll
            for (int e = 0; e < 16; ++e) { const float p = __builtin_amdgcn_exp2f(S[kt][e] - m); S[kt][e] = p; l += p; }
#pragma unroll
            for (int s2 = 0; s2 < 2; ++s2) { v4u w; w.x = pk2(S[kt][8 * s2 + 0], S[kt][8 * s2 + 1]); w.y = pk2(S[kt][8 * s2 + 2], S[kt][8 * s2 + 3]); w.z = pk2(S[kt][8 * s2 + 4], S[kt][8 * s2 + 5]); w.w = pk2(S[kt][8 * s2 + 6], S[kt][8 * s2 + 7]);
                Pk[kt][s2] = __builtin_bit_cast(bf16x8, w); }
        }
        l += __shfl_xor(l, 32);
        f32x16 OT[2];
#pragma unroll
        for (int e = 0; e < 16; ++e) { OT[0][e] = 0.f; OT[1][e] = 0.f; }
        const int g2 = (lane >> 4) & 1, qq = (lane & 15) >> 2, pp = lane & 3;
#pragma unroll
        for (int kt = 0; kt < 5; ++kt) {
            const int row0 = 32 * (wave + kt);
            if (j0 - 128 + row0 >= 0) {
#pragma unroll
                for (int s2 = 0; s2 < 2; ++s2)
#pragma unroll
                    for (int d0 = 0; d0 < 2; ++d0) {
                        const int rlo = row0 + 16 * s2 + 4 * hi + qq, rhi = rlo + 8;
                        const int lc = 4 * d0 + 2 * g2 + (pp >> 1);
                        const LAS unsigned char* alo = Vl + rlo * 128 + ((lc ^ (((rlo >> 1) & 1) << 2)) << 4) + 8 * (pp & 1);
                        const LAS unsigned char* ahi = Vl + rhi * 128 + ((lc ^ (((rhi >> 1) & 1) << 2)) << 4) + 8 * (pp & 1);
                        const v4i16_t lo = __builtin_amdgcn_ds_read_tr16_b64_v4i16((LAS v4i16_t*)alo);
                        const v4i16_t hh = __builtin_amdgcn_ds_read_tr16_b64_v4i16((LAS v4i16_t*)ahi);
                        const bf16x8 vf = (bf16x8){lo[0], lo[1], lo[2], lo[3], hh[0], hh[1], hh[2], hh[3]};
                        OT[d0] = __builtin_amdgcn_mfma_f32_32x32x16_bf16(vf, Pk[kt][s2], OT[d0], 0, 0, 0);
                    }
            }
        }
        const float inv = 1.0f / l;
        bf16* op = OPART + ((size_t)br * SEQ + tokq) * ATTW + h * 64;
#pragma unroll
        for (int d0 = 0; d0 < 2; ++d0)
#pragma unroll
            for (int g = 0; g < 4; ++g) { const int dd = 32 * d0 + 8 * g + 4 * hi;
                *(unsigned long long*)(op + dd) = (unsigned long long)pk2(OT[d0][4 * g] * inv, OT[d0][4 * g + 1] * inv) | ((unsigned long long)pk2(OT[d0][4 * g + 2] * inv, OT[d0][4 * g + 3] * inv) << 32); }
        if (hi == 0) { float* mp = ML + (((size_t)br * SEQ + tokq) * AH + h) * 2; mp[0] = m; mp[1] = l; }
        __syncthreads();
    }
}

template <int CTRL> __device__ __forceinline__ float dpp_f(float x) { return __int_as_float(__builtin_amdgcn_update_dpp(0, __float_as_int(x), CTRL, 0xf, 0xf, true)); }
__device__ __forceinline__ float sum16(float x) { x += dpp_f<0xB1>(x); x += dpp_f<0x4E>(x); x += dpp_f<0x141>(x); x += dpp_f<0x140>(x); return x; }
__device__ __forceinline__ int samp_rho(int e) { return e < 384 ? 16 * (e >> 2) + (e & 3) : (e < 768 ? 1536 + (e - 384) : 1920 + (e - 768)); }
__device__ __forceinline__ void attn_sample(Frame& F) {
    const bf16* PROJ = WSP(bf16, WS_PROJ); bf16* MIX = WSP(bf16, WS_MIX); float* ATTSS = WSP(float, WS_ATTSS);
    const int* BKT = WSP(int, WS_BKT); const float* relb = F.in[6];
    const float* cache_k = F.in[2]; const float* cache_v = F.in[3];
    const int wave = F.wave;
    LAS float* comb = (LAS float*)F.lds;
    LAS float* btab = (LAS float*)(F.lds + 49152);
    constexpr float LOG2E = 1.4426950408889634f, NEG = -1e30f;
    for (int unit = blockIdx.x; unit < DB * 6; unit += F.G) {
        const int tid = lnd(F.tid), lane = lnd(F.lane), r2 = lane >> 5, hd = (lane >> 4) & 1, d0 = 4 * (lane & 15);
        const int b = unit / 6, hp = unit % 6, head = 2 * hp + hd;
        for (int i = tid; i < 2052 * 2; i += NTHR) { const int dl = i >> 1; btab[i] = relb[BKT[dl > 2048 ? 2048 : dl] * AH + 2 * hp + (i & 1)] * LOG2E; }
        float q[4][4];
#pragma unroll
        for (int t = 0; t < 4; ++t) { const bf16* qp = PROJ + (size_t)(SEQ + 4 * b + t) * NP + CQ + head * 64 + d0;
#pragma unroll
            for (int e = 0; e < 4; ++e) q[t][e] = bf2f(qp[e]) * (0.125f * LOG2E); }
        float m[4], l[4], o[4][4];
#pragma unroll
        for (int t = 0; t < 4; ++t) { m[t] = NEG; l[t] = 0.f;
#pragma unroll
            for (int e = 0; e < 4; ++e) o[t][e] = 0.f; }
        __syncthreads();
#define SAMP_ROW(KK, VV, RHO) do { \
            _Pragma("unroll") for (int t = 0; t < 4; ++t) { \
                const int delta = WB + t - (RHO); const int mu = delta >= 0 ? attn_mult(delta) : 0; \
                float s = (q[t][0] * KK[0] + q[t][1] * KK[1]) + (q[t][2] * KK[2] + q[t][3] * KK[3]); \
                s = sum16(s) + btab[(delta < 0 ? 0 : delta) * 2 + hd]; \
                s = mu > 0 ? s : NEG; \
                const float mn = fmaxf(m[t], s); const float a = __builtin_amdgcn_exp2f(m[t] - mn), pw = (float)mu * __builtin_amdgcn_exp2f(s - mn); \
                l[t] = l[t] * a + pw; m[t] = mn; \
                _Pragma("unroll") for (int e2 = 0; e2 < 4; ++e2) o[t][e2] = o[t][e2] * a + pw * VV[e2]; } } while (0)
#pragma unroll 1
        for (int bt = 0; bt < 7; ++bt) {
            f32x4 kk[8], vv[8]; int rho[8];
#pragma unroll
            for (int j = 0; j < 8; ++j) { const int pi = wave + 8 * (bt * 8 + j); rho[j] = samp_rho(2 * pi + r2);
                const size_t off = (((size_t)b * WB + rho[j]) * AH + head) * HD + d0; kk[j] = *(const f32x4*)(cache_k + off); vv[j] = *(const f32x4*)(cache_v + off); }
#pragma unroll
            for (int j = 0; j < 8; ++j) SAMP_ROW(kk[j], vv[j], rho[j]);
        }
        if (wave == 0) {
#pragma unroll
            for (int j = 0; j < 2; ++j) { const int rn = 2 * j + r2; const bf16* kp = PROJ + (size_t)(SEQ + 4 * b + rn) * NP + CK + head * 64 + d0;
                const f32x4 kn = (f32x4){bf2f(kp[0]), bf2f(kp[1]), bf2f(kp[2]), bf2f(kp[3])}, vn = (f32x4){bf2f(kp[CV - CK]), bf2f(kp[CV - CK + 1]), bf2f(kp[CV - CK + 2]), bf2f(kp[CV - CK + 3])};
                SAMP_ROW(kn, vn, WB + rn); }
        }
#undef SAMP_ROW
#pragma unroll
        for (int t = 0; t < 4; ++t) { LAS float* cr = comb + ((wave * 4 + t) * 64 + lane) * 6; cr[0] = m[t]; cr[1] = l[t]; cr[2] = o[t][0]; cr[3] = o[t][1]; cr[4] = o[t][2]; cr[5] = o[t][3]; }
        __syncthreads();
        const int tid2 = lnd(F.tid);
        if (tid2 < 128) {
            const int t = tid2 >> 5, hd2 = (tid2 >> 4) & 1, dl = tid2 & 15;
            float mm = NEG;
#pragma unroll
            for (int w = 0; w < 16; ++w) mm = fmaxf(mm, comb[(((w >> 1) * 4 + t) * 64 + (w & 1) * 32 + hd2 * 16 + dl) * 6]);
            float ll = 0.f, oo[4] = {0.f, 0.f, 0.f, 0.f};
#pragma unroll
            for (int w = 0; w < 16; ++w) { const LAS float* cr = comb + (((w >> 1) * 4 + t) * 64 + (w & 1) * 32 + hd2 * 16 + dl) * 6; const float a = __builtin_amdgcn_exp2f(cr[0] - mm); ll += cr[1] * a;
#pragma unroll
                for (int e2 = 0; e2 < 4; ++e2) oo[e2] += cr[2 + e2] * a; }
            const float inv = 1.0f / ll; float sq = 0.f;
#pragma unroll
            for (int e2 = 0; e2 < 4; ++e2) { oo[e2] *= inv; sq += oo[e2] * oo[e2]; }
            const int row = SEQ + 4 * b + t, hh = 2 * hp + hd2;
            *(unsigned long long*)(MIX + (size_t)row * MIXW + hh * 64 + 4 * dl) = (unsigned long long)pk2(oo[0], oo[1]) | ((unsigned long long)pk2(oo[2], oo[3]) << 32);
            sq = sum16(sq);
            if (dl == 0) ATTSS[row * AH + hh] = sq;
        }
        __syncthreads();
    }
}

__device__ __forceinline__ void ssd_phase_a(Frame& F) {
    const bf16* PROJ = WSP(bf16, WS_PROJ); bf16* XC = WSP(bf16, WS_XC); float* DTB = WSP(float, WS_DTB); float* ACS = WSP(float, WS_ACS); float* CDEC = WSP(float, WS_CDEC); float* ST = WSP(float, WS_ST);
    const float* conv_w = F.in[9]; const float* conv_b = F.in[10]; const float* dt_bias = F.in[11]; const float* a_log = F.in[12];
    LAS bf16* xs = (LAS bf16*)F.lds;
    LAS bf16* Bs = (LAS bf16*)(F.lds + 81920);
    LAS float* dts = (LAS float*)(F.lds + 81920 + 32768);
    LAS float* acsS = dts + 640;
    LAS float* wl = acsS + 640;
    const int tid = lnd(F.tid), lane = lnd(F.lane), wave = F.wave;
    for (int unit = blockIdx.x; unit < NCHUNK * NG; unit += F.G) {
        const int c = unit >> 2, g = unit & 3, T0 = c * CL;
        for (int task = tid; task < 576 * 8; task += NTHR) {
            const int cj = task % 576, seg = task / 576;
            const int xcol = cj < 320 ? g * 320 + cj : (cj < 448 ? 1280 + g * 128 + (cj - 320) : 1792 + g * 128 + (cj - 448));
            const float w0 = conv_w[xcol], w1 = conv_w[CONVD + xcol], w2 = conv_w[2 * CONVD + xcol], w3 = conv_w[3 * CONVD + xcol], bb = conv_b[xcol];
            const int t0 = T0 + seg * 16;
            float x0 = t0 >= 3 ? bf2f(PROJ[(size_t)(t0 - 3) * NP + CX + xcol]) : 0.f, x1 = t0 >= 2 ? bf2f(PROJ[(size_t)(t0 - 2) * NP + CX + xcol]) : 0.f, x2 = t0 >= 1 ? bf2f(PROJ[(size_t)(t0 - 1) * NP + CX + xcol]) : 0.f;
#pragma unroll 4
            for (int i = 0; i < 16; ++i) { const float x3 = bf2f(PROJ[(size_t)(t0 + i) * NP + CX + xcol]);
                const float y = silu_f(x0 * w0 + x1 * w1 + x2 * w2 + x3 * w3 + bb); const bf16 yb = (bf16)f2bf(y);
                XC[(size_t)(t0 + i) * CONVD + xcol] = yb;
                const int l = seg * 16 + i;
                if (cj < 320) xs[l * 320 + cj] = yb; else if (cj < 448) Bs[l * 128 + (cj - 320)] = yb;
                x0 = x1; x1 = x2; x2 = x3; }
            if (c == NCHUNK - 1 && seg == 7) {
                F.out[O_CVP + 0 * CONVD + xcol] = x0; F.out[O_CVP + 1 * CONVD + xcol] = x1; F.out[O_CVP + 2 * CONVD + xcol] = x2; }
        }
        for (int i = tid; i < 640; i += NTHR) { const int l = i / 5, hl = i % 5, h = g * 5 + hl;
            const float dt = softplus_f(bf2f(PROJ[(size_t)(T0 + l) * NP + CDT + h]) + dt_bias[h]);
            dts[i] = dt; acsS[i] = dt * (-__expf(a_log[h])); DTB[(size_t)(T0 + l) * SH + h] = dt; }
        __syncthreads();
        if (wave < 5) {
            const int hl = wave; const float a0 = acsS[(2 * lane) * 5 + hl], a1 = acsS[(2 * lane + 1) * 5 + hl];
            float s = a0 + a1;
#pragma unroll
            for (int o = 1; o < 64; o <<= 1) { const float u = __shfl_up(s, o); if (lane >= o) s += u; }
            const float e0 = s - a1;
            acsS[(2 * lane) * 5 + hl] = e0; acsS[(2 * lane + 1) * 5 + hl] = s;
            ACS[(size_t)(T0 + 2 * lane) * SH + g * 5 + hl] = e0; ACS[(size_t)(T0 + 2 * lane + 1) * SH + g * 5 + hl] = s;
            if (lane == 63) CDEC[c * SH + g * 5 + hl] = __expf(s);
        }
        __syncthreads();
        const int n = tid & 127, pq = __builtin_amdgcn_readfirstlane(tid >> 7);
        for (int hl = 0; hl < 5; ++hl) {
            if (tid < 128) wl[tid] = __expf(acsS[127 * 5 + hl] - acsS[tid * 5 + hl]) * dts[tid * 5 + hl];
            __syncthreads();
            float acc[16];
#pragma unroll
            for (int j = 0; j < 16; ++j) acc[j] = 0.f;
            for (int l = 0; l < CL; ++l) { const float bw = bf2f(Bs[l * 128 + n]) * wl[l];
                const LAS bf16* xr = xs + l * 320 + hl * 64 + pq * 16;
#pragma unroll
                for (int j = 0; j < 16; ++j) acc[j] += bw * bf2f(xr[j]); }
            float* dst = ST + (((size_t)c * SH + g * 5 + hl) * HD + pq * 16) * DSTATE + n;
#pragma unroll
            for (int j = 0; j < 16; ++j) dst[(size_t)j * DSTATE] = acc[j];
            __syncthreads();
        }
    }
}


__device__ __forceinline__ void ssd_phase_a_mfma(Frame& F) {
    const bf16* PROJ = WSP(bf16, WS_PROJ); bf16* XC = WSP(bf16, WS_XC); float* DTB = WSP(float, WS_DTB); float* ACS = WSP(float, WS_ACS); float* CDEC = WSP(float, WS_CDEC); float* ST = WSP(float, WS_ST);
    const float* conv_w = F.in[9]; const float* conv_b = F.in[10]; const float* dt_bias = F.in[11]; const float* a_log = F.in[12];
    LAS unsigned char* xim = F.lds;
    LAS unsigned char* Bim = F.lds + 81920;
    LAS float* dts = (LAS float*)(F.lds + 114688);
    LAS float* acsS = dts + 640;
    LAS float* wls = acsS + 640;
    const int tid = lnd(F.tid), lane = lnd(F.lane), wave = F.wave;
    for (int unit = blockIdx.x; unit < NCHUNK * NG; unit += F.G) {
        const int c = unit >> 2, g = unit & 3, T0 = c * CL;
        for (int i = tid; i < 640; i += NTHR) { const int l = i / 5, hl = i % 5, h = g * 5 + hl;
            const float dt = softplus_f(bf2f(PROJ[(size_t)(T0 + l) * NP + CDT + h]) + dt_bias[h]);
            dts[i] = dt; acsS[i] = dt * (-__expf(a_log[h])); DTB[(size_t)(T0 + l) * SH + h] = dt; }
        __syncthreads();
        if (wave < 5) {
            const int hl = wave; const float a0 = acsS[(2 * lane) * 5 + hl], a1 = acsS[(2 * lane + 1) * 5 + hl];
            float s = a0 + a1;
#pragma unroll
            for (int o = 1; o < 64; o <<= 1) { const float u = __shfl_up(s, o); if (lane >= o) s += u; }
            const float e0 = s - a1; const float last = __shfl(s, 63);
            acsS[(2 * lane) * 5 + hl] = e0; acsS[(2 * lane + 1) * 5 + hl] = s;
            ACS[(size_t)(T0 + 2 * lane) * SH + g * 5 + hl] = e0; ACS[(size_t)(T0 + 2 * lane + 1) * SH + g * 5 + hl] = s;
            wls[(2 * lane) * 5 + hl] = __expf(last - e0) * dts[(2 * lane) * 5 + hl]; wls[(2 * lane + 1) * 5 + hl] = __expf(last - s) * dts[(2 * lane + 1) * 5 + hl];
            if (lane == 63) CDEC[c * SH + g * 5 + hl] = __expf(s);
        }
        __syncthreads();
        for (int task = tid; task < 144 * 16; task += NTHR) {
            const int cq = task % 144, seg = task / 144, cj0 = 4 * cq;
            const int xcol = cj0 < 320 ? g * 320 + cj0 : (cj0 < 448 ? 1280 + g * 128 + (cj0 - 320) : 1792 + g * 128 + (cj0 - 448));
            const f32x4 w0 = *(const f32x4*)(conv_w + xcol), w1 = *(const f32x4*)(conv_w + CONVD + xcol), w2 = *(const f32x4*)(conv_w + 2 * CONVD + xcol), w3 = *(const f32x4*)(conv_w + 3 * CONVD + xcol), bb = *(const f32x4*)(conv_b + xcol);
            const int l0 = seg * 8, t0 = T0 + l0;
            f32x4 xr[11];
#pragma unroll
            for (int i = 0; i < 11; ++i) { const int t = t0 - 3 + i;
                if (t >= 0) { const unsigned long long u = *(const unsigned long long*)(PROJ + (size_t)t * NP + CX + xcol);
                    xr[i] = (f32x4){bf2f((unsigned short)u), bf2f((unsigned short)(u >> 16)), bf2f((unsigned short)(u >> 32)), bf2f((unsigned short)(u >> 48))}; }
                else xr[i] = (f32x4){0.f, 0.f, 0.f, 0.f}; }
#pragma unroll
            for (int i = 0; i < 8; ++i) { const int l = l0 + i;
                f32x4 y = xr[i] * w0 + xr[i + 1] * w1 + xr[i + 2] * w2 + xr[i + 3] * w3 + bb;
#pragma unroll
                for (int e = 0; e < 4; ++e) y[e] = silu_f(y[e]);
                *(unsigned long long*)(XC + (size_t)(T0 + l) * CONVD + xcol) = (unsigned long long)pk2(y[0], y[1]) | ((unsigned long long)pk2(y[2], y[3]) << 32);
                if (cj0 < 320) { const int hl = cj0 >> 6, p0 = cj0 & 63; const float wv = wls[l * 5 + hl];
                    const int ch = (p0 >> 3) ^ (((l >> 1) & 1) << 2);
                    *(LAS unsigned long long*)(xim + hl * 16384 + l * 128 + ch * 16 + 8 * ((p0 >> 2) & 1)) = (unsigned long long)pk2(y[0] * wv, y[1] * wv) | ((unsigned long long)pk2(y[2] * wv, y[3] * wv) << 32); }
                else if (cj0 < 448) { const int n0 = cj0 - 320; const int ch = (n0 >> 3) ^ ((l & 3) << 2);
                    *(LAS unsigned long long*)(Bim + l * 256 + ch * 16 + 8 * ((n0 >> 2) & 1)) = (unsigned long long)pk2(y[0], y[1]) | ((unsigned long long)pk2(y[2], y[3]) << 32); } }
            if (c == NCHUNK - 1 && seg == 15) {
#pragma unroll
                for (int j = 0; j < 3; ++j) *(f32x4*)(F.out + O_CVP + j * CONVD + xcol) = xr[8 + j]; }
        }
        __syncthreads();
        {
            const int nt = wave & 3, pt = wave >> 2, hi = lane >> 5, g2 = (lane >> 4) & 1, qq = (lane & 15) >> 2, pp = lane & 3;
#pragma unroll 1
            for (int hl = 0; hl < 5; ++hl) {
                f32x16 acc;
#pragma unroll
                for (int e = 0; e < 16; ++e) acc[e] = 0.f;
#pragma unroll
                for (int ks = 0; ks < 8; ++ks) {
                    const int rlo = 16 * ks + 4 * hi + qq, rhi = rlo + 8;
                    const int lcx = 4 * pt + 2 * g2 + (pp >> 1), lcb = 4 * nt + 2 * g2 + (pp >> 1);
                    const LAS unsigned char* xb = xim + hl * 16384;
                    const v4i16_t xlo = __builtin_amdgcn_ds_read_tr16_b64_v4i16((LAS v4i16_t*)(xb + rlo * 128 + ((lcx ^ (((rlo >> 1) & 1) << 2)) << 4) + 8 * (pp & 1)));
                    const v4i16_t xhi = __builtin_amdgcn_ds_read_tr16_b64_v4i16((LAS v4i16_t*)(xb + rhi * 128 + ((lcx ^ (((rhi >> 1) & 1) << 2)) << 4) + 8 * (pp & 1)));
                    const v4i16_t blo = __builtin_amdgcn_ds_read_tr16_b64_v4i16((LAS v4i16_t*)(Bim + rlo * 256 + ((lcb ^ ((rlo & 3) << 2)) << 4) + 8 * (pp & 1)));
                    const v4i16_t bhi = __builtin_amdgcn_ds_read_tr16_b64_v4i16((LAS v4i16_t*)(Bim + rhi * 256 + ((lcb ^ ((rhi & 3) << 2)) << 4) + 8 * (pp & 1)));
                    const bf16x8 af = (bf16x8){xlo[0], xlo[1], xlo[2], xlo[3], xhi[0], xhi[1], xhi[2], xhi[3]};
                    const bf16x8 bfr = (bf16x8){blo[0], blo[1], blo[2], blo[3], bhi[0], bhi[1], bhi[2], bhi[3]};
                    acc = __builtin_amdgcn_mfma_f32_32x32x16_bf16(af, bfr, acc, 0, 0, 0);
                }
                float* dst = ST + (((size_t)c * SH + g * 5 + hl) * HD + 32 * pt) * DSTATE + 32 * nt + (lane & 31);
#pragma unroll
                for (int e = 0; e < 16; ++e) dst[(size_t)((e & 3) + 8 * (e >> 2) + 4 * hi) * DSTATE] = acc[e];
            }
        }
        __syncthreads();
    }
}

__device__ __forceinline__ void ssd_sample(Frame& F) {
    const bf16* PROJ = WSP(bf16, WS_PROJ); bf16* MIX = WSP(bf16, WS_MIX);
    const float* state_conv = F.in[4]; const float* state_ssm = F.in[5];
    const float* conv_w = F.in[9]; const float* conv_b = F.in[10]; const float* dt_bias = F.in[11]; const float* a_log = F.in[12]; const float* d_skip = F.in[13]; const float* g_ssd = F.in[15];
    LAS float* xs = (LAS float*)F.lds;
    LAS float* Bs = xs + 1280;
    LAS float* Cs = Bs + 512;
    LAS float* dts = Cs + 512;
    LAS float* acs = dts + 20;
    LAS float* CBs = acs + 20;
    LAS float* ys = CBs + 16;
    LAS float* red = ys + 1280;
    const int tid = lnd(F.tid), lane = lnd(F.lane), wave = F.wave;
    for (int unit = blockIdx.x; unit < DB * NG; unit += F.G) {
        const int b = unit >> 2, g = unit & 3; const int r0 = SEQ + 4 * b;
        for (int cj = tid; cj < 576; cj += NTHR) {
            const int xcol = cj < 320 ? g * 320 + cj : (cj < 448 ? 1280 + g * 128 + (cj - 320) : 1792 + g * 128 + (cj - 448));
            const float w0 = conv_w[xcol], w1 = conv_w[CONVD + xcol], w2 = conv_w[2 * CONVD + xcol], w3 = conv_w[3 * CONVD + xcol], bb = conv_b[xcol];
            float xp[7];
#pragma unroll
            for (int j = 0; j < 3; ++j) xp[j] = state_conv[((size_t)b * 3 + j) * CONVD + xcol];
#pragma unroll
            for (int t = 0; t < 4; ++t) xp[3 + t] = bf2f(PROJ[(size_t)(r0 + t) * NP + CX + xcol]);
#pragma unroll
            for (int t = 0; t < 4; ++t) { const float y = silu_f(xp[t] * w0 + xp[t + 1] * w1 + xp[t + 2] * w2 + xp[t + 3] * w3 + bb);
                if (cj < 320) xs[t * 320 + cj] = y; else if (cj < 448) Bs[t * 128 + (cj - 320)] = y; else Cs[t * 128 + (cj - 448)] = y; }
#pragma unroll
            for (int j = 0; j < 3; ++j) F.out[O_CVS + ((size_t)b * 3 + j) * CONVD + xcol] = xp[4 + j];
        }
        if (tid < 20) { const int t = tid / 5, hl = tid % 5, h = g * 5 + hl; dts[tid] = softplus_f(bf2f(PROJ[(size_t)(r0 + t) * NP + CDT + h]) + dt_bias[h]); }
        __syncthreads();
        if (tid < 5) { const float a = -__expf(a_log[g * 5 + tid]); float s = 0.f;
#pragma unroll
            for (int t = 0; t < 4; ++t) { s += dts[t * 5 + tid] * a; acs[t * 5 + tid] = s; } }
        { const int pair = tid >> 5, n4 = tid & 31, t = pair >> 2, s = pair & 3; float v = 0.f;
#pragma unroll
            for (int e = 0; e < 4; ++e) v += Cs[t * 128 + 4 * n4 + e] * Bs[s * 128 + 4 * n4 + e];
            v += __shfl_xor(v, 1); v += __shfl_xor(v, 2); v += __shfl_xor(v, 4); v += __shfl_xor(v, 8); v += __shfl_xor(v, 16);
            if (n4 == 0) CBs[pair] = v; }
        __syncthreads();
        const int n4 = tid & 31, pr = tid >> 5;
        float Bv[4][4], Cv[4][4];
#pragma unroll
        for (int t = 0; t < 4; ++t)
#pragma unroll
            for (int e = 0; e < 4; ++e) { Bv[t][e] = Bs[t * 128 + 4 * n4 + e]; Cv[t][e] = Cs[t * 128 + 4 * n4 + e]; }
        for (int hl = 0; hl < 5; ++hl) {
            const int h = g * 5 + hl;
            float ac[4], dtv[4];
#pragma unroll
            for (int t = 0; t < 4; ++t) { ac[t] = acs[t * 5 + hl]; dtv[t] = dts[t * 5 + hl]; }
            const float dsk = d_skip[h];
#pragma unroll
            for (int j = 0; j < 4; ++j) {
                const int p = pr + 16 * j;
                const size_t soff = (((size_t)b * SH + h) * HD + p) * DSTATE + 4 * n4;
                const f32x4 S = *(const f32x4*)(state_ssm + soff);
                float xv[4];
#pragma unroll
                for (int t = 0; t < 4; ++t) xv[t] = xs[t * 320 + hl * 64 + p];
                f32x4 Hn = S * __expf(ac[3]);
#pragma unroll
                for (int t = 0; t < 4; ++t) { const float wgt = __expf(ac[3] - ac[t]) * dtv[t] * xv[t];
#pragma unroll
                    for (int e = 0; e < 4; ++e) Hn[e] += wgt * Bv[t][e]; }
                *(f32x4*)(F.out + O_SSS + soff) = Hn;
#pragma unroll
                for (int t = 0; t < 4; ++t) {
                    float yo = (Cv[t][0] * S[0] + Cv[t][1] * S[1]) + (Cv[t][2] * S[2] + Cv[t][3] * S[3]);
                    yo += __shfl_xor(yo, 1); yo += __shfl_xor(yo, 2); yo += __shfl_xor(yo, 4); yo += __shfl_xor(yo, 8); yo += __shfl_xor(yo, 16);
                    float y = yo * __expf(ac[t]) + dsk * xv[t];
#pragma unroll
                    for (int s = 0; s < 4; ++s) if (s <= t) y += CBs[t * 4 + s] * __expf(ac[t] - ac[s]) * dtv[s] * xv[s];
                    if (n4 == t) ys[t * 320 + hl * 64 + p] = y;
                }
            }
        }
        __syncthreads();
        float yv[4]; float part[4];
#pragma unroll
        for (int t = 0; t < 4; ++t) { yv[t] = 0.f;
            if (tid < 320) { const float z = bf2f(PROJ[(size_t)(r0 + t) * NP + CZ + g * 320 + tid]); yv[t] = ys[t * 320 + tid] * silu_f(z); }
            part[t] = wave_sum(yv[t] * yv[t]); }
        if (lane == 0) {
#pragma unroll
            for (int t = 0; t < 4; ++t) red[t * 8 + wave] = part[t]; }
        __syncthreads();
        if (tid < 320) {
#pragma unroll
            for (int t = 0; t < 4; ++t) { float ss = 0.f;
#pragma unroll
                for (int w = 0; w < 8; ++w) ss += red[t * 8 + w];
                const float rs = 1.0f / sqrtf(ss * (1.0f / 320.f) + EPS);
                MIX[(size_t)(r0 + t) * MIXW + ATTW + g * 320 + tid] = (bf16)f2bf(yv[t] * rs * g_ssd[g * 320 + tid]); } }
        __syncthreads();
    }
}

__device__ __forceinline__ void scan_and_attnorm(Frame& F) {
    const float* ST = WSP(float, WS_ST); const float* CDEC = WSP(float, WS_CDEC); bf16* HIN = WSP(bf16, WS_HIN);
    const int gt = blockIdx.x * NTHR + F.tid, NGT = F.G * NTHR;
    for (int e4 = gt; e4 < SH * HD * DSTATE / 4; e4 += NGT) {
        const int h = e4 / (HD * DSTATE / 4);
        f32x4 hcur = (f32x4){0.f, 0.f, 0.f, 0.f};
        for (int c0 = 0; c0 < NCHUNK; c0 += 8) {
            f32x4 st[8]; float dc[8];
#pragma unroll
            for (int j = 0; j < 8; ++j) { st[j] = *(const f32x4*)(ST + (size_t)(c0 + j) * (SH * HD * DSTATE) + (size_t)e4 * 4); dc[j] = CDEC[(c0 + j) * SH + h]; }
#pragma unroll
            for (int j = 0; j < 8; ++j) { *(unsigned long long*)(HIN + (size_t)(c0 + j) * (SH * HD * DSTATE) + (size_t)e4 * 4) = (unsigned long long)pk2(hcur[0], hcur[1]) | ((unsigned long long)pk2(hcur[2], hcur[3]) << 32);
                hcur = hcur * dc[j] + st[j]; }
        }
        *(f32x4*)(F.out + O_SSP + (size_t)e4 * 4) = hcur;
    }
    bf16* MIX = WSP(bf16, WS_MIX); const float* ATTSS = WSP(float, WS_ATTSS); const float* g_attn = F.in[14];
    const bf16* OPART = WSP(bf16, WS_OPART); const float* ML = WSP(float, WS_ML);
    const int gw = blockIdx.x * NWAVES + F.wave, NGW = F.G * NWAVES, lane = lnd(F.lane);
    for (int row = gw; row < SEQ; row += NGW) {
        float o[3][4]; float sq = 0.f;
#pragma unroll
        for (int j = 0; j < 3; ++j) { const int col = 4 * lane + 256 * j, h = col >> 6;
            float mb[3], lb[3];
#pragma unroll
            for (int b = 0; b < 3; ++b) { const float* mp = ML + (((size_t)b * SEQ + row) * AH + h) * 2; mb[b] = mp[0]; lb[b] = mp[1]; }
            const float M = fmaxf(fmaxf(mb[0], mb[1]), mb[2]);
            float w[3], W = 0.f;
#pragma unroll
            for (int b = 0; b < 3; ++b) { w[b] = __builtin_amdgcn_exp2f(mb[b] - M) * lb[b]; W += w[b]; }
            const float iw = 1.0f / W;
#pragma unroll
            for (int e = 0; e < 4; ++e) o[j][e] = 0.f;
#pragma unroll
            for (int b = 0; b < 3; ++b) { const unsigned long long x = *(const unsigned long long*)(OPART + ((size_t)b * SEQ + row) * ATTW + col); const float wb = w[b] * iw;
                o[j][0] += wb * bf2f((unsigned short)x); o[j][1] += wb * bf2f((unsigned short)(x >> 16)); o[j][2] += wb * bf2f((unsigned short)(x >> 32)); o[j][3] += wb * bf2f((unsigned short)(x >> 48)); }
#pragma unroll
            for (int e = 0; e < 4; ++e) sq += o[j][e] * o[j][e]; }
        sq = wave_sum(sq);
        const float rs = 1.0f / sqrtf(sq * (1.0f / ATTW) + EPS);
#pragma unroll
        for (int j = 0; j < 3; ++j) { const int col = 4 * lane + 256 * j; const f32x4 gg = *(const f32x4*)(g_attn + col);
            *(unsigned long long*)(MIX + (size_t)row * MIXW + col) = (unsigned long long)pk2(o[j][0] * rs * gg[0], o[j][1] * rs * gg[1]) | ((unsigned long long)pk2(o[j][2] * rs * gg[2], o[j][3] * rs * gg[3]) << 32); }
    }
    for (int row = SEQ + gw; row < MTOT; row += NGW) {
        float s = lane < AH ? ATTSS[row * AH + lane] : 0.f; s = wave_sum(s);
        const float rs = 1.0f / sqrtf(s * (1.0f / ATTW) + EPS);
#pragma unroll
        for (int j = 0; j < 3; ++j) { const int col = 4 * lane + 256 * j; unsigned long long* p = (unsigned long long*)(MIX + (size_t)row * MIXW + col);
            const unsigned long long w = *p; const f32x4 gg = *(const f32x4*)(g_attn + col);
            const float v0 = bf2f((unsigned short)w) * rs * gg[0], v1 = bf2f((unsigned short)(w >> 16)) * rs * gg[1], v2 = bf2f((unsigned short)(w >> 32)) * rs * gg[2], v3 = bf2f((unsigned short)(w >> 48)) * rs * gg[3];
            *p = (unsigned long long)pk2(v0, v1) | ((unsigned long long)pk2(v2, v3) << 32); }
    }
}

__device__ __forceinline__ void ssd_phase_b(Frame& F) {
    const bf16* PROJ = WSP(bf16, WS_PROJ); const bf16* XC = WSP(bf16, WS_XC); const float* DTB = WSP(float, WS_DTB); const float* ACS = WSP(float, WS_ACS); const float* ST = WSP(float, WS_ST);
    bf16* MIX = WSP(bf16, WS_MIX); const float* d_skip = F.in[13]; const float* g_ssd = F.in[15];
    LAS float* Wm = (LAS float*)F.lds;
    LAS float* Hs = (LAS float*)(F.lds + 66048);
    LAS bf16* xh = (LAS bf16*)(F.lds + 66048 + 32768);
    LAS float* acsS = (LAS float*)(F.lds + 66048 + 32768 + 16384);
    LAS float* dtS = acsS + 128;
    LAS float* ssq = dtS + 128;
    const int tid = lnd(F.tid), lane = lnd(F.lane);
    const int l = tid & 127, pq = __builtin_amdgcn_readfirstlane(tid >> 7);
    for (int unit = blockIdx.x; unit < NCHUNK * NG; unit += F.G) {
        const int c = unit >> 2, g = unit & 3, T0 = c * CL;
        float yv[5][16];
        if (tid < 128) ssq[tid] = 0.f;
#pragma unroll
        for (int hl = 0; hl < 5; ++hl) {
            const int h = g * 5 + hl;
            __syncthreads();
            if (tid < 128) { acsS[tid] = ACS[(size_t)(T0 + tid) * SH + h]; dtS[tid] = DTB[(size_t)(T0 + tid) * SH + h]; }
            for (int i = tid; i < 64 * 128 / 4; i += NTHR) ((LAS f32x4*)Hs)[i] = *(const f32x4*)(ST + ((size_t)c * SH + h) * (HD * DSTATE) + (size_t)i * 4);
            for (int i = tid; i < 128 * 64 / 8; i += NTHR) { const int r = i >> 3, ch = i & 7; ((LAS v4u*)xh)[i] = *(const v4u*)(XC + (size_t)(T0 + r) * CONVD + h * 64 + ch * 8); }
            __syncthreads();
            for (int pair = tid; pair < 128 * 128; pair += NTHR) {
                const int ll = pair >> 7, s = pair & 127; float w = 0.f;
                if (s <= ll) { const bf16* cp = XC + (size_t)(T0 + ll) * CONVD + 1792 + g * 128; const bf16* bp = XC + (size_t)(T0 + s) * CONVD + 1280 + g * 128; float d = 0.f;
#pragma unroll 4
                    for (int k8 = 0; k8 < 16; ++k8) { const v4u cw = *(const v4u*)(cp + 8 * k8), bw = *(const v4u*)(bp + 8 * k8);
#pragma unroll
                        for (int e = 0; e < 4; ++e) { d += __uint_as_float(cw[e] << 16) * __uint_as_float(bw[e] << 16) + __uint_as_float(cw[e] & 0xffff0000u) * __uint_as_float(bw[e] & 0xffff0000u); } }
                    w = d * __expf(acsS[ll] - acsS[s]) * dtS[s]; }
                Wm[ll * 129 + s] = w; }
            __syncthreads();
            float acc[16];
#pragma unroll
            for (int j = 0; j < 16; ++j) acc[j] = 0.f;
            for (int s = 0; s < CL; ++s) { const float w = Wm[l * 129 + s]; const LAS bf16* xr = xh + s * 64 + pq * 16;
#pragma unroll
                for (int j = 0; j < 16; ++j) acc[j] += w * bf2f(xr[j]); }
            { const bf16* cp = XC + (size_t)(T0 + l) * CONVD + 1792 + g * 128; const float ea = __expf(acsS[l]);
                float off[16];
#pragma unroll
                for (int j = 0; j < 16; ++j) off[j] = 0.f;
                for (int k8 = 0; k8 < 16; ++k8) { const v4u cw = *(const v4u*)(cp + 8 * k8); float cf[8];
#pragma unroll
                    for (int e = 0; e < 4; ++e) { cf[2 * e] = __uint_as_float(cw[e] << 16); cf[2 * e + 1] = __uint_as_float(cw[e] & 0xffff0000u); }
#pragma unroll
                    for (int j = 0; j < 16; ++j) { const LAS float* hr = Hs + (pq * 16 + j) * 128 + 8 * k8;
#pragma unroll
                        for (int e = 0; e < 8; ++e) off[j] += cf[e] * hr[e]; } }
#pragma unroll
                for (int j = 0; j < 16; ++j) acc[j] += ea * off[j]; }
            { const float dsk = d_skip[h]; const LAS bf16* xr = xh + l * 64 + pq * 16; const bf16* zp = PROJ + (size_t)(T0 + l) * NP + CZ + h * 64 + pq * 16; float sq = 0.f;
#pragma unroll
                for (int j = 0; j < 16; ++j) { const float y = (acc[j] + dsk * bf2f(xr[j])) * silu_f(bf2f(zp[j])); yv[hl][j] = y; sq += y * y; }
                __hip_atomic_fetch_add(&ssq[l], sq, __ATOMIC_RELAXED, __HIP_MEMORY_SCOPE_WORKGROUP); }
        }
        __syncthreads();
        const float rs = 1.0f / sqrtf(ssq[l] * (1.0f / 320.f) + EPS);
#pragma unroll
        for (int hl = 0; hl < 5; ++hl) { const int col = (g * 5 + hl) * 64 + pq * 16; bf16* mp = MIX + (size_t)(T0 + l) * MIXW + ATTW + col;
            v4u w0, w1;
            w0.x = pk2(yv[hl][0] * rs * g_ssd[col + 0], yv[hl][1] * rs * g_ssd[col + 1]); w0.y = pk2(yv[hl][2] * rs * g_ssd[col + 2], yv[hl][3] * rs * g_ssd[col + 3]);
            w0.z = pk2(yv[hl][4] * rs * g_ssd[col + 4], yv[hl][5] * rs * g_ssd[col + 5]); w0.w = pk2(yv[hl][6] * rs * g_ssd[col + 6], yv[hl][7] * rs * g_ssd[col + 7]);
            w1.x = pk2(yv[hl][8] * rs * g_ssd[col + 8], yv[hl][9] * rs * g_ssd[col + 9]); w1.y = pk2(yv[hl][10] * rs * g_ssd[col + 10], yv[hl][11] * rs * g_ssd[col + 11]);
            w1.z = pk2(yv[hl][12] * rs * g_ssd[col + 12], yv[hl][13] * rs * g_ssd[col + 13]); w1.w = pk2(yv[hl][14] * rs * g_ssd[col + 14], yv[hl][15] * rs * g_ssd[col + 15]);
            *(v4u*)mp = w0; *(v4u*)(mp + 8) = w1; }
        __syncthreads();
    }
}


__device__ __forceinline__ void ssd_phase_b_mfma(Frame& F) {
    const bf16* PROJ = WSP(bf16, WS_PROJ); const bf16* XC = WSP(bf16, WS_XC); const float* DTB = WSP(float, WS_DTB); const float* ACS = WSP(float, WS_ACS); const bf16* HIN = WSP(bf16, WS_HIN);
    bf16* MIX = WSP(bf16, WS_MIX); const float* d_skip = F.in[13]; const float* g_ssd = F.in[15];
    constexpr int YP = 656;
    LAS unsigned char* Cim = F.lds;
    LAS unsigned char* Bim = F.lds + 32768;
    LAS unsigned char* yst = F.lds + 32768;
    LAS unsigned char* xim = F.lds + 116736;
    LAS unsigned char* Him = F.lds + 133120;
    LAS float* acsS = (LAS float*)(F.lds + 149504);
    LAS float* dtS = acsS + 128;
    LAS float* ssqp = dtS + 128;
    const int tid = lnd(F.tid), lane = lnd(F.lane), wave = F.wave;
    const int lt = wave >> 1, pt = wave & 1;
    constexpr float LOG2E = 1.4426950408889634f;
    for (int unit = blockIdx.x; unit < NCHUNK * NG; unit += F.G) {
        const int c = unit >> 2, g = unit & 3, T0 = c * CL;
        int lane_u = lane; asm volatile("" : "+v"(lane_u));
        const int lq = lane_u & 31, hi = lane_u >> 5;
        for (int n = wave; n < 32; n += 8) { const int row = 4 * n + (lane >> 4), pc = lane & 15, lc = pc ^ (row & 15);
            __builtin_amdgcn_global_load_lds((const unsigned*)(XC + (size_t)(T0 + row) * CONVD + 1792 + g * 128 + lc * 8), (LAS unsigned*)(Cim + n * 1024), 16, 0, 0);
            __builtin_amdgcn_global_load_lds((const unsigned*)(XC + (size_t)(T0 + row) * CONVD + 1280 + g * 128 + lc * 8), (LAS unsigned*)(Bim + n * 1024), 16, 0, 0); }
        asm volatile("s_waitcnt vmcnt(0)" ::: "memory");
        __syncthreads();
        const LAS unsigned char* crow_ = Cim + (32 * lt + lq) * 256; const int cx = (32 * lt + lq) & 15;
#define CF(ks) (*(const LAS bf16x8*)(crow_ + (((2 * (ks) + hi) ^ cx) << 4)))
        unsigned GTp[4][8];
#pragma unroll
        for (int st = 0; st < 4; ++st) {
            f32x16 gt;
#pragma unroll
            for (int e = 0; e < 16; ++e) gt[e] = 0.f;
            { const int row = 32 * st + lq;
#pragma unroll
                for (int ks = 0; ks < 8; ++ks) { const bf16x8 bfr = *(const LAS bf16x8*)(Bim + row * 256 + (((2 * ks + hi) ^ (row & 15)) << 4));
                    gt = __builtin_amdgcn_mfma_f32_32x32x16_bf16(bfr, CF(ks), gt, 0, 0, 0); } }
#pragma unroll
            for (int e = 0; e < 8; ++e) GTp[st][e] = pk2(gt[2 * e], gt[2 * e + 1]);
            __builtin_amdgcn_sched_barrier(0);
        }
        float sq = 0.f;
#pragma unroll 1
        for (int hl = 0; hl < 5; ++hl) {
            const int h = g * 5 + hl;
            int lane_h = lane; asm volatile("" : "+v"(lane_h));
            const int lq = lane_h & 31, hi = lane_h >> 5, g2 = (lane_h >> 4) & 1, qq = (lane_h & 15) >> 2, pp = lane_h & 3;
            __syncthreads();
            for (int n = wave; n < 16; n += 8) { const int row = 8 * n + (lane >> 3), pc = lane & 7, lc = pc ^ (((row >> 1) & 1) << 2);
                __builtin_amdgcn_global_load_lds((const unsigned*)(XC + (size_t)(T0 + row) * CONVD + h * 64 + lc * 8), (LAS unsigned*)(xim + n * 1024), 16, 0, 0); }
            for (int n = wave; n < 16; n += 8) { const int row = 4 * n + (lane >> 4), pc = lane & 15, lc = pc ^ (row & 15);
                __builtin_amdgcn_global_load_lds((const unsigned*)(HIN + (((size_t)c * SH + h) * HD + row) * DSTATE + lc * 8), (LAS unsigned*)(Him + n * 1024), 16, 0, 0); }
            if (tid < 128) { acsS[tid] = ACS[(size_t)(T0 + tid) * SH + h] * LOG2E; dtS[tid] = DTB[(size_t)(T0 + tid) * SH + h]; }
            const int lrow = T0 + 32 * lt + lq;
            const float al = ACS[(size_t)lrow * SH + h] * LOG2E;
            asm volatile("s_waitcnt vmcnt(0)" ::: "memory");
            __syncthreads();
            const LAS unsigned char* crow_h = Cim + (32 * lt + lq) * 256; const int cxh = lq & 15;
#define CFH(ks) (*(const LAS bf16x8*)(crow_h + (((2 * (ks) + hi) ^ cxh) << 4)))
            const LAS unsigned char* xtr = xim + (4 * hi + qq) * 128 + (((4 * pt + 2 * g2 + (pp >> 1)) ^ (((qq >> 1) & 1) << 2)) << 4) + 8 * (pp & 1);
            f32x16 yo, yd;
#pragma unroll
            for (int e = 0; e < 16; ++e) { yo[e] = 0.f; yd[e] = 0.f; }
            { const int row = 32 * pt + lq;
#pragma unroll
                for (int ks = 0; ks < 8; ++ks) { const bf16x8 hf = *(const LAS bf16x8*)(Him + row * 256 + (((2 * ks + hi) ^ (row & 15)) << 4));
                    yo = __builtin_amdgcn_mfma_f32_32x32x16_bf16(hf, CFH(ks), yo, 0, 0, 0); } }
#pragma unroll
            for (int st = 0; st < 4; ++st) {
#pragma unroll
                for (int s2 = 0; s2 < 2; ++s2) {
                    float w[8];
#pragma unroll
                    for (int j = 0; j < 8; ++j) { const int e = 8 * s2 + j, s = 32 * st + (e & 3) + 8 * (e >> 2) + 4 * hi;
                        const float gv = (e & 1) ? __uint_as_float(GTp[st][e >> 1] & 0xffff0000u) : __uint_as_float(GTp[st][e >> 1] << 16);
                        const float v = gv * __builtin_amdgcn_exp2f(al - acsS[s]) * dtS[s];
                        w[j] = (s <= 32 * lt + lq) ? v : 0.f; }
                    v4u wp; wp.x = pk2(w[0], w[1]); wp.y = pk2(w[2], w[3]); wp.z = pk2(w[4], w[5]); wp.w = pk2(w[6], w[7]);
                    const v4i16_t xlo = __builtin_amdgcn_ds_read_tr16_b64_v4i16((LAS v4i16_t*)(xtr + (32 * st + 16 * s2) * 128));
                    const v4i16_t xhi = __builtin_amdgcn_ds_read_tr16_b64_v4i16((LAS v4i16_t*)(xtr + (32 * st + 16 * s2 + 8) * 128));
                    const bf16x8 xf = (bf16x8){xlo[0], xlo[1], xlo[2], xlo[3], xhi[0], xhi[1], xhi[2], xhi[3]};
                    yd = __builtin_amdgcn_mfma_f32_32x32x16_bf16(xf, __builtin_bit_cast(bf16x8, wp), yd, 0, 0, 0);
                    __builtin_amdgcn_sched_barrier(0);
                }
            }
            const float ea = __builtin_amdgcn_exp2f(al), dsk = d_skip[h];
#pragma unroll
            for (int gq = 0; gq < 4; ++gq) { const int p = 32 * pt + 8 * gq + 4 * hi;
                const unsigned long long xu = *(const unsigned long long*)(XC + (size_t)lrow * CONVD + h * 64 + p), zu = *(const unsigned long long*)(PROJ + (size_t)lrow * NP + CZ + h * 64 + p);
                float y[4];
#pragma unroll
                for (int e = 0; e < 4; ++e) { const float xv = bf2f((unsigned short)(xu >> (16 * e))), zv = bf2f((unsigned short)(zu >> (16 * e)));
                    y[e] = (yd[4 * gq + e] + ea * yo[4 * gq + e] + dsk * xv) * silu_f(zv); sq += y[e] * y[e]; }
                *(LAS unsigned long long*)(yst + (32 * lt + lq) * YP + (hl * 64 + p) * 2) = (unsigned long long)pk2(y[0], y[1]) | ((unsigned long long)pk2(y[2], y[3]) << 32); }
        }
        sq += __shfl_xor(sq, 32);
        if (lane < 32) ssqp[pt * 128 + 32 * lt + lane] = sq;
        __syncthreads();
        for (int task = tid; task < 128 * 40; task += NTHR) { const int row = task / 40, ch = task % 40, col = g * 320 + 8 * ch;
            const float rs = 1.0f / sqrtf((ssqp[row] + ssqp[128 + row]) * (1.0f / 320.f) + EPS);
            const v4u yv = *(const LAS v4u*)(yst + row * YP + ch * 16); const f32x4 g0 = *(const f32x4*)(g_ssd + col), g1 = *(const f32x4*)(g_ssd + col + 4);
            v4u o;
            o.x = pk2(__uint_as_float(yv.x << 16) * rs * g0[0], __uint_as_float(yv.x & 0xffff0000u) * rs * g0[1]); o.y = pk2(__uint_as_float(yv.y << 16) * rs * g0[2], __uint_as_float(yv.y & 0xffff0000u) * rs * g0[3]);
            o.z = pk2(__uint_as_float(yv.z << 16) * rs * g1[0], __uint_as_float(yv.z & 0xffff0000u) * rs * g1[1]); o.w = pk2(__uint_as_float(yv.w << 16) * rs * g1[2], __uint_as_float(yv.w & 0xffff0000u) * rs * g1[3]);
            *(v4u*)(MIX + (size_t)(T0 + row) * MIXW + ATTW + col) = o; }
        __syncthreads();
    }
#undef CF
#undef CFH
}

__device__ __forceinline__ void final_norm(Frame& F) {
    const float* SS3 = (const float*)(F.ws + CTL_SS3); const float* gf = F.in[21];
    const int gw = blockIdx.x * NWAVES + F.wave, NGW = F.G * NWAVES, lane = lnd(F.lane);
    for (int row = gw; row < MTOT; row += NGW) {
        const float rs = 1.0f / sqrtf(SS3[row] * (1.0f / DM) + EPS);
        f32x4* yr = (f32x4*)(F.out + (size_t)row * DM) + lane;
#pragma unroll
        for (int j = 0; j < 4; ++j) { const f32x4 gg = *((const f32x4*)gf + lane + 64 * j); yr[64 * j] = yr[64 * j] * rs * gg; }
    }
}

#ifndef MK_N_LAUNCHES
#define MK_N_LAUNCHES 1
#endif
constexpr int N_PHASES = 9;
struct Args { const float* in[22]; float* out; unsigned char* ws; int ph_lo, ph_hi; };
__global__ void __launch_bounds__(NTHR, 2) fwd(Args args) {
    extern __shared__ __attribute__((aligned(16))) unsigned char lds[];
    Frame F;
    F.lds = (LAS unsigned char*)lds;
    F.tid = threadIdx.x; F.lane = F.tid & 63; F.wave = __builtin_amdgcn_readfirstlane(F.tid >> 6); F.G = gridDim.x;
#pragma unroll
    for (int i = 0; i < 22; ++i) F.in[i] = args.in[i];
    F.out = args.out; F.ws = args.ws;
    volatile LAS unsigned* MISC = (volatile LAS unsigned*)(F.lds + MISC_OFF);
    if (F.tid < 64) MISC[F.tid] = 0u;
    __syncthreads();
    unsigned* barw = (unsigned*)(F.ws + WS_CTL) + CW_BAR;
    XcdBarrier bar; bar.bar = barw; bar.x = 0; bar.st = nullptr;
    if (MK_N_LAUNCHES == 1) bar = xcd_barrier_post(barw, MISC + 8);
    const int lo = args.ph_lo, hi = args.ph_hi;
#define IN(k) (lo <= (k) && (k) < hi)
#define SEAM(k) do { if (IN(k) && IN((k) + 1)) xcd_barrier(bar); } while (0)

    if (IN(0)) { p0_prologue(F); __syncthreads(); }
    SEAM(0);
    if (IN(1)) {
        pg8::Gemm g{WSP(const pg8::bf16_t, WS_XB), WSP(const pg8::bf16_t, WS_WIN), MTOT, NP, DM}; pg8::StaticOrder S; S.init(MTOT, NP, F.G, (int)blockIdx.x);
        EpiProj E{WSP(bf16, WS_PROJ), WSP(const float, WS_RS1), F.out};
        pg8::gemm_phase<EpiProj, pg8::StaticOrder, true, true>(F.lds, g, S, E);
    }
    SEAM(1);
    if (IN(2)) { attn_sample(F); __syncthreads(); ssd_sample(F); __syncthreads(); ssd_phase_a_mfma(F); __syncthreads(); attn_prompt_mfma(F); }
    SEAM(2);
    if (IN(3)) { scan_and_attnorm(F); }
    SEAM(3);
    if (IN(4)) { ssd_phase_b_mfma(F); }
    SEAM(4);
    if (IN(5)) {
        pg8::Gemm g{WSP(const pg8::bf16_t, WS_MIX), WSP(const pg8::bf16_t, WS_WOUT), MTOT, DM, MIXW}; pg8::StaticOrder S; S.init(MTOT, DM, F.G, (int)blockIdx.x);
        EpiOut E{F.in[0], F.in[1], WSP(float, WS_X1), WSP(bf16, WS_X1B), (float*)(F.ws + CTL_SS2)};
        pg8::gemm_phase<EpiOut, pg8::StaticOrder, true, true>(F.lds, g, S, E);
    }
    SEAM(5);
    if (IN(6)) {
        pg8::Gemm g{WSP(const pg8::bf16_t, WS_X1B), WSP(const pg8::bf16_t, WS_WGU), MTOT, 2 * DFF, DM}; pg8::StaticOrder S; S.init(MTOT, 2 * DFF, F.G, (int)blockIdx.x);
        EpiGU E{WSP(bf16, WS_ACT), (const float*)(F.ws + CTL_SS2)};
        pg8::gemm_phase<EpiGU, pg8::StaticOrder, true, true>(F.lds, g, S, E);
    }
    SEAM(6);
    if (IN(7)) {
        pg8::Gemm g{WSP(const pg8::bf16_t, WS_ACT), WSP(const pg8::bf16_t, WS_WDN), MTOT, DM, DFF}; pg8::StaticOrder S; S.init(MTOT, DM, F.G, (int)blockIdx.x);
        EpiDown E{WSP(const float, WS_X1), F.out, (float*)(F.ws + CTL_SS3)};
        pg8::gemm_phase<EpiDown, pg8::StaticOrder, true, true>(F.lds, g, S, E);
    }
    SEAM(7);
    if (IN(8)) { final_norm(F); }
#undef IN
#undef SEAM
}

extern "C" void kernel_launch(void* const* d_in, const int* in_sizes, int n_in, void* d_out, int out_size, void* d_ws, size_t ws_size, hipStream_t stream) {
    static int grid = 0;
    if (grid == 0) {
        if (n_in != 22 || (size_t)out_size != O_END || ws_size < WS_END) fprintf(stderr, "kernel_launch: unexpected shapes (n_in %d, out %d, ws %zu)\n", n_in, out_size, ws_size);
        int dev = 0, cus = 0, per_cu = 0;
        if (hipGetDevice(&dev) != hipSuccess || hipDeviceGetAttribute(&cus, hipDeviceAttributeMultiprocessorCount, dev) != hipSuccess) { grid = -1; return; }
        if (hipFuncSetAttribute((const void*)fwd, hipFuncAttributeMaxDynamicSharedMemorySize, LDS_BYTES) != hipSuccess) { fprintf(stderr, "kernel_launch: hipFuncSetAttribute failed\n"); grid = -1; return; }
        if (hipOccupancyMaxActiveBlocksPerMultiprocessor(&per_cu, (const void*)fwd, NTHR, LDS_BYTES) != hipSuccess || per_cu < 1) fprintf(stderr, "kernel_launch: occupancy query says %d\n", per_cu);
        (void)hipGetLastError();
        grid = cus;
    }
    if (grid < 0) return;
    if (hipMemsetAsync((char*)d_ws + WS_CTL, 0, CTL_ZERO_BYTES, stream) != hipSuccess) return;
    Args a{};
    for (int i = 0; i < 22; ++i) a.in[i] = (const float*)d_in[i];
    a.out = (float*)d_out; a.ws = (unsigned char*)d_ws;
    if (MK_N_LAUNCHES == 1) { a.ph_lo = 0; a.ph_hi = N_PHASES; hipLaunchKernelGGL(fwd, dim3(grid), dim3(NTHR), LDS_BYTES, stream, a); }
    else { for (int p = 0; p < N_PHASES; ++p) { a.ph_lo = p; a.ph_hi = p + 1; hipLaunchKernelGGL(fwd, dim3(grid), dim3(NTHR), LDS_BYTES, stream, a); } }
}
```

```cpp
#include <hip/hip_runtime.h>
#include <cstdio>
#include <cstdint>
namespace pg8 {
#define PG8_LAS __attribute__((address_space(3)))
typedef unsigned short bf16_t;
typedef short bf16x8 __attribute__((ext_vector_type(8)));
typedef float f32x4 __attribute__((ext_vector_type(4)));
typedef unsigned u32x4 __attribute__((ext_vector_type(4)));
constexpr int BM = 256, BK = 64, HALF = 128, HTB = HALF * BK * 2  , STAGE_BYTES = 8 * HTB, NXCD = 8, WGM = 8;

__host__ __device__ __forceinline__ int lds_byte(int r, int c) { const int st = (r >> 4) * 2 + (c >> 5), rr = r & 15, cc = c & 31, ob = rr * 64 + cc * 2; return st * 1024 + (ob ^ (((ob >> 9) & 1) << 5)); }
__host__ __device__ __forceinline__ void stage_rc(int b, int& R, int& C) { const int st = b / 1024, sb = b % 1024, swz = sb ^ (((sb >> 9) & 1) << 5); R = (st >> 1) * 16 + swz / 64; C = (st & 1) * 32 + (swz % 64) / 2; }
__host__ __device__ __forceinline__ int perm32(int rho) { const int n = rho >> 4, i = rho & 15; return 8 * (i >> 2) + 4 * n + (i & 3); }

struct Unit { int pm, pn; };
struct Gemm { const bf16_t* A; const bf16_t* Bt; int M, N, K; };

struct StaticOrder {
    int nM, nN, nwg, G, c;
    __host__ __device__ void init(int M, int N, int G_, int c_) { nM = M / BM; nN = N / BM; nwg = nM * nN; G = G_; c = c_; }
    __host__ __device__ bool next(int i, Unit& u) const {
        const long L = (long)i * G + c; if (L >= nwg) return false;
        int wgid = (int)L; { const int q = nwg / NXCD, r = nwg % NXCD, xcd = wgid % NXCD, off = wgid / NXCD; wgid = (xcd < r ? xcd * (q + 1) : r * (q + 1) + (xcd - r) * q) + off; }
        const int nig = WGM * nN, gid = wgid / nig, fm = gid * WGM, gsz = (nM - fm) < WGM ? (nM - fm) : WGM;
        u.pm = fm + ((wgid % nig) % gsz); u.pn = (wgid % nig) / gsz; return true;
    }
    __device__ __forceinline__ void a_ready(const Unit&) const {}
    __device__ __forceinline__ void done(const Unit&) const {}
};

__device__ __forceinline__ unsigned cvt_pk_bf16(float lo, float hi) { unsigned r; asm volatile("v_cvt_pk_bf16_f32 %0, %1, %2" : "=v"(r) : "v"(lo), "v"(hi)); return r; }
typedef float f32x2 __attribute__((ext_vector_type(2)));

template <class Epi, class Sched, bool ALIGN_EPI = false, bool SP2 = false>
__device__ __forceinline__ void gemm_phase(PG8_LAS unsigned char* lds, const Gemm g, const Sched& S, const Epi& E) {
    const int tid = threadIdx.x, wid = __builtin_amdgcn_readfirstlane(tid >> 6), lane = tid & 63, wr = wid >> 2, wc = wid & 3, fr = lane & 15, fq = lane >> 4;
    const int K = g.K, nt = K / BK;
    unsigned voffA[2], voffB[2];
#pragma unroll
    for (int i = 0; i < 2; ++i) { int R, C; stage_rc(tid * 16 + i * 8192, R, C); const int Rb = Epi::PERM ? ((R & ~31) + perm32(R & 31)) : R;
        voffA[i] = (unsigned)(R * K + C) * 2u; voffB[i] = (unsigned)(Rb * K + C) * 2u; }
    const size_t kstep = (size_t)(BK * 2);
    const size_t hstep = (size_t)HALF * K * 2;
    const size_t tstep = 2 * hstep;
    const unsigned ldsw = (unsigned)wid * 1024u;
    const int aoff = lds_byte(wr * 64 + fr, fq * 8), boff = lds_byte(wc * 32 + fr, fq * 8);
#define PG8_SA(b, h) (((b) * 2 + (h)) * HTB)
#define PG8_SB(b, h) ((4 + (b) * 2 + (h)) * HTB)
#define PG8_STAGE(bufoff, gbase, voff) do { _Pragma("unroll") for (int _i = 0; _i < 2; ++_i) \
        __builtin_amdgcn_global_load_lds((const unsigned*)((const char*)(gbase) + (voff)[_i]), (PG8_LAS unsigned*)(lds + (bufoff) + ldsw + _i * 8192), 16, 0, 0); } while (0)
#define PG8_LDA(dst, b, h) do { _Pragma("unroll") for (int m = 0; m < 4; ++m) _Pragma("unroll") for (int k = 0; k < 2; ++k) dst[m][k] = *(const PG8_LAS bf16x8*)(lds + PG8_SA(b, h) + aoff + m * 2048 + k * 1024); } while (0)
#define PG8_LDB(dst, b, h) do { _Pragma("unroll") for (int n = 0; n < 2; ++n) _Pragma("unroll") for (int k = 0; k < 2; ++k) dst[n][k] = *(const PG8_LAS bf16x8*)(lds + PG8_SB(b, h) + boff + n * 2048 + k * 1024); } while (0)
#define PG8_MMA(ai, bj, At, Bt) do { __builtin_amdgcn_s_setprio(1); _Pragma("unroll") for (int m = 0; m < 4; ++m) _Pragma("unroll") for (int n = 0; n < 2; ++n) _Pragma("unroll") for (int k = 0; k < 2; ++k) \
        acc[ai][bj][m][n] = __builtin_amdgcn_mfma_f32_16x16x32_bf16(Bt[n][k], At[m][k], acc[ai][bj][m][n], 0, 0, 0); __builtin_amdgcn_s_setprio(0); } while (0)
#define PG8_WAIT_V(n) asm volatile("s_waitcnt vmcnt(" #n ")" ::: "memory")
#define PG8_WAIT_L(n) asm volatile("s_waitcnt lgkmcnt(" #n ")" ::: "memory")
#define PG8_BAR __builtin_amdgcn_s_barrier()
#define PG8_SCHED __builtin_amdgcn_sched_barrier(0)
    Unit cur, nxt; int ui = 0;
    if (!S.next(0, cur)) return;
    f32x4 acc[2][2][4][2];
#pragma unroll
    for (int a = 0; a < 2; ++a)
#pragma unroll
        for (int b = 0; b < 2; ++b)
#pragma unroll
            for (int m = 0; m < 4; ++m)
#pragma unroll
                for (int n = 0; n < 2; ++n) acc[a][b][m][n] = (f32x4){0.f, 0.f, 0.f, 0.f};
    bf16x8 At[4][2], B0[2][2], B1[2][2];
    const char* cA = (const char*)g.A + (size_t)cur.pm * tstep; const char* cB = (const char*)g.Bt + (size_t)cur.pn * tstep;
    S.a_ready(cur);
    if constexpr (SP2) {
        PG8_STAGE(PG8_SB(0, 0), cB, voffB); PG8_STAGE(PG8_SB(0, 1), cB + hstep, voffB); PG8_STAGE(PG8_SA(0, 0), cA, voffA); PG8_STAGE(PG8_SA(0, 1), cA + hstep, voffA);
        if (wr == 1) PG8_BAR;
        PG8_WAIT_V(2); PG8_BAR;
        PG8_STAGE(PG8_SB(1, 0), cB + kstep, voffB); PG8_STAGE(PG8_SA(1, 0), cA + kstep, voffA); PG8_STAGE(PG8_SB(1, 1), cB + hstep + kstep, voffB);
        PG8_WAIT_V(6); PG8_BAR;
    } else {
        PG8_STAGE(PG8_SB(0, 0), cB, voffB); PG8_STAGE(PG8_SA(0, 0), cA, voffA); PG8_STAGE(PG8_SB(0, 1), cB + hstep, voffB); PG8_STAGE(PG8_SA(0, 1), cA + hstep, voffA);
        if (wr == 1) PG8_BAR;
        PG8_WAIT_V(4); PG8_BAR;
        PG8_STAGE(PG8_SB(1, 0), cB + kstep, voffB); PG8_STAGE(PG8_SA(1, 0), cA + kstep, voffA); PG8_STAGE(PG8_SB(1, 1), cB + hstep + kstep, voffB);
        PG8_WAIT_V(6); PG8_BAR;
    }
    for (;;) {
        const bool has_next = S.next(ui + 1, nxt);
        const char* nA = has_next ? (const char*)g.A + (size_t)nxt.pm * tstep : cA; const char* nB = has_next ? (const char*)g.Bt + (size_t)nxt.pn * tstep : cB;
        for (int t = 0; t < nt; t += 2) {
            const bool last = (t == nt - 2);
            const char* a1 = cA + (size_t)(t + 1) * kstep;
            const char* a2 = last ? nA : cA + (size_t)(t + 2) * kstep; const char* b2 = last ? nB : cB + (size_t)(t + 2) * kstep;
            const char* a3 = a2 + kstep; const char* b3 = b2 + kstep;
            if (last && has_next) S.a_ready(nxt);
            if constexpr (SP2) {
            PG8_LDB(B0, 0, 0); PG8_LDB(B1, 0, 1); PG8_SCHED; PG8_LDA(At, 0, 0); PG8_STAGE(PG8_SA(1, 1), a1 + hstep, voffA);
            PG8_WAIT_V(8); PG8_WAIT_L(0); PG8_BAR; PG8_MMA(0, 0, At, B0); PG8_MMA(0, 1, At, B1); PG8_BAR; PG8_SCHED;
            PG8_LDA(At, 0, 1); PG8_STAGE(PG8_SB(0, 0), b2, voffB); PG8_STAGE(PG8_SB(0, 1), b2 + hstep, voffB); PG8_STAGE(PG8_SA(0, 0), a2, voffA);
            PG8_WAIT_V(8); PG8_WAIT_L(0); PG8_BAR; PG8_MMA(1, 0, At, B0); PG8_MMA(1, 1, At, B1); PG8_BAR; PG8_SCHED;
            PG8_LDB(B0, 1, 0); PG8_LDB(B1, 1, 1); PG8_SCHED; PG8_LDA(At, 1, 0); PG8_STAGE(PG8_SA(0, 1), a2 + hstep, voffA);
            PG8_WAIT_V(8); PG8_WAIT_L(0); PG8_BAR; PG8_MMA(0, 0, At, B0); PG8_MMA(0, 1, At, B1); PG8_BAR; PG8_SCHED;
            PG8_LDA(At, 1, 1); PG8_STAGE(PG8_SB(1, 0), b3, voffB); PG8_STAGE(PG8_SB(1, 1), b3 + hstep, voffB); PG8_STAGE(PG8_SA(1, 0), a3, voffA);
            PG8_WAIT_V(8); PG8_WAIT_L(0); PG8_BAR; PG8_MMA(1, 0, At, B0); PG8_MMA(1, 1, At, B1); PG8_BAR; PG8_SCHED;
            } else {
            PG8_LDB(B0, 0, 0); PG8_SCHED; PG8_LDA(At, 0, 0); PG8_STAGE(PG8_SA(1, 1), a1 + hstep, voffA);
            PG8_WAIT_L(8); PG8_BAR; PG8_WAIT_L(0); PG8_MMA(0, 0, At, B0); PG8_BAR; PG8_SCHED;
            PG8_LDB(B1, 0, 1); PG8_STAGE(PG8_SB(0, 0), b2, voffB);
            PG8_BAR; PG8_WAIT_L(0); PG8_MMA(0, 1, At, B1); PG8_BAR;
            PG8_LDA(At, 0, 1); PG8_STAGE(PG8_SA(0, 0), a2, voffA);
            PG8_BAR; PG8_WAIT_L(0); PG8_MMA(1, 0, At, B0); PG8_BAR; PG8_SCHED;
            PG8_STAGE(PG8_SB(0, 1), b2 + hstep, voffB);
            PG8_WAIT_V(6); PG8_BAR; PG8_MMA(1, 1, At, B1); PG8_BAR;
            PG8_LDB(B0, 1, 0); PG8_SCHED; PG8_LDA(At, 1, 0); PG8_STAGE(PG8_SA(0, 1), a2 + hstep, voffA);
            PG8_WAIT_L(8); PG8_BAR; PG8_WAIT_L(0); PG8_MMA(0, 0, At, B0); PG8_BAR; PG8_SCHED;
            PG8_LDB(B1, 1, 1); PG8_STAGE(PG8_SB(1, 0), b3, voffB);
            PG8_BAR; PG8_WAIT_L(0); PG8_MMA(0, 1, At, B1); PG8_BAR;
            PG8_LDA(At, 1, 1); PG8_STAGE(PG8_SA(1, 0), a3, voffA);
            PG8_BAR; PG8_WAIT_L(0); PG8_MMA(1, 0, At, B0); PG8_BAR; PG8_SCHED;
            PG8_STAGE(PG8_SB(1, 1), b3 + hstep, voffB);
            PG8_WAIT_V(6); PG8_BAR; PG8_MMA(1, 1, At, B1); PG8_BAR;
            }
        }
        if constexpr (ALIGN_EPI) { if (wr == 0) PG8_BAR; }
        if constexpr (!Epi::AFTER_DRAIN) { E(acc, cur, wr, wc, fr, fq); S.done(cur); }
        if (!has_next) break;
#pragma unroll
        for (int a = 0; a < 2; ++a)
#pragma unroll
            for (int b = 0; b < 2; ++b)
#pragma unroll
                for (int m = 0; m < 4; ++m)
#pragma unroll
                    for (int n = 0; n < 2; ++n) acc[a][b][m][n] = (f32x4){0.f, 0.f, 0.f, 0.f};
        cur = nxt; cA = nA; cB = nB; ++ui;
        if constexpr (ALIGN_EPI) { if (wr == 1) PG8_BAR; }
    }
    PG8_WAIT_V(0);
    if constexpr (!ALIGN_EPI) { if (wr == 0) PG8_BAR; }
    PG8_BAR;
    if constexpr (Epi::AFTER_DRAIN) { E.fused(acc, cur, wr, wc, fr, fq, lds, wid, lane); S.done(cur); }
#undef PG8_SA
#undef PG8_SB
#undef PG8_STAGE
#undef PG8_LDA
#undef PG8_LDB
#undef PG8_MMA
#undef PG8_WAIT_V
#undef PG8_WAIT_L
#undef PG8_BAR
#undef PG8_SCHED
}
}

constexpr int NWAVES = 8, NTHR = 512;
constexpr int DM = 1024, SEQ = 16384, DB = 128, DSEQ = 4, NSAMP = DB * DSEQ, MTOT = SEQ + NSAMP;
constexpr int AH = 12, HD = 64, ATTW = 768, SH = 20, SSW = 1280, NG = 4, DSTATE = 128, CONVD = 2304, MIXW = 2048, DFF = 2816, DINP = 5908;
constexpr int NP = 6144;
constexpr int CQ = 0, CK = 768, CV = 1536, CZ = 2304, CX = 3584, CDT = 5888;
constexpr int WB = 2048;
constexpr int NCHUNK = 128, CL = 128;
constexpr float EPS = 1e-6f;
constexpr size_t O_YP = 0, O_YS = O_YP + (size_t)SEQ * DM, O_WKP = O_YS + (size_t)NSAMP * DM, O_WVP = O_WKP + (size_t)2048 * ATTW, O_CVP = O_WVP + (size_t)2048 * ATTW,
                 O_SSP = O_CVP + 3 * CONVD, O_WKS = O_SSP + (size_t)SH * HD * DSTATE, O_WVS = O_WKS + (size_t)NSAMP * ATTW, O_CVS = O_WVS + (size_t)NSAMP * ATTW,
                 O_SSS = O_CVS + (size_t)DB * 3 * CONVD, O_END = O_SSS + (size_t)DB * SH * HD * DSTATE;
constexpr size_t MiB = 1u << 20;
constexpr size_t WS_CTL = 0, CTL_ZERO_BYTES = 1 * MiB;
constexpr size_t CTL_SS2 = 256 * 1024, CTL_SS3 = 384 * 1024;
constexpr size_t WS_WIN = 2 * MiB;
constexpr size_t WS_WOUT = WS_WIN + (size_t)NP * DM * 2;
constexpr size_t WS_WGU = WS_WOUT + (size_t)DM * MIXW * 2;
constexpr size_t WS_WDN = WS_WGU + (size_t)2 * DFF * DM * 2;
constexpr size_t WS_BKT = WS_WDN + (size_t)DM * DFF * 2;
constexpr size_t WS_RS1 = WS_BKT + 16384;
constexpr size_t WS_ATTSS = WS_RS1 + (size_t)MTOT * 4;
constexpr size_t WS_DTB = WS_ATTSS + (size_t)MTOT * 12 * 4;
constexpr size_t WS_ACS = WS_DTB + (size_t)SEQ * 20 * 4;
constexpr size_t WS_CDEC = WS_ACS + (size_t)SEQ * 20 * 4;
constexpr size_t WS_XB = 64 * MiB;
constexpr size_t WS_PROJ = WS_XB + (size_t)MTOT * DM * 2;
constexpr size_t WS_MIX = WS_PROJ + (size_t)MTOT * NP * 2;
constexpr size_t WS_X1 = WS_MIX + (size_t)MTOT * MIXW * 2;
constexpr size_t WS_X1B = WS_X1 + (size_t)MTOT * DM * 4;
constexpr size_t WS_ACT = WS_X1B + (size_t)MTOT * DM * 2;
constexpr size_t WS_XC = WS_ACT + (size_t)MTOT * DFF * 2;
constexpr size_t WS_ST = WS_XC + (size_t)SEQ * CONVD * 2;
constexpr size_t WS_OPART = WS_ST + (size_t)NCHUNK * SH * HD * DSTATE * 4;
constexpr size_t WS_ML = WS_OPART + (size_t)3 * SEQ * ATTW * 2;
constexpr size_t WS_HIN = WS_ML + (size_t)3 * SEQ * AH * 2 * 4;
constexpr size_t WS_BIASP = WS_HIN + (size_t)NCHUNK * SH * HD * DSTATE * 2;
constexpr size_t WS_BIASS = WS_BIASP + 3 * 12 * 132 * 4;
constexpr size_t WS_END = WS_BIASS + 6 * 2052 * 2 * 4;
static_assert(WS_CDEC + 128 * 20 * 4 <= WS_XB, "ws map");
constexpr int CW_BAR = 1024;
constexpr int RING_BYTES = 131072;
constexpr int MISC_OFF = 155648;
constexpr int LDS_BYTES = 155648 + 256;

#define GAS __attribute__((address_space(1)))
#define LAS __attribute__((address_space(3)))
typedef unsigned short bf16;
typedef unsigned v4u __attribute__((ext_vector_type(4)));
typedef float f32x4 __attribute__((ext_vector_type(4)));
typedef short bf16x8 __attribute__((ext_vector_type(8)));
typedef GAS unsigned gu32;
typedef GAS unsigned long long gu64;
#define RLX_AGENT __ATOMIC_RELAXED, __HIP_MEMORY_SCOPE_AGENT
#define LDS_WAIT() asm volatile("s_waitcnt lgkmcnt(0)" ::: "memory")
#define VM_WAIT() asm volatile("s_waitcnt vmcnt(0)" ::: "memory")
__device__ __forceinline__ unsigned long long rt() { return __builtin_amdgcn_s_memrealtime(); }
__device__ __forceinline__ unsigned f2bf(float f) { unsigned u = __builtin_bit_cast(unsigned, f); return (u + 0x7fffu + ((u >> 16) & 1u)) >> 16; }
__device__ __forceinline__ unsigned pk2(float lo, float hi) { return f2bf(lo) | (f2bf(hi) << 16); }

#define XB_TMO      128
#define XB_XCNT(j)  (256  + 64 * (j))
#define XB_XSUB(j)  (1280 + 64 * (j))
#define XB_XGEN(j)  (2304 + 64 * (j))
#define XB_TOP      3328
#define XB_TOPGEN   3392
#define XCD_BAR_WORDS 3456
#define XB_SPIN_CAP (1u << 23)

__device__ __forceinline__ unsigned xb_ld(unsigned* p)              { return __hip_atomic_load(p, __ATOMIC_RELAXED, __HIP_MEMORY_SCOPE_AGENT); }
__device__ __forceinline__ unsigned xb_add(unsigned* p, unsigned v) { return __hip_atomic_fetch_add(p, v, __ATOMIC_RELAXED, __HIP_MEMORY_SCOPE_AGENT); }
__device__ __forceinline__ unsigned xb_xcc_id() { return (unsigned)__builtin_amdgcn_s_getreg((3 << 11) | 20) & 0xFu; }
#define XB_SPIN(cond, bar) do { unsigned _sp = 0; while (cond) { __builtin_amdgcn_s_sleep(1); \
    if ((++_sp & 255u) == 0u) { if (xb_ld(&(bar)[XB_TMO])) break; if (_sp > XB_SPIN_CAP) { atomicAdd(&(bar)[XB_TMO], 1u); break; } } } } while (0)

struct XcdBarrier {
    unsigned* bar; unsigned x;
    volatile LAS unsigned* st;
};

__device__ __forceinline__ XcdBarrier xcd_barrier_post(unsigned* bar, volatile LAS unsigned* st) {
    XcdBarrier b; b.bar = bar; b.x = xb_xcc_id(); b.st = st;
    if (threadIdx.x == 0) (void)xb_add(&bar[XB_XCNT(b.x)], 1u);
    return b;
}
__device__ __forceinline__ void xcd_barrier_complete(unsigned* bar, unsigned x, unsigned& nloc, unsigned& nx) {
    const unsigned G = gridDim.x * gridDim.y * gridDim.z;
    unsigned sum, cnt, mine, sp = 0u;
    for (;;) {
        sum = 0u; cnt = 0u; mine = 0u;
#pragma unroll
        for (unsigned j = 0; j < 16; ++j) { const unsigned c = xb_ld(&bar[XB_XCNT(j)]); sum += c; cnt += (c > 0u) ? 1u : 0u; mine = (j == x) ? c : mine; }
        if (sum == G) break;
        __builtin_amdgcn_s_sleep(1);
        if ((++sp & 255u) == 0u) { if (xb_ld(&bar[XB_TMO])) break; if (sp > XB_SPIN_CAP) { atomicAdd(&bar[XB_TMO], 1u); break; } }
    }
    nloc = mine > 0u ? mine : 1u; nx = cnt > 0u ? cnt : 1u;
}

__device__ __forceinline__ void xcd_barrier(const XcdBarrier& b) {
    asm volatile("s_waitcnt vmcnt(0)" ::: "memory");
    __syncthreads();
    if (threadIdx.x == 0) {
        unsigned* bar = b.bar;
        __builtin_amdgcn_s_waitcnt(0);
        unsigned nloc = b.st[0], nx = b.st[1];
        if (nloc == 0u) { xcd_barrier_complete(bar, b.x, nloc, nx); b.st[0] = nloc; b.st[1] = nx; }
        const unsigned old = xb_add(&bar[XB_XSUB(b.x)], 1u);
        const unsigned gen = old / nloc;
        if (old + 1u == (gen + 1u) * nloc) {
            __builtin_amdgcn_fence(__ATOMIC_RELEASE, "agent");
            asm volatile("s_waitcnt vmcnt(0)" ::: "memory");
            const unsigned og = xb_add(&bar[XB_TOP], 1u);
            const unsigned tg = og / nx;
            if (og + 1u == (tg + 1u) * nx) xb_add(&bar[XB_TOPGEN], 1u);
            else XB_SPIN(xb_ld(&bar[XB_TOPGEN]) == tg, bar);
            __builtin_amdgcn_fence(__ATOMIC_ACQUIRE, "agent");
            xb_add(&bar[XB_XGEN(b.x)], 1u);
            asm volatile("s_waitcnt vmcnt(0)" ::: "memory");
        } else {
            XB_SPIN(xb_ld(&bar[XB_XGEN(b.x)]) == gen, bar);
            __builtin_amdgcn_fence(__ATOMIC_ACQUIRE, "agent");
            asm volatile("s_waitcnt vmcnt(0)" ::: "memory");
        }
    }
    __syncthreads();
}

__device__ __forceinline__ float bf2f(unsigned short u) { return __uint_as_float((unsigned)u << 16); }
__device__ __forceinline__ float wave_sum(float v) {
#pragma unroll
    for (int o = 1; o < 64; o <<= 1) v += __shfl_xor(v, o);
    return v;
}
__device__ __forceinline__ float silu_f(float x) { return x * __builtin_amdgcn_rcpf(1.f + __builtin_amdgcn_exp2f(-1.4426950408889634f * x)); }
__device__ __forceinline__ float softplus_f(float x) { return x > 20.f ? x : log1pf(__expf(x)); }
__device__ __forceinline__ int rel_bucket(int n) {
    if (n < 16) return n;
    const float v = logf((float)n / 16.0f) / 4.852030263919617f * 16.0f;
    int b = 16 + (int)v; return b > 31 ? 31 : b;
}
__device__ __forceinline__ int attn_mult(int delta) {
    return (delta <= 128 ? 1 : 0) + (((delta & 3) == 0 && delta <= 512) ? 1 : 0) + (((delta & 15) == 0 && delta <= 2048) ? 1 : 0);
}

__device__ __forceinline__ int lnd(int x) { asm volatile("" : "+v"(x)); return x; }
struct Frame {
    LAS unsigned char* lds;
    int tid, lane, wave, G;
    const float* in[22]; float* out; unsigned char* ws;
};
#define WSP(T, off) ((T*)(F.ws + (off)))

template <int MODE>
__device__ __forceinline__ void tr_item(const float* W, int K, int N, const float* gain, bf16* WT, LAS float* scr, int kb, int nb, int lane) {
    const int k0 = 64 * kb, n0 = 32 * nb;
    {
        const int n = n0 + (lane & 31);
#pragma unroll 8
        for (int i = 0; i < 32; ++i) { const int kk = 2 * i + (lane >> 5); float v = (n < N) ? W[(size_t)(k0 + kk) * N + n] : 0.f; if (gain) v *= gain[k0 + kk]; scr[kk * 33 + (lane & 31)] = v; }
    }
    LDS_WAIT(); asm volatile("" ::: "memory");
    const int c = lane & 7;
#pragma unroll
    for (int j = 0; j < 4; ++j) { const int nl = (lane >> 3) + 8 * j, n = n0 + nl; const LAS float* s = scr + (8 * c) * 33 + nl;
        v4u o; o.x = pk2(s[0 * 33], s[1 * 33]); o.y = pk2(s[2 * 33], s[3 * 33]); o.z = pk2(s[4 * 33], s[5 * 33]); o.w = pk2(s[6 * 33], s[7 * 33]);
        int drow = n; if (MODE == 1) drow = (n >> 7) * 256 + (n & 127); if (MODE == 2) drow = (n >> 7) * 256 + 128 + (n & 127);
        *(GAS v4u*)(WT + (size_t)drow * K + k0 + 8 * c) = o; }
    LDS_WAIT(); asm volatile("" ::: "memory");
}
__device__ __forceinline__ void p0_prologue(Frame& F) {
    LAS float* scr = (LAS float*)(F.lds + F.wave * 16384);
    const int gw = blockIdx.x * NWAVES + F.wave, NGW = F.G * NWAVES;
    constexpr int I_IN = 16 * 192, I_OUT = 32 * 32, I_G = 16 * 88, I_D = 44 * 32;
    constexpr int NITEMS = I_IN + I_OUT + 2 * I_G + I_D;
    for (int it = gw; it < NITEMS; it += NGW) {
        int r = it;
        if (r < I_IN) { tr_item<0>(F.in[8], DM, DINP, F.in[7], WSP(bf16, WS_WIN), scr, r / 192, r % 192, F.lane); continue; } r -= I_IN;
        if (r < I_OUT) { tr_item<0>(F.in[16], MIXW, DM, nullptr, WSP(bf16, WS_WOUT), scr, r / 32, r % 32, F.lane); continue; } r -= I_OUT;
        if (r < I_G) { tr_item<1>(F.in[18], DM, DFF, F.in[17], WSP(bf16, WS_WGU), scr, r / 88, r % 88, F.lane); continue; } r -= I_G;
        if (r < I_G) { tr_item<2>(F.in[19], DM, DFF, F.in[17], WSP(bf16, WS_WGU), scr, r / 88, r % 88, F.lane); continue; } r -= I_G;
        tr_item<0>(F.in[20], DFF, DM, nullptr, WSP(bf16, WS_WDN), scr, r / 32, r % 32, F.lane);
    }
    bf16* XB = WSP(bf16, WS_XB); float* RS1 = WSP(float, WS_RS1);
    for (int m = gw; m < MTOT; m += NGW) {
        const float* xrow = m < SEQ ? F.in[0] + (size_t)m * DM : F.in[1] + (size_t)(m - SEQ) * DM;
        const GAS f32x4* xr = (const GAS f32x4*)xrow + F.lane;
        f32x4 v[4]; float s = 0.f;
#pragma unroll
        for (int j = 0; j < 4; ++j) { v[j] = xr[64 * j]; s += (v[j].x * v[j].x + v[j].y * v[j].y) + (v[j].z * v[j].z + v[j].w * v[j].w); }
        s = wave_sum(s);
        GAS unsigned long long* o8 = (GAS unsigned long long*)(XB + (size_t)m * DM) + F.lane;
#pragma unroll
        for (int j = 0; j < 4; ++j) o8[64 * j] = (unsigned long long)pk2(v[j].x, v[j].y) | ((unsigned long long)pk2(v[j].z, v[j].w) << 32);
        if (F.lane == 0) RS1[m] = 1.0f / sqrtf(s * (1.0f / DM) + EPS);
    }
    { const float* relb = F.in[6]; float* BP = WSP(float, WS_BIASP); float* BS = WSP(float, WS_BIASS); constexpr float LOG2E = 1.4426950408889634f;
      for (int i = blockIdx.x * NTHR + F.tid; i < 3 * 12 * 132 + 6 * 2052 * 2; i += F.G * NTHR) {
          if (i < 3 * 12 * 132) { const int br = i / (12 * 132), h = (i / 132) % 12, k = i % 132; BP[i] = relb[rel_bucket((k > 128 ? 128 : k) << (2 * br)) * AH + h] * LOG2E; }
          else { const int j = i - 3 * 12 * 132; const int hp = j / (2052 * 2), dl = (j >> 1) % 2052, hd = j & 1; BS[j] = relb[rel_bucket(dl > 2048 ? 2048 : dl) * AH + 2 * hp + hd] * LOG2E; } } }
}

struct EpiProj {
    static constexpr bool PERM = true, AFTER_DRAIN = false;
    bf16* O; const float* rs; float* out;
    __device__ __forceinline__ void operator()(const pg8::f32x4 (&acc)[2][2][4][2], const pg8::Unit& u, int wr, int wc, int fr, int fq) const {
        const int row0 = u.pm * 256 + wr * 64 + fr, col0 = u.pn * 256 + wc * 32 + 8 * fq;
        const bool kv = (u.pm >= 56) && (u.pn >= 3) && (u.pn < 9); const bool is_k = u.pn < 6;
#pragma unroll
        for (int ai = 0; ai < 2; ++ai)
#pragma unroll
            for (int m = 0; m < 4; ++m) { const int row = row0 + ai * 128 + m * 16; const float s = rs[row];
#pragma unroll
                for (int bj = 0; bj < 2; ++bj) { const int col = col0 + bj * 128; const pg8::f32x4 v0 = acc[ai][bj][m][0] * s, v1 = acc[ai][bj][m][1] * s;
                    pg8::u32x4 w; w.x = pg8::cvt_pk_bf16(v0[0], v0[1]); w.y = pg8::cvt_pk_bf16(v0[2], v0[3]); w.z = pg8::cvt_pk_bf16(v1[0], v1[1]); w.w = pg8::cvt_pk_bf16(v1[2], v1[3]);
                    *(pg8::u32x4*)(O + (size_t)row * NP + col) = w;
                    if (kv) { const int cc = col - (is_k ? CK : CV);
                        float* dst = row < SEQ ? out + (is_k ? O_WKP : O_WVP) + (size_t)(row - (SEQ - 2048)) * ATTW + cc : out + (is_k ? O_WKS : O_WVS) + (size_t)(row - SEQ) * ATTW + cc;
                        *(pg8::f32x4*)dst = v0; *(pg8::f32x4*)(dst + 4) = v1; } } }
    }
};
struct EpiOut {
    static constexpr bool PERM = false, AFTER_DRAIN = false;
    const float* xp; const float* xs; float* X1; bf16* X1B; float* SS;
    __device__ __forceinline__ void operator()(const pg8::f32x4 (&acc)[2][2][4][2], const pg8::Unit& u, int wr, int wc, int fr, int fq) const {
        const int row0 = u.pm * 256 + wr * 64 + fr, col0 = u.pn * 256 + wc * 32 + 4 * fq;
#pragma unroll
        for (int ai = 0; ai < 2; ++ai)
#pragma unroll
            for (int m = 0; m < 4; ++m) { const int row = row0 + ai * 128 + m * 16; const float* xr = row < SEQ ? xp + (size_t)row * DM : xs + (size_t)(row - SEQ) * DM; float ss = 0.f;
#pragma unroll
                for (int bj = 0; bj < 2; ++bj)
#pragma unroll
                    for (int n = 0; n < 2; ++n) { const int col = col0 + bj * 128 + n * 16; const pg8::f32x4 v = acc[ai][bj][m][n] + *(const pg8::f32x4*)(xr + col);
                        *(pg8::f32x4*)(X1 + (size_t)row * DM + col) = v; ss += (v[0] * v[0] + v[1] * v[1]) + (v[2] * v[2] + v[3] * v[3]);
                        *(unsigned long long*)(X1B + (size_t)row * DM + col) = (unsigned long long)pg8::cvt_pk_bf16(v[0], v[1]) | ((unsigned long long)pg8::cvt_pk_bf16(v[2], v[3]) << 32); }
                ss += __shfl_xor(ss, 16); ss += __shfl_xor(ss, 32);
                if (fq == 0) atomicAdd(SS + row, ss); }
    }
};
struct EpiGU {
    static constexpr bool PERM = true, AFTER_DRAIN = false;
    bf16* ACT; const float* SS;
    __device__ __forceinline__ void operator()(const pg8::f32x4 (&acc)[2][2][4][2], const pg8::Unit& u, int wr, int wc, int fr, int fq) const {
        const int row0 = u.pm * 256 + wr * 64 + fr, col0 = u.pn * 128 + wc * 32 + 8 * fq;
#pragma unroll
        for (int ai = 0; ai < 2; ++ai)
#pragma unroll
            for (int m = 0; m < 4; ++m) { const int row = row0 + ai * 128 + m * 16; const float s = 1.0f / sqrtf(SS[row] * (1.0f / DM) + EPS);
                float a[8];
#pragma unroll
                for (int n = 0; n < 2; ++n)
#pragma unroll
                    for (int e = 0; e < 4; ++e) { const float g = acc[ai][0][m][n][e] * s, uu = acc[ai][1][m][n][e] * s; a[4 * n + e] = silu_f(g) * uu; }
                pg8::u32x4 w; w.x = pg8::cvt_pk_bf16(a[0], a[1]); w.y = pg8::cvt_pk_bf16(a[2], a[3]); w.z = pg8::cvt_pk_bf16(a[4], a[5]); w.w = pg8::cvt_pk_bf16(a[6], a[7]);
                *(pg8::u32x4*)(ACT + (size_t)row * DFF + col0) = w; }
    }
};
struct EpiDown {
    static constexpr bool PERM = false, AFTER_DRAIN = false;
    const float* X1; float* Y; float* SS;
    __device__ __forceinline__ void operator()(const pg8::f32x4 (&acc)[2][2][4][2], const pg8::Unit& u, int wr, int wc, int fr, int fq) const {
        const int row0 = u.pm * 256 + wr * 64 + fr, col0 = u.pn * 256 + wc * 32 + 4 * fq;
#pragma unroll
        for (int ai = 0; ai < 2; ++ai)
#pragma unroll
            for (int m = 0; m < 4; ++m) { const int row = row0 + ai * 128 + m * 16; float ss = 0.f;
#pragma unroll
                for (int bj = 0; bj < 2; ++bj)
#pragma unroll
                    for (int n = 0; n < 2; ++n) { const int col = col0 + bj * 128 + n * 16; const pg8::f32x4 v = acc[ai][bj][m][n] + *(const pg8::f32x4*)(X1 + (size_t)row * DM + col);
                        *(pg8::f32x4*)(Y + (size_t)row * DM + col) = v; ss += (v[0] * v[0] + v[1] * v[1]) + (v[2] * v[2] + v[3] * v[3]); }
                ss += __shfl_xor(ss, 16); ss += __shfl_xor(ss, 32);
                if (fq == 0) atomicAdd(SS + row, ss); }
    }
};

__device__ __forceinline__ void attn_prompt_simple(Frame& F) {
    const bf16* PROJ = WSP(bf16, WS_PROJ); bf16* MIX = WSP(bf16, WS_MIX); float* ATTSS = WSP(float, WS_ATTSS);
    const int* BKT = WSP(int, WS_BKT); const float* relb = F.in[6];
    const int gw = blockIdx.x * NWAVES + F.wave, NGW = F.G * NWAVES, lane = lnd(F.lane);
    for (int t = gw; t < SEQ; t += NGW) {
        for (int h = 0; h < AH; ++h) {
            const float q = bf2f(PROJ[(size_t)t * NP + CQ + h * 64 + lane]) * 0.125f;
            float m = -1e30f, l = 0.f, o = 0.f;
            for (int br = 0; br < 3; ++br) {
                const int d = (br == 0) ? 1 : (br == 1) ? 4 : 16;
                int imax = t / d; if (imax > 128) imax = 128;
                int i = 0;
                for (; i + 3 <= imax; i += 4) {
                    float k[4], v[4], s[4];
#pragma unroll
                    for (int j = 0; j < 4; ++j) { const bf16* kp = PROJ + (size_t)(t - (i + j) * d) * NP + CK + h * 64 + lane; k[j] = bf2f(kp[0]); v[j] = bf2f(kp[CV - CK]); s[j] = q * k[j]; }
#pragma unroll
                    for (int o_ = 1; o_ < 64; o_ <<= 1) {
#pragma unroll
                        for (int j = 0; j < 4; ++j) s[j] += __shfl_xor(s[j], o_); }
#pragma unroll
                    for (int j = 0; j < 4; ++j) s[j] += relb[BKT[(i + j) * d] * AH + h];
                    const float mn = fmaxf(fmaxf(fmaxf(m, s[0]), fmaxf(s[1], s[2])), s[3]);
                    const float a = __expf(m - mn); l *= a; o *= a; m = mn;
#pragma unroll
                    for (int j = 0; j < 4; ++j) { const float p = __expf(s[j] - mn); l += p; o += p * v[j]; }
                }
                for (; i <= imax; ++i) {
                    const bf16* kp = PROJ + (size_t)(t - i * d) * NP + CK + h * 64 + lane;
                    const float kk = bf2f(kp[0]), vv = bf2f(kp[CV - CK]);
                    const float s = wave_sum(q * kk) + relb[BKT[i * d] * AH + h];
                    const float mn = fmaxf(m, s); const float a = __expf(m - mn), p = __expf(s - mn);
                    l = l * a + p; o = o * a + p * vv; m = mn;
                }
            }
            const float r = o / l;
            MIX[(size_t)t * MIXW + h * 64 + lane] = (bf16)f2bf(r);
            const float sq = wave_sum(r * r); if (lane == 0) ATTSS[t * AH + h] = sq;
        }
    }
}


typedef short v4i16_t __attribute__((ext_vector_type(4)));
typedef float f32x16 __attribute__((ext_vector_type(16)));
__device__ __forceinline__ void attn_prompt_mfma(Frame& F) {
    const bf16* PROJ = WSP(bf16, WS_PROJ); bf16* OPART = WSP(bf16, WS_OPART); float* ML = WSP(float, WS_ML);
    const float* BP = WSP(float, WS_BIASP);
    LAS unsigned char* Kl = F.lds; LAS unsigned char* Vl = F.lds + 49152; LAS float* btab = (LAS float*)(F.lds + 98304);
    const int tid = lnd(F.tid), lane = lnd(F.lane), wave = F.wave, q = lane & 31, hi = lane >> 5;
    constexpr float LOG2E = 1.4426950408889634f, C1 = 0.125f * LOG2E, NEG = -1e30f;
    for (int unit = blockIdx.x; unit < 3 * AH * 64; unit += F.G) {
        const int br = unit / 768, rem = unit % 768, h = rem >> 6, blk = rem & 63;
        const int dsh = 2 * br, d = 1 << dsh, r = blk & (d - 1), qb = blk >> dsh, j0 = qb * 256;
        for (int n = wave; n < 48; n += 8) {
            const int row = 8 * n + (lane >> 3), pc = lane & 7; int jj = j0 - 128 + row; if (jj < 0) jj = 0;
            const size_t tok = (size_t)jj * d + r;
            const int lcK = pc ^ ((row >> 1) & 7), lcV = pc ^ (((row >> 1) & 1) << 2);
            __builtin_amdgcn_global_load_lds((const unsigned*)(PROJ + tok * NP + CK + h * 64 + lcK * 8), (LAS unsigned*)(Kl + n * 1024), 16, 0, 0);
            __builtin_amdgcn_global_load_lds((const unsigned*)(PROJ + tok * NP + CV + h * 64 + lcV * 8), (LAS unsigned*)(Vl + n * 1024), 16, 0, 0);
        }
        if (tid < 129) btab[tid] = BP[(br * AH + h) * 132 + tid];
        const size_t tokq = (size_t)(j0 + 32 * wave + q) * d + r;
        bf16x8 qf[4];
#pragma unroll
        for (int s = 0; s < 4; ++s) qf[s] = *(const bf16x8*)(PROJ + tokq * NP + CQ + h * 64 + 16 * s + 8 * hi);
        asm volatile("s_waitcnt vmcnt(0)" ::: "memory");
        __syncthreads();
        f32x16 S[5];
#pragma unroll
        for (int kt = 0; kt < 5; ++kt) {
            const int row0 = 32 * (wave + kt);
            if (j0 - 128 + row0 >= 0) {
                f32x16 acc;
#pragma unroll
                for (int e = 0; e < 16; ++e) acc[e] = 0.f;
                const int krow = row0 + q;
#pragma unroll
                for (int s = 0; s < 4; ++s) { const bf16x8 kf = *(const LAS bf16x8*)(Kl + krow * 128 + (((2 * s + hi) ^ ((krow >> 1) & 7)) << 4));
                    acc = __builtin_amdgcn_mfma_f32_32x32x16_bf16(kf, qf[s], acc, 0, 0, 0); }
#pragma unroll
                for (int e = 0; e < 16; ++e) { const int kl = (e & 3) + 8 * (e >> 2) + 4 * hi; const int i = 128 - 32 * kt + q - kl;
                    const int ic = i < 0 ? 0 : (i > 128 ? 128 : i);
                    const float v = acc[e] * C1 + btab[ic];
                    S[kt][e] = (kt == 0 || kt == 4) ? ((i >= 0 && i <= 128) ? v : NEG) : v; }
            } else {
#pragma unroll
                for (int e = 0; e < 16; ++e) S[kt][e] = NEG;
            }
        }
        float m = NEG;
#pragma unroll
        for (int kt = 0; kt < 5; ++kt)
#pragma unroll
            for (int e = 0; e < 16; ++e) m = fmaxf(m, S[kt][e]);
        m = fmaxf(m, __shfl_xor(m, 32));
        float l = 0.f;
        bf16x8 Pk[5][2];
#pragma unroll
        for (int kt = 0; kt < 5; ++kt) {
#pragma unroll
            for (int e = 0; e < 16; ++e) { const float p = __builtin_amdgcn_exp2f(S[kt][e] - m); S[kt][e] = p; l += p; }
#pragma unroll
            for (int s2 = 0; s2 < 2; ++s2) { v4u w; w.x = pk2(S[kt][8 * s2 + 0], S[kt][8 * s2 + 1]); w.y = pk2(S[kt][8 * s2 + 2], S[kt][8 * s2 + 3]); w.z = pk2(S[kt][8 * s2 + 4], S[kt][8 * s2 + 5]); w.w = pk2(S[kt][8 * s2 + 6], S[kt][8 * s2 + 7]);
                Pk[kt][s2] = __builtin_bit_cast(bf16x8, w); }
        }
        l += __shfl_xor(l, 32);
        f32x16 OT[2];
#pragma unroll
        for (int e = 0; e < 16; ++e) { OT[0][e] = 0.f; OT[1][e] = 0.f; }
        const int g2 = (lane >> 4) & 1, qq = (lane & 15) >> 2, pp = lane & 3;
#pragma unroll
        for (int kt = 0; kt < 5; ++kt) {
            const int row0 = 32 * (wave + kt);
            if (j0 - 128 + row0 >= 0) {
#pragma unroll
                for (int s2 = 0; s2 < 2; ++s2)
#pragma unroll
                    for (int d0 = 0; d0 < 2; ++d0) {
                        const int rlo = row0 + 16 * s2 + 4 * hi + qq, rhi = rlo + 8;
                        const int lc = 4 * d0 + 2 * g2 + (pp >> 1);
                        const LAS unsigned char* alo = Vl + rlo * 128 + ((lc ^ (((rlo >> 1) & 1) << 2)) << 4) + 8 * (pp & 1);
                        const LAS unsigned char* ahi = Vl + rhi * 128 + ((lc ^ (((rhi >> 1) & 1) << 2)) << 4) + 8 * (pp & 1);
                        const v4i16_t lo = __builtin_amdgcn_ds_read_tr16_b64_v4i16((LAS v4i16_t*)alo);
                        const v4i16_t hh = __builtin_amdgcn_ds_read_tr16_b64_v4i16((LAS v4i16_t*)ahi);
                        const bf16x8 vf = (bf16x8){lo[0], lo[1], lo[2], lo[3], hh[0], hh[1], hh[2], hh[3]};
                        OT[d0] = __builtin_amdgcn_mfma_f32_32x32x16_bf16(vf, Pk[kt][s2], OT[d0], 0, 0, 0);
                    }
            }
        }
        const float inv = 1.0f / l;
        bf16* op = OPART + ((size_t)br * SEQ + tokq) * ATTW + h * 64;
#pragma unroll
        for (int d0 = 0; d0 < 2; ++d0)
#pragma unroll
            for (int g = 0; g < 4; ++g) { const int dd = 32 * d0 + 8 * g + 4 * hi;
                *(unsigned long long*)(op + dd) = (unsigned long long)pk2(OT[d0][4 * g] * inv, OT[d0][4 * g + 1] * inv) | ((unsigned long long)pk2(OT[d0][4 * g + 2] * inv, OT[d0][4 * g + 3] * inv) << 32); }
        if (hi == 0) { float* mp = ML + (((size_t)br * SEQ + tokq) * AH + h) * 2; mp[0] = m; mp[1] = l; }
        __syncthreads();
    }
}

template <int CTRL> __device__ __forceinline__ float dpp_f(float x) { return __int_as_float(__builtin_amdgcn_update_dpp(0, __float_as_int(x), CTRL, 0xf, 0xf, true)); }
__device__ __forceinline__ float sum16(float x) { x += dpp_f<0xB1>(x); x += dpp_f<0x4E>(x); x += dpp_f<0x141>(x); x += dpp_f<0x140>(x); return x; }
__device__ __forceinline__ int samp_rho(int e) { return e < 384 ? 16 * (e >> 2) + (e & 3) : (e < 768 ? 1536 + (e - 384) : 1920 + (e - 768)); }
__device__ __forceinline__ void attn_sample(Frame& F) {
    const bf16* PROJ = WSP(bf16, WS_PROJ); bf16* MIX = WSP(bf16, WS_MIX); float* ATTSS = WSP(float, WS_ATTSS);
    const float* BS = WSP(float, WS_BIASS);
    const float* cache_k = F.in[2]; const float* cache_v = F.in[3];
    const int wave = F.wave;
    LAS float* comb = (LAS float*)F.lds;
    LAS float* btab = (LAS float*)(F.lds + 49152);
    constexpr float LOG2E = 1.4426950408889634f, NEG = -1e30f;
    for (int unit = blockIdx.x; unit < DB * 6; unit += F.G) {
        const int tid = lnd(F.tid), lane = lnd(F.lane), r2 = lane >> 5, hd = (lane >> 4) & 1, d0 = 4 * (lane & 15);
        const int b = unit / 6, hp = unit % 6, head = 2 * hp + hd;
        for (int i = tid; i < 2052 * 2 / 4; i += NTHR) ((LAS f32x4*)btab)[i] = *((const f32x4*)(BS + (size_t)hp * 2052 * 2) + i);
        float q[4][4];
#pragma unroll
        for (int t = 0; t < 4; ++t) { const bf16* qp = PROJ + (size_t)(SEQ + 4 * b + t) * NP + CQ + head * 64 + d0;
#pragma unroll
            for (int e = 0; e < 4; ++e) q[t][e] = bf2f(qp[e]) * (0.125f * LOG2E); }
        float m[4], l[4], o[4][4];
#pragma unroll
        for (int t = 0; t < 4; ++t) { m[t] = NEG; l[t] = 0.f;
#pragma unroll
            for (int e = 0; e < 4; ++e) o[t][e] = 0.f; }
        __syncthreads();
#define SAMP_ROW(KK, VV, RHO) do { \
            _Pragma("unroll") for (int t = 0; t < 4; ++t) { \
                const int delta = WB + t - (RHO); const int mu = delta >= 0 ? attn_mult(delta) : 0; \
                float s = (q[t][0] * KK[0] + q[t][1] * KK[1]) + (q[t][2] * KK[2] + q[t][3] * KK[3]); \
                s = sum16(s) + btab[(delta < 0 ? 0 : delta) * 2 + hd]; \
                s = mu > 0 ? s : NEG; \
                const float mn = fmaxf(m[t], s); const float a = __builtin_amdgcn_exp2f(m[t] - mn), pw = (float)mu * __builtin_amdgcn_exp2f(s - mn); \
                l[t] = l[t] * a + pw; m[t] = mn; \
                _Pragma("unroll") for (int e2 = 0; e2 < 4; ++e2) o[t][e2] = o[t][e2] * a + pw * VV[e2]; } } while (0)
#pragma unroll 1
        for (int bt = 0; bt < 7; ++bt) {
            f32x4 kk[8], vv[8]; int rho[8];
#pragma unroll
            for (int j = 0; j < 8; ++j) { const int pi = wave + 8 * (bt * 8 + j); rho[j] = samp_rho(2 * pi + r2);
                const size_t off = (((size_t)b * WB + rho[j]) * AH + head) * HD + d0; kk[j] = *(const f32x4*)(cache_k + off); vv[j] = *(const f32x4*)(cache_v + off); }
#pragma unroll
            for (int j = 0; j < 8; ++j) SAMP_ROW(kk[j], vv[j], rho[j]);
        }
        if (wave == 0) {
#pragma unroll
            for (int j = 0; j < 2; ++j) { const int rn = 2 * j + r2; const bf16* kp = PROJ + (size_t)(SEQ + 4 * b + rn) * NP + CK + head * 64 + d0;
                const f32x4 kn = (f32x4){bf2f(kp[0]), bf2f(kp[1]), bf2f(kp[2]), bf2f(kp[3])}, vn = (f32x4){bf2f(kp[CV - CK]), bf2f(kp[CV - CK + 1]), bf2f(kp[CV - CK + 2]), bf2f(kp[CV - CK + 3])};
                SAMP_ROW(kn, vn, WB + rn); }
        }
#undef SAMP_ROW
#pragma unroll
        for (int t = 0; t < 4; ++t) { LAS float* cr = comb + ((wave * 4 + t) * 64 + lane) * 6; cr[0] = m[t]; cr[1] = l[t]; cr[2] = o[t][0]; cr[3] = o[t][1]; cr[4] = o[t][2]; cr[5] = o[t][3]; }
        __syncthreads();
        const int tid2 = lnd(F.tid);
        if (tid2 < 128) {
            const int t = tid2 >> 5, hd2 = (tid2 >> 4) & 1, dl = tid2 & 15;
            float mm = NEG;
#pragma unroll
            for (int w = 0; w < 16; ++w) mm = fmaxf(mm, comb[(((w >> 1) * 4 + t) * 64 + (w & 1) * 32 + hd2 * 16 + dl) * 6]);
            float ll = 0.f, oo[4] = {0.f, 0.f, 0.f, 0.f};
#pragma unroll
            for (int w = 0; w < 16; ++w) { const LAS float* cr = comb + (((w >> 1) * 4 + t) * 64 + (w & 1) * 32 + hd2 * 16 + dl) * 6; const float a = __builtin_amdgcn_exp2f(cr[0] - mm); ll += cr[1] * a;
#pragma unroll
                for (int e2 = 0; e2 < 4; ++e2) oo[e2] += cr[2 + e2] * a; }
            const float inv = 1.0f / ll; float sq = 0.f;
#pragma unroll
            for (int e2 = 0; e2 < 4; ++e2) { oo[e2] *= inv; sq += oo[e2] * oo[e2]; }
            const int row = SEQ + 4 * b + t, hh = 2 * hp + hd2;
            *(unsigned long long*)(MIX + (size_t)row * MIXW + hh * 64 + 4 * dl) = (unsigned long long)pk2(oo[0], oo[1]) | ((unsigned long long)pk2(oo[2], oo[3]) << 32);
            sq = sum16(sq);
            if (dl == 0) ATTSS[row * AH + hh] = sq;
        }
        __syncthreads();
    }
}

__device__ __forceinline__ void ssd_phase_a(Frame& F) {
    const bf16* PROJ = WSP(bf16, WS_PROJ); bf16* XC = WSP(bf16, WS_XC); float* DTB = WSP(float, WS_DTB); float* ACS = WSP(float, WS_ACS); float* CDEC = WSP(float, WS_CDEC); float* ST = WSP(float, WS_ST);
    const float* conv_w = F.in[9]; const float* conv_b = F.in[10]; const float* dt_bias = F.in[11]; const float* a_log = F.in[12];
    LAS bf16* xs = (LAS bf16*)F.lds;
    LAS bf16* Bs = (LAS bf16*)(F.lds + 81920);
    LAS float* dts = (LAS float*)(F.lds + 81920 + 32768);
    LAS float* acsS = dts + 640;
    LAS float* wl = acsS + 640;
    const int tid = lnd(F.tid), lane = lnd(F.lane), wave = F.wave;
    for (int unit = blockIdx.x; unit < NCHUNK * NG; unit += F.G) {
        const int c = unit >> 2, g = unit & 3, T0 = c * CL;
        for (int task = tid; task < 576 * 8; task += NTHR) {
            const int cj = task % 576, seg = task / 576;
            const int xcol = cj < 320 ? g * 320 + cj : (cj < 448 ? 1280 + g * 128 + (cj - 320) : 1792 + g * 128 + (cj - 448));
            const float w0 = conv_w[xcol], w1 = conv_w[CONVD + xcol], w2 = conv_w[2 * CONVD + xcol], w3 = conv_w[3 * CONVD + xcol], bb = conv_b[xcol];
            const int t0 = T0 + seg * 16;
            float x0 = t0 >= 3 ? bf2f(PROJ[(size_t)(t0 - 3) * NP + CX + xcol]) : 0.f, x1 = t0 >= 2 ? bf2f(PROJ[(size_t)(t0 - 2) * NP + CX + xcol]) : 0.f, x2 = t0 >= 1 ? bf2f(PROJ[(size_t)(t0 - 1) * NP + CX + xcol]) : 0.f;
#pragma unroll 4
            for (int i = 0; i < 16; ++i) { const float x3 = bf2f(PROJ[(size_t)(t0 + i) * NP + CX + xcol]);
                const float y = silu_f(x0 * w0 + x1 * w1 + x2 * w2 + x3 * w3 + bb); const bf16 yb = (bf16)f2bf(y);
                XC[(size_t)(t0 + i) * CONVD + xcol] = yb;
                const int l = seg * 16 + i;
                if (cj < 320) xs[l * 320 + cj] = yb; else if (cj < 448) Bs[l * 128 + (cj - 320)] = yb;
                x0 = x1; x1 = x2; x2 = x3; }
            if (c == NCHUNK - 1 && seg == 7) {
                F.out[O_CVP + 0 * CONVD + xcol] = x0; F.out[O_CVP + 1 * CONVD + xcol] = x1; F.out[O_CVP + 2 * CONVD + xcol] = x2; }
        }
        for (int i = tid; i < 640; i += NTHR) { const int l = i / 5, hl = i % 5, h = g * 5 + hl;
            const float dt = softplus_f(bf2f(PROJ[(size_t)(T0 + l) * NP + CDT + h]) + dt_bias[h]);
            dts[i] = dt; acsS[i] = dt * (-__expf(a_log[h])); DTB[(size_t)(T0 + l) * SH + h] = dt; }
        __syncthreads();
        if (wave < 5) {
            const int hl = wave; const float a0 = acsS[(2 * lane) * 5 + hl], a1 = acsS[(2 * lane + 1) * 5 + hl];
            float s = a0 + a1;
#pragma unroll
            for (int o = 1; o < 64; o <<= 1) { const float u = __shfl_up(s, o); if (lane >= o) s += u; }
            const float e0 = s - a1;
            acsS[(2 * lane) * 5 + hl] = e0; acsS[(2 * lane + 1) * 5 + hl] = s;
            ACS[(size_t)(T0 + 2 * lane) * SH + g * 5 + hl] = e0; ACS[(size_t)(T0 + 2 * lane + 1) * SH + g * 5 + hl] = s;
            if (lane == 63) CDEC[c * SH + g * 5 + hl] = __expf(s);
        }
        __syncthreads();
        const int n = tid & 127, pq = __builtin_amdgcn_readfirstlane(tid >> 7);
        for (int hl = 0; hl < 5; ++hl) {
            if (tid < 128) wl[tid] = __expf(acsS[127 * 5 + hl] - acsS[tid * 5 + hl]) * dts[tid * 5 + hl];
            __syncthreads();
            float acc[16];
#pragma unroll
            for (int j = 0; j < 16; ++j) acc[j] = 0.f;
            for (int l = 0; l < CL; ++l) { const float bw = bf2f(Bs[l * 128 + n]) * wl[l];
                const LAS bf16* xr = xs + l * 320 + hl * 64 + pq * 16;
#pragma unroll
                for (int j = 0; j < 16; ++j) acc[j] += bw * bf2f(xr[j]); }
            float* dst = ST + (((size_t)c * SH + g * 5 + hl) * HD + pq * 16) * DSTATE + n;
#pragma unroll
            for (int j = 0; j < 16; ++j) dst[(size_t)j * DSTATE] = acc[j];
            __syncthreads();
        }
    }
}


__device__ __forceinline__ void ssd_phase_a_mfma(Frame& F) {
    const bf16* PROJ = WSP(bf16, WS_PROJ); bf16* XC = WSP(bf16, WS_XC); float* DTB = WSP(float, WS_DTB); float* ACS = WSP(float, WS_ACS); float* CDEC = WSP(float, WS_CDEC); float* ST = WSP(float, WS_ST);
    const float* conv_w = F.in[9]; const float* conv_b = F.in[10]; const float* dt_bias = F.in[11]; const float* a_log = F.in[12];
    LAS unsigned char* xim = F.lds;
    LAS unsigned char* Bim = F.lds + 81920;
    LAS float* dts = (LAS float*)(F.lds + 114688);
    LAS float* acsS = dts + 640;
    LAS float* wls = acsS + 640;
    const int tid = lnd(F.tid), lane = lnd(F.lane), wave = F.wave;
    for (int unit = blockIdx.x; unit < NCHUNK * NG; unit += F.G) {
        const int c = unit >> 2, g = unit & 3, T0 = c * CL;
        for (int i = tid; i < 640; i += NTHR) { const int l = i / 5, hl = i % 5, h = g * 5 + hl;
            const float dt = softplus_f(bf2f(PROJ[(size_t)(T0 + l) * NP + CDT + h]) + dt_bias[h]);
            dts[i] = dt; acsS[i] = dt * (-__expf(a_log[h])); DTB[(size_t)(T0 + l) * SH + h] = dt; }
        __syncthreads();
        if (wave < 5) {
            const int hl = wave; const float a0 = acsS[(2 * lane) * 5 + hl], a1 = acsS[(2 * lane + 1) * 5 + hl];
            float s = a0 + a1;
#pragma unroll
            for (int o = 1; o < 64; o <<= 1) { const float u = __shfl_up(s, o); if (lane >= o) s += u; }
            const float e0 = s - a1; const float last = __shfl(s, 63);
            acsS[(2 * lane) * 5 + hl] = e0; acsS[(2 * lane + 1) * 5 + hl] = s;
            ACS[(size_t)(T0 + 2 * lane) * SH + g * 5 + hl] = e0; ACS[(size_t)(T0 + 2 * lane + 1) * SH + g * 5 + hl] = s;
            wls[(2 * lane) * 5 + hl] = __expf(last - e0) * dts[(2 * lane) * 5 + hl]; wls[(2 * lane + 1) * 5 + hl] = __expf(last - s) * dts[(2 * lane + 1) * 5 + hl];
            if (lane == 63) CDEC[c * SH + g * 5 + hl] = __expf(s);
        }
        __syncthreads();
#pragma unroll 1
        for (int kb = 0; kb < 5; kb += 3) {
            unsigned long long xraw[3][11];
#pragma unroll
            for (int k = 0; k < 3; ++k) { const int task = tid + NTHR * (kb + k);
                if (task < 144 * 16) { const int cq = task % 144, seg = task / 144, cj0 = 4 * cq;
                    const int xcol = cj0 < 320 ? g * 320 + cj0 : (cj0 < 448 ? 1280 + g * 128 + (cj0 - 320) : 1792 + g * 128 + (cj0 - 448));
                    const int t0 = T0 + seg * 8;
#pragma unroll
                    for (int i = 0; i < 11; ++i) { const int t = t0 - 3 + i; xraw[k][i] = t >= 0 ? *(const unsigned long long*)(PROJ + (size_t)t * NP + CX + xcol) : 0ull; } } }
#pragma unroll
            for (int k = 0; k < 3; ++k) { const int task = tid + NTHR * (kb + k);
                if (task < 144 * 16) { const int cq = task % 144, seg = task / 144, cj0 = 4 * cq;
                    const int xcol = cj0 < 320 ? g * 320 + cj0 : (cj0 < 448 ? 1280 + g * 128 + (cj0 - 320) : 1792 + g * 128 + (cj0 - 448));
                    const f32x4 w0 = *(const f32x4*)(conv_w + xcol), w1 = *(const f32x4*)(conv_w + CONVD + xcol), w2 = *(const f32x4*)(conv_w + 2 * CONVD + xcol), w3 = *(const f32x4*)(conv_w + 3 * CONVD + xcol), bb = *(const f32x4*)(conv_b + xcol);
                    const int l0 = seg * 8;
#define XR(i) ((f32x4){bf2f((unsigned short)xraw[k][i]), bf2f((unsigned short)(xraw[k][i] >> 16)), bf2f((unsigned short)(xraw[k][i] >> 32)), bf2f((unsigned short)(xraw[k][i] >> 48))})
#pragma unroll
                    for (int i = 0; i < 8; ++i) { const int l = l0 + i;
                        f32x4 y = XR(i) * w0 + XR(i + 1) * w1 + XR(i + 2) * w2 + XR(i + 3) * w3 + bb;
#pragma unroll
                        for (int e2 = 0; e2 < 4; ++e2) y[e2] = silu_f(y[e2]);
                        *(unsigned long long*)(XC + (size_t)(T0 + l) * CONVD + xcol) = (unsigned long long)pk2(y[0], y[1]) | ((unsigned long long)pk2(y[2], y[3]) << 32);
                        if (cj0 < 320) { const int hl = cj0 >> 6, p0 = cj0 & 63; const float wv = wls[l * 5 + hl];
                            const int ch = (p0 >> 3) ^ (((l >> 1) & 1) << 2);
                            *(LAS unsigned long long*)(xim + hl * 16384 + l * 128 + ch * 16 + 8 * ((p0 >> 2) & 1)) = (unsigned long long)pk2(y[0] * wv, y[1] * wv) | ((unsigned long long)pk2(y[2] * wv, y[3] * wv) << 32); }
                        else if (cj0 < 448) { const int n0 = cj0 - 320; const int ch = (n0 >> 3) ^ ((l & 3) << 2);
                            *(LAS unsigned long long*)(Bim + l * 256 + ch * 16 + 8 * ((n0 >> 2) & 1)) = (unsigned long long)pk2(y[0], y[1]) | ((unsigned long long)pk2(y[2], y[3]) << 32); } }
                    if (c == NCHUNK - 1 && seg == 15) {
#pragma unroll
                        for (int j = 0; j < 3; ++j) *(f32x4*)(F.out + O_CVP + j * CONVD + xcol) = XR(8 + j); }
#undef XR
                } }
        }
        __syncthreads();
        {
            const int nt = wave & 3, pt = wave >> 2, hi = lane >> 5, g2 = (lane >> 4) & 1, qq = (lane & 15) >> 2, pp = lane & 3;
#pragma unroll 1
            for (int hl = 0; hl < 5; ++hl) {
                f32x16 acc;
#pragma unroll
                for (int e = 0; e < 16; ++e) acc[e] = 0.f;
#pragma unroll
                for (int ks = 0; ks < 8; ++ks) {
                    const int rlo = 16 * ks + 4 * hi + qq, rhi = rlo + 8;
                    const int lcx = 4 * pt + 2 * g2 + (pp >> 1), lcb = 4 * nt + 2 * g2 + (pp >> 1);
                    const LAS unsigned char* xb = xim + hl * 16384;
                    const v4i16_t xlo = __builtin_amdgcn_ds_read_tr16_b64_v4i16((LAS v4i16_t*)(xb + rlo * 128 + ((lcx ^ (((rlo >> 1) & 1) << 2)) << 4) + 8 * (pp & 1)));
                    const v4i16_t xhi = __builtin_amdgcn_ds_read_tr16_b64_v4i16((LAS v4i16_t*)(xb + rhi * 128 + ((lcx ^ (((rhi >> 1) & 1) << 2)) << 4) + 8 * (pp & 1)));
                    const v4i16_t blo = __builtin_amdgcn_ds_read_tr16_b64_v4i16((LAS v4i16_t*)(Bim + rlo * 256 + ((lcb ^ ((rlo & 3) << 2)) << 4) + 8 * (pp & 1)));
                    const v4i16_t bhi = __builtin_amdgcn_ds_read_tr16_b64_v4i16((LAS v4i16_t*)(Bim + rhi * 256 + ((lcb ^ ((rhi & 3) << 2)) << 4) + 8 * (pp & 1)));
                    const bf16x8 af = (bf16x8){xlo[0], xlo[1], xlo[2], xlo[3], xhi[0], xhi[1], xhi[2], xhi[3]};
                    const bf16x8 bfr = (bf16x8){blo[0], blo[1], blo[2], blo[3], bhi[0], bhi[1], bhi[2], bhi[3]};
                    acc = __builtin_amdgcn_mfma_f32_32x32x16_bf16(af, bfr, acc, 0, 0, 0);
                }
                float* dst = ST + (((size_t)c * SH + g * 5 + hl) * HD + 32 * pt) * DSTATE + 32 * nt + (lane & 31);
#pragma unroll
                for (int e = 0; e < 16; ++e) dst[(size_t)((e & 3) + 8 * (e >> 2) + 4 * hi) * DSTATE] = acc[e];
            }
        }
        __syncthreads();
    }
}

__device__ __forceinline__ void ssd_sample(Frame& F) {
    const bf16* PROJ = WSP(bf16, WS_PROJ); bf16* MIX = WSP(bf16, WS_MIX);
    const float* state_conv = F.in[4]; const float* state_ssm = F.in[5];
    const float* conv_w = F.in[9]; const float* conv_b = F.in[10]; const float* dt_bias = F.in[11]; const float* a_log = F.in[12]; const float* d_skip = F.in[13]; const float* g_ssd = F.in[15];
    LAS float* xs = (LAS float*)F.lds;
    LAS float* Bs = xs + 1280;
    LAS float* Cs = Bs + 512;
    LAS float* dts = Cs + 512;
    LAS float* acs = dts + 20;
    LAS float* CBs = acs + 20;
    LAS float* ys = CBs + 16;
    LAS float* red = ys + 1280;
    const int tid = lnd(F.tid), lane = lnd(F.lane), wave = F.wave;
    for (int unit = blockIdx.x; unit < DB * NG; unit += F.G) {
        const int b = unit >> 2, g = unit & 3; const int r0 = SEQ + 4 * b;
        const int n4 = tid & 31, pr = tid >> 5;
        f32x4 Sreg[5][4];
#pragma unroll
        for (int hl = 0; hl < 5; ++hl)
#pragma unroll
            for (int j = 0; j < 4; ++j) Sreg[hl][j] = *(const f32x4*)(state_ssm + (((size_t)b * SH + g * 5 + hl) * HD + pr + 16 * j) * DSTATE + 4 * n4);
        for (int cj = tid; cj < 576; cj += NTHR) {
            const int xcol = cj < 320 ? g * 320 + cj : (cj < 448 ? 1280 + g * 128 + (cj - 320) : 1792 + g * 128 + (cj - 448));
            const float w0 = conv_w[xcol], w1 = conv_w[CONVD + xcol], w2 = conv_w[2 * CONVD + xcol], w3 = conv_w[3 * CONVD + xcol], bb = conv_b[xcol];
            float xp[7];
#pragma unroll
            for (int j = 0; j < 3; ++j) xp[j] = state_conv[((size_t)b * 3 + j) * CONVD + xcol];
#pragma unroll
            for (int t = 0; t < 4; ++t) xp[3 + t] = bf2f(PROJ[(size_t)(r0 + t) * NP + CX + xcol]);
#pragma unroll
            for (int t = 0; t < 4; ++t) { const float y = silu_f(xp[t] * w0 + xp[t + 1] * w1 + xp[t + 2] * w2 + xp[t + 3] * w3 + bb);
                if (cj < 320) xs[t * 320 + cj] = y; else if (cj < 448) Bs[t * 128 + (cj - 320)] = y; else Cs[t * 128 + (cj - 448)] = y; }
#pragma unroll
            for (int j = 0; j < 3; ++j) F.out[O_CVS + ((size_t)b * 3 + j) * CONVD + xcol] = xp[4 + j];
        }
        if (tid < 20) { const int t = tid / 5, hl = tid % 5, h = g * 5 + hl; dts[tid] = softplus_f(bf2f(PROJ[(size_t)(r0 + t) * NP + CDT + h]) + dt_bias[h]); }
        __syncthreads();
        if (tid < 5) { const float a = -__expf(a_log[g * 5 + tid]); float s = 0.f;
#pragma unroll
            for (int t = 0; t < 4; ++t) { s += dts[t * 5 + tid] * a; acs[t * 5 + tid] = s; } }
        { const int pair = tid >> 5, n4 = tid & 31, t = pair >> 2, s = pair & 3; float v = 0.f;
#pragma unroll
            for (int e = 0; e < 4; ++e) v += Cs[t * 128 + 4 * n4 + e] * Bs[s * 128 + 4 * n4 + e];
            v += __shfl_xor(v, 1); v += __shfl_xor(v, 2); v += __shfl_xor(v, 4); v += __shfl_xor(v, 8); v += __shfl_xor(v, 16);
            if (n4 == 0) CBs[pair] = v; }
        __syncthreads();
        float Bv[4][4], Cv[4][4];
#pragma unroll
        for (int t = 0; t < 4; ++t)
#pragma unroll
            for (int e = 0; e < 4; ++e) { Bv[t][e] = Bs[t * 128 + 4 * n4 + e]; Cv[t][e] = Cs[t * 128 + 4 * n4 + e]; }
#pragma unroll
        for (int hl = 0; hl < 5; ++hl) {
            const int h = g * 5 + hl;
            float ac[4], dtv[4];
#pragma unroll
            for (int t = 0; t < 4; ++t) { ac[t] = acs[t * 5 + hl]; dtv[t] = dts[t * 5 + hl]; }
            const float dsk = d_skip[h];
#pragma unroll
            for (int j = 0; j < 4; ++j) {
                const int p = pr + 16 * j;
                const size_t soff = (((size_t)b * SH + h) * HD + p) * DSTATE + 4 * n4;
                const f32x4 S = Sreg[hl][j];
                float xv[4];
#pragma unroll
                for (int t = 0; t < 4; ++t) xv[t] = xs[t * 320 + hl * 64 + p];
                f32x4 Hn = S * __expf(ac[3]);
#pragma unroll
                for (int t = 0; t < 4; ++t) { const float wgt = __expf(ac[3] - ac[t]) * dtv[t] * xv[t];
#pragma unroll
                    for (int e = 0; e < 4; ++e) Hn[e] += wgt * Bv[t][e]; }
                *(f32x4*)(F.out + O_SSS + soff) = Hn;
#pragma unroll
                for (int t = 0; t < 4; ++t) {
                    float yo = (Cv[t][0] * S[0] + Cv[t][1] * S[1]) + (Cv[t][2] * S[2] + Cv[t][3] * S[3]);
                    yo += __shfl_xor(yo, 1); yo += __shfl_xor(yo, 2); yo += __shfl_xor(yo, 4); yo += __shfl_xor(yo, 8); yo += __shfl_xor(yo, 16);
                    float y = yo * __expf(ac[t]) + dsk * xv[t];
#pragma unroll
                    for (int s = 0; s < 4; ++s) if (s <= t) y += CBs[t * 4 + s] * __expf(ac[t] - ac[s]) * dtv[s] * xv[s];
                    if (n4 == t) ys[t * 320 + hl * 64 + p] = y;
                }
            }
        }
        __syncthreads();
        float yv[4]; float part[4];
#pragma unroll
        for (int t = 0; t < 4; ++t) { yv[t] = 0.f;
            if (tid < 320) { const float z = bf2f(PROJ[(size_t)(r0 + t) * NP + CZ + g * 320 + tid]); yv[t] = ys[t * 320 + tid] * silu_f(z); }
            part[t] = wave_sum(yv[t] * yv[t]); }
        if (lane == 0) {
#pragma unroll
            for (int t = 0; t < 4; ++t) red[t * 8 + wave] = part[t]; }
        __syncthreads();
        if (tid < 320) {
#pragma unroll
            for (int t = 0; t < 4; ++t) { float ss = 0.f;
#pragma unroll
                for (int w = 0; w < 8; ++w) ss += red[t * 8 + w];
                const float rs = 1.0f / sqrtf(ss * (1.0f / 320.f) + EPS);
                MIX[(size_t)(r0 + t) * MIXW + ATTW + g * 320 + tid] = (bf16)f2bf(yv[t] * rs * g_ssd[g * 320 + tid]); } }
        __syncthreads();
    }
}

__device__ __forceinline__ void scan_and_attnorm(Frame& F) {
    const float* ST = WSP(float, WS_ST); const float* CDEC = WSP(float, WS_CDEC); bf16* HIN = WSP(bf16, WS_HIN);
    const int gt = blockIdx.x * NTHR + F.tid, NGT = F.G * NTHR;
    for (int e4 = gt; e4 < SH * HD * DSTATE / 4; e4 += NGT) {
        const int h = e4 / (HD * DSTATE / 4);
        f32x4 hcur = (f32x4){0.f, 0.f, 0.f, 0.f};
        for (int c0 = 0; c0 < NCHUNK; c0 += 8) {
            f32x4 st[8]; float dc[8];
#pragma unroll
            for (int j = 0; j < 8; ++j) { st[j] = *(const f32x4*)(ST + (size_t)(c0 + j) * (SH * HD * DSTATE) + (size_t)e4 * 4); dc[j] = CDEC[(c0 + j) * SH + h]; }
#pragma unroll
            for (int j = 0; j < 8; ++j) { *(unsigned long long*)(HIN + (size_t)(c0 + j) * (SH * HD * DSTATE) + (size_t)e4 * 4) = (unsigned long long)pk2(hcur[0], hcur[1]) | ((unsigned long long)pk2(hcur[2], hcur[3]) << 32);
                hcur = hcur * dc[j] + st[j]; }
        }
        *(f32x4*)(F.out + O_SSP + (size_t)e4 * 4) = hcur;
    }
    bf16* MIX = WSP(bf16, WS_MIX); const float* ATTSS = WSP(float, WS_ATTSS); const float* g_attn = F.in[14];
    const bf16* OPART = WSP(bf16, WS_OPART); const float* ML = WSP(float, WS_ML);
    const int gw = blockIdx.x * NWAVES + F.wave, NGW = F.G * NWAVES, lane = lnd(F.lane);
    for (int row = gw; row < SEQ; row += NGW) {
        float o[3][4]; float sq = 0.f;
#pragma unroll
        for (int j = 0; j < 3; ++j) { const int col = 4 * lane + 256 * j, h = col >> 6;
            float mb[3], lb[3];
#pragma unroll
            for (int b = 0; b < 3; ++b) { const float* mp = ML + (((size_t)b * SEQ + row) * AH + h) * 2; mb[b] = mp[0]; lb[b] = mp[1]; }
            const float M = fmaxf(fmaxf(mb[0], mb[1]), mb[2]);
            float w[3], W = 0.f;
#pragma unroll
            for (int b = 0; b < 3; ++b) { w[b] = __builtin_amdgcn_exp2f(mb[b] - M) * lb[b]; W += w[b]; }
            const float iw = 1.0f / W;
#pragma unroll
            for (int e = 0; e < 4; ++e) o[j][e] = 0.f;
#pragma unroll
            for (int b = 0; b < 3; ++b) { const unsigned long long x = *(const unsigned long long*)(OPART + ((size_t)b * SEQ + row) * ATTW + col); const float wb = w[b] * iw;
                o[j][0] += wb * bf2f((unsigned short)x); o[j][1] += wb * bf2f((unsigned short)(x >> 16)); o[j][2] += wb * bf2f((unsigned short)(x >> 32)); o[j][3] += wb * bf2f((unsigned short)(x >> 48)); }
#pragma unroll
            for (int e = 0; e < 4; ++e) sq += o[j][e] * o[j][e]; }
        sq = wave_sum(sq);
        const float rs = 1.0f / sqrtf(sq * (1.0f / ATTW) + EPS);
#pragma unroll
        for (int j = 0; j < 3; ++j) { const int col = 4 * lane + 256 * j; const f32x4 gg = *(const f32x4*)(g_attn + col);
            *(unsigned long long*)(MIX + (size_t)row * MIXW + col) = (unsigned long long)pk2(o[j][0] * rs * gg[0], o[j][1] * rs * gg[1]) | ((unsigned long long)pk2(o[j][2] * rs * gg[2], o[j][3] * rs * gg[3]) << 32); }
    }
    for (int row = SEQ + gw; row < MTOT; row += NGW) {
        float s = lane < AH ? ATTSS[row * AH + lane] : 0.f; s = wave_sum(s);
        const float rs = 1.0f / sqrtf(s * (1.0f / ATTW) + EPS);
#pragma unroll
        for (int j = 0; j < 3; ++j) { const int col = 4 * lane + 256 * j; unsigned long long* p = (unsigned long long*)(MIX + (size_t)row * MIXW + col);
            const unsigned long long w = *p; const f32x4 gg = *(const f32x4*)(g_attn + col);
            const float v0 = bf2f((unsigned short)w) * rs * gg[0], v1 = bf2f((unsigned short)(w >> 16)) * rs * gg[1], v2 = bf2f((unsigned short)(w >> 32)) * rs * gg[2], v3 = bf2f((unsigned short)(w >> 48)) * rs * gg[3];
            *p = (unsigned long long)pk2(v0, v1) | ((unsigned long long)pk2(v2, v3) << 32); }
    }
}

__device__ __forceinline__ void ssd_phase_b(Frame& F) {
    const bf16* PROJ = WSP(bf16, WS_PROJ); const bf16* XC = WSP(bf16, WS_XC); const float* DTB = WSP(float, WS_DTB); const float* ACS = WSP(float, WS_ACS); const float* ST = WSP(float, WS_ST);
    bf16* MIX = WSP(bf16, WS_MIX); const float* d_skip = F.in[13]; const float* g_ssd = F.in[15];
    LAS float* Wm = (LAS float*)F.lds;
    LAS float* Hs = (LAS float*)(F.lds + 66048);
    LAS bf16* xh = (LAS bf16*)(F.lds + 66048 + 32768);
    LAS float* acsS = (LAS float*)(F.lds + 66048 + 32768 + 16384);
    LAS float* dtS = acsS + 128;
    LAS float* ssq = dtS + 128;
    const int tid = lnd(F.tid), lane = lnd(F.lane);
    const int l = tid & 127, pq = __builtin_amdgcn_readfirstlane(tid >> 7);
    for (int unit = blockIdx.x; unit < NCHUNK * NG; unit += F.G) {
        const int c = unit >> 2, g = unit & 3, T0 = c * CL;
        float yv[5][16];
        if (tid < 128) ssq[tid] = 0.f;
#pragma unroll
        for (int hl = 0; hl < 5; ++hl) {
            const int h = g * 5 + hl;
            __syncthreads();
            if (tid < 128) { acsS[tid] = ACS[(size_t)(T0 + tid) * SH + h]; dtS[tid] = DTB[(size_t)(T0 + tid) * SH + h]; }
            for (int i = tid; i < 64 * 128 / 4; i += NTHR) ((LAS f32x4*)Hs)[i] = *(const f32x4*)(ST + ((size_t)c * SH + h) * (HD * DSTATE) + (size_t)i * 4);
            for (int i = tid; i < 128 * 64 / 8; i += NTHR) { const int r = i >> 3, ch = i & 7; ((LAS v4u*)xh)[i] = *(const v4u*)(XC + (size_t)(T0 + r) * CONVD + h * 64 + ch * 8); }
            __syncthreads();
            for (int pair = tid; pair < 128 * 128; pair += NTHR) {
                const int ll = pair >> 7, s = pair & 127; float w = 0.f;
                if (s <= ll) { const bf16* cp = XC + (size_t)(T0 + ll) * CONVD + 1792 + g * 128; const bf16* bp = XC + (size_t)(T0 + s) * CONVD + 1280 + g * 128; float d = 0.f;
#pragma unroll 4
                    for (int k8 = 0; k8 < 16; ++k8) { const v4u cw = *(const v4u*)(cp + 8 * k8), bw = *(const v4u*)(bp + 8 * k8);
#pragma unroll
                        for (int e = 0; e < 4; ++e) { d += __uint_as_float(cw[e] << 16) * __uint_as_float(bw[e] << 16) + __uint_as_float(cw[e] & 0xffff0000u) * __uint_as_float(bw[e] & 0xffff0000u); } }
                    w = d * __expf(acsS[ll] - acsS[s]) * dtS[s]; }
                Wm[ll * 129 + s] = w; }
            __syncthreads();
            float acc[16];
#pragma unroll
            for (int j = 0; j < 16; ++j) acc[j] = 0.f;
            for (int s = 0; s < CL; ++s) { const float w = Wm[l * 129 + s]; const LAS bf16* xr = xh + s * 64 + pq * 16;
#pragma unroll
                for (int j = 0; j < 16; ++j) acc[j] += w * bf2f(xr[j]); }
            { const bf16* cp = XC + (size_t)(T0 + l) * CONVD + 1792 + g * 128; const float ea = __expf(acsS[l]);
                float off[16];
#pragma unroll
                for (int j = 0; j < 16; ++j) off[j] = 0.f;
                for (int k8 = 0; k8 < 16; ++k8) { const v4u cw = *(const v4u*)(cp + 8 * k8); float cf[8];
#pragma unroll
                    for (int e = 0; e < 4; ++e) { cf[2 * e] = __uint_as_float(cw[e] << 16); cf[2 * e + 1] = __uint_as_float(cw[e] & 0xffff0000u); }
#pragma unroll
                    for (int j = 0; j < 16; ++j) { const LAS float* hr = Hs + (pq * 16 + j) * 128 + 8 * k8;
#pragma unroll
                        for (int e = 0; e < 8; ++e) off[j] += cf[e] * hr[e]; } }
#pragma unroll
                for (int j = 0; j < 16; ++j) acc[j] += ea * off[j]; }
            { const float dsk = d_skip[h]; const LAS bf16* xr = xh + l * 64 + pq * 16; const bf16* zp = PROJ + (size_t)(T0 + l) * NP + CZ + h * 64 + pq * 16; float sq = 0.f;
#pragma unroll
                for (int j = 0; j < 16; ++j) { const float y = (acc[j] + dsk * bf2f(xr[j])) * silu_f(bf2f(zp[j])); yv[hl][j] = y; sq += y * y; }
                __hip_atomic_fetch_add(&ssq[l], sq, __ATOMIC_RELAXED, __HIP_MEMORY_SCOPE_WORKGROUP); }
        }
        __syncthreads();
        const float rs = 1.0f / sqrtf(ssq[l] * (1.0f / 320.f) + EPS);
#pragma unroll
        for (int hl = 0; hl < 5; ++hl) { const int col = (g * 5 + hl) * 64 + pq * 16; bf16* mp = MIX + (size_t)(T0 + l) * MIXW + ATTW + col;
            v4u w0, w1;
            w0.x = pk2(yv[hl][0] * rs * g_ssd[col + 0], yv[hl][1] * rs * g_ssd[col + 1]); w0.y = pk2(yv[hl][2] * rs * g_ssd[col + 2], yv[hl][3] * rs * g_ssd[col + 3]);
            w0.z = pk2(yv[hl][4] * rs * g_ssd[col + 4], yv[hl][5] * rs * g_ssd[col + 5]); w0.w = pk2(yv[hl][6] * rs * g_ssd[col + 6], yv[hl][7] * rs * g_ssd[col + 7]);
            w1.x = pk2(yv[hl][8] * rs * g_ssd[col + 8], yv[hl][9] * rs * g_ssd[col + 9]); w1.y = pk2(yv[hl][10] * rs * g_ssd[col + 10], yv[hl][11] * rs * g_ssd[col + 11]);
            w1.z = pk2(yv[hl][12] * rs * g_ssd[col + 12], yv[hl][13] * rs * g_ssd[col + 13]); w1.w = pk2(yv[hl][14] * rs * g_ssd[col + 14], yv[hl][15] * rs * g_ssd[col + 15]);
            *(v4u*)mp = w0; *(v4u*)(mp + 8) = w1; }
        __syncthreads();
    }
}


__device__ __forceinline__ void ssd_phase_b_mfma(Frame& F) {
    const bf16* PROJ = WSP(bf16, WS_PROJ); const bf16* XC = WSP(bf16, WS_XC); const float* DTB = WSP(float, WS_DTB); const float* ACS = WSP(float, WS_ACS); const bf16* HIN = WSP(bf16, WS_HIN);
    bf16* MIX = WSP(bf16, WS_MIX); const float* d_skip = F.in[13]; const float* g_ssd = F.in[15];
    constexpr int YP = 656;
    LAS unsigned char* Cim = F.lds;
    LAS unsigned char* Bim = F.lds + 32768;
    LAS unsigned char* yst = F.lds + 32768;
    LAS unsigned char* xim = F.lds + 116736;
    LAS unsigned char* Him = F.lds + 133120;
    LAS float* acsS = (LAS float*)(F.lds + 149504);
    LAS float* dtS = acsS + 128;
    LAS float* ssqp = dtS + 128;
    const int tid = lnd(F.tid), lane = lnd(F.lane), wave = F.wave;
    const int lt = wave >> 1, pt = wave & 1;
    constexpr float LOG2E = 1.4426950408889634f;
    for (int unit = blockIdx.x; unit < NCHUNK * NG; unit += F.G) {
        const int c = unit >> 2, g = unit & 3, T0 = c * CL;
        int lane_u = lane; asm volatile("" : "+v"(lane_u));
        const int lq = lane_u & 31, hi = lane_u >> 5;
        for (int n = wave; n < 32; n += 8) { const int row = 4 * n + (lane >> 4), pc = lane & 15, lc = pc ^ (row & 15);
            __builtin_amdgcn_global_load_lds((const unsigned*)(XC + (size_t)(T0 + row) * CONVD + 1792 + g * 128 + lc * 8), (LAS unsigned*)(Cim + n * 1024), 16, 0, 0);
            __builtin_amdgcn_global_load_lds((const unsigned*)(XC + (size_t)(T0 + row) * CONVD + 1280 + g * 128 + lc * 8), (LAS unsigned*)(Bim + n * 1024), 16, 0, 0); }
        asm volatile("s_waitcnt vmcnt(0)" ::: "memory");
        __syncthreads();
        const LAS unsigned char* crow_ = Cim + (32 * lt + lq) * 256; const int cx = (32 * lt + lq) & 15;
#define CF(ks) (*(const LAS bf16x8*)(crow_ + (((2 * (ks) + hi) ^ cx) << 4)))
        unsigned GTp[4][8];
#pragma unroll
        for (int st = 0; st < 4; ++st) {
            f32x16 gt;
#pragma unroll
            for (int e = 0; e < 16; ++e) gt[e] = 0.f;
            { const int row = 32 * st + lq;
#pragma unroll
                for (int ks = 0; ks < 8; ++ks) { const bf16x8 bfr = *(const LAS bf16x8*)(Bim + row * 256 + (((2 * ks + hi) ^ (row & 15)) << 4));
                    gt = __builtin_amdgcn_mfma_f32_32x32x16_bf16(bfr, CF(ks), gt, 0, 0, 0); } }
#pragma unroll
            for (int e = 0; e < 8; ++e) GTp[st][e] = pk2(gt[2 * e], gt[2 * e + 1]);
            __builtin_amdgcn_sched_barrier(0);
        }
        float sq = 0.f;
#pragma unroll 1
        for (int hl = 0; hl < 5; ++hl) {
            const int h = g * 5 + hl;
            int lane_h = lane; asm volatile("" : "+v"(lane_h));
            const int lq = lane_h & 31, hi = lane_h >> 5, g2 = (lane_h >> 4) & 1, qq = (lane_h & 15) >> 2, pp = lane_h & 3;
            __syncthreads();
            for (int n = wave; n < 16; n += 8) { const int row = 8 * n + (lane >> 3), pc = lane & 7, lc = pc ^ (((row >> 1) & 1) << 2);
                __builtin_amdgcn_global_load_lds((const unsigned*)(XC + (size_t)(T0 + row) * CONVD + h * 64 + lc * 8), (LAS unsigned*)(xim + n * 1024), 16, 0, 0); }
            for (int n = wave; n < 16; n += 8) { const int row = 4 * n + (lane >> 4), pc = lane & 15, lc = pc ^ (row & 15);
                __builtin_amdgcn_global_load_lds((const unsigned*)(HIN + (((size_t)c * SH + h) * HD + row) * DSTATE + lc * 8), (LAS unsigned*)(Him + n * 1024), 16, 0, 0); }
            if (tid < 128) { acsS[tid] = ACS[(size_t)(T0 + tid) * SH + h] * LOG2E; dtS[tid] = DTB[(size_t)(T0 + tid) * SH + h]; }
            const int lrow = T0 + 32 * lt + lq;
            const float al = ACS[(size_t)lrow * SH + h] * LOG2E;
            asm volatile("s_waitcnt vmcnt(0)" ::: "memory");
            __syncthreads();
            const LAS unsigned char* crow_h = Cim + (32 * lt + lq) * 256; const int cxh = lq & 15;
#define CFH(ks) (*(const LAS bf16x8*)(crow_h + (((2 * (ks) + hi) ^ cxh) << 4)))
            const LAS unsigned char* xtr = xim + (4 * hi + qq) * 128 + (((4 * pt + 2 * g2 + (pp >> 1)) ^ (((qq >> 1) & 1) << 2)) << 4) + 8 * (pp & 1);
            f32x16 yo, yd;
#pragma unroll
            for (int e = 0; e < 16; ++e) { yo[e] = 0.f; yd[e] = 0.f; }
            { const int row = 32 * pt + lq;
#pragma unroll
                for (int ks = 0; ks < 8; ++ks) { const bf16x8 hf = *(const LAS bf16x8*)(Him + row * 256 + (((2 * ks + hi) ^ (row & 15)) << 4));
                    yo = __builtin_amdgcn_mfma_f32_32x32x16_bf16(hf, CFH(ks), yo, 0, 0, 0); } }
#pragma unroll
            for (int st = 0; st < 4; ++st) {
#pragma unroll
                for (int s2 = 0; s2 < 2; ++s2) {
                    float w[8];
#pragma unroll
                    for (int j = 0; j < 8; ++j) { const int e = 8 * s2 + j, s = 32 * st + (e & 3) + 8 * (e >> 2) + 4 * hi;
                        const float gv = (e & 1) ? __uint_as_float(GTp[st][e >> 1] & 0xffff0000u) : __uint_as_float(GTp[st][e >> 1] << 16);
                        const float v = gv * __builtin_amdgcn_exp2f(al - acsS[s]) * dtS[s];
                        w[j] = (s <= 32 * lt + lq) ? v : 0.f; }
                    v4u wp; wp.x = pk2(w[0], w[1]); wp.y = pk2(w[2], w[3]); wp.z = pk2(w[4], w[5]); wp.w = pk2(w[6], w[7]);
                    const v4i16_t xlo = __builtin_amdgcn_ds_read_tr16_b64_v4i16((LAS v4i16_t*)(xtr + (32 * st + 16 * s2) * 128));
                    const v4i16_t xhi = __builtin_amdgcn_ds_read_tr16_b64_v4i16((LAS v4i16_t*)(xtr + (32 * st + 16 * s2 + 8) * 128));
                    const bf16x8 xf = (bf16x8){xlo[0], xlo[1], xlo[2], xlo[3], xhi[0], xhi[1], xhi[2], xhi[3]};
                    yd = __builtin_amdgcn_mfma_f32_32x32x16_bf16(xf, __builtin_bit_cast(bf16x8, wp), yd, 0, 0, 0);
                    __builtin_amdgcn_sched_barrier(0);
                }
            }
            const float ea = __builtin_amdgcn_exp2f(al), dsk = d_skip[h];
#pragma unroll
            for (int gq = 0; gq < 4; ++gq) { const int p = 32 * pt + 8 * gq + 4 * hi;
                const unsigned long long xu = *(const unsigned long long*)(XC + (size_t)lrow * CONVD + h * 64 + p), zu = *(const unsigned long long*)(PROJ + (size_t)lrow * NP + CZ + h * 64 + p);
                float y[4];
#pragma unroll
                for (int e = 0; e < 4; ++e) { const float xv = bf2f((unsigned short)(xu >> (16 * e))), zv = bf2f((unsigned short)(zu >> (16 * e)));
                    y[e] = (yd[4 * gq + e] + ea * yo[4 * gq + e] + dsk * xv) * silu_f(zv); sq += y[e] * y[e]; }
                *(LAS unsigned long long*)(yst + (32 * lt + lq) * YP + (hl * 64 + p) * 2) = (unsigned long long)pk2(y[0], y[1]) | ((unsigned long long)pk2(y[2], y[3]) << 32); }
        }
        sq += __shfl_xor(sq, 32);
        if (lane < 32) ssqp[pt * 128 + 32 * lt + lane] = sq;
        __syncthreads();
        for (int task = tid; task < 128 * 40; task += NTHR) { const int row = task / 40, ch = task % 40, col = g * 320 + 8 * ch;
            const float rs = 1.0f / sqrtf((ssqp[row] + ssqp[128 + row]) * (1.0f / 320.f) + EPS);
            const v4u yv = *(const LAS v4u*)(yst + row * YP + ch * 16); const f32x4 g0 = *(const f32x4*)(g_ssd + col), g1 = *(const f32x4*)(g_ssd + col + 4);
            v4u o;
            o.x = pk2(__uint_as_float(yv.x << 16) * rs * g0[0], __uint_as_float(yv.x & 0xffff0000u) * rs * g0[1]); o.y = pk2(__uint_as_float(yv.y << 16) * rs * g0[2], __uint_as_float(yv.y & 0xffff0000u) * rs * g0[3]);
            o.z = pk2(__uint_as_float(yv.z << 16) * rs * g1[0], __uint_as_float(yv.z & 0xffff0000u) * rs * g1[1]); o.w = pk2(__uint_as_float(yv.w << 16) * rs * g1[2], __uint_as_float(yv.w & 0xffff0000u) * rs * g1[3]);
            *(v4u*)(MIX + (size_t)(T0 + row) * MIXW + ATTW + col) = o; }
        __syncthreads();
    }
#undef CF
#undef CFH
}

__device__ __forceinline__ void final_norm(Frame& F) {
    const float* SS3 = (const float*)(F.ws + CTL_SS3); const float* gf = F.in[21];
    const int gw = blockIdx.x * NWAVES + F.wave, NGW = F.G * NWAVES, lane = lnd(F.lane);
    for (int row = gw; row < MTOT; row += NGW) {
        const float rs = 1.0f / sqrtf(SS3[row] * (1.0f / DM) + EPS);
        f32x4* yr = (f32x4*)(F.out + (size_t)row * DM) + lane;
#pragma unroll
        for (int j = 0; j < 4; ++j) { const f32x4 gg = *((const f32x4*)gf + lane + 64 * j); yr[64 * j] = yr[64 * j] * rs * gg; }
    }
}

#ifndef MK_N_LAUNCHES
#define MK_N_LAUNCHES 1
#endif
constexpr int N_PHASES = 9;
struct Args { const float* in[22]; float* out; unsigned char* ws; int ph_lo, ph_hi; };
__global__ void __launch_bounds__(NTHR, 2) fwd(Args args) {
    extern __shared__ __attribute__((aligned(16))) unsigned char lds[];
    Frame F;
    F.lds = (LAS unsigned char*)lds;
    F.tid = threadIdx.x; F.lane = F.tid & 63; F.wave = __builtin_amdgcn_readfirstlane(F.tid >> 6); F.G = gridDim.x;
#pragma unroll
    for (int i = 0; i < 22; ++i) F.in[i] = args.in[i];
    F.out = args.out; F.ws = args.ws;
    volatile LAS unsigned* MISC = (volatile LAS unsigned*)(F.lds + MISC_OFF);
    if (F.tid < 64) MISC[F.tid] = 0u;
    __syncthreads();
    unsigned* barw = (unsigned*)(F.ws + WS_CTL) + CW_BAR;
    XcdBarrier bar; bar.bar = barw; bar.x = 0; bar.st = nullptr;
    if (MK_N_LAUNCHES == 1) bar = xcd_barrier_post(barw, MISC + 8);
    const int lo = args.ph_lo, hi = args.ph_hi;
#define IN(k) (lo <= (k) && (k) < hi)
#define SEAM(k) do { if (IN(k) && IN((k) + 1)) xcd_barrier(bar); } while (0)

    if (IN(0)) { p0_prologue(F); __syncthreads(); }
    SEAM(0);
    if (IN(1)) {
        pg8::Gemm g{WSP(const pg8::bf16_t, WS_XB), WSP(const pg8::bf16_t, WS_WIN), MTOT, NP, DM}; pg8::StaticOrder S; S.init(MTOT, NP, F.G, (int)blockIdx.x);
        EpiProj E{WSP(bf16, WS_PROJ), WSP(const float, WS_RS1), F.out};
        pg8::gemm_phase<EpiProj, pg8::StaticOrder, true, true>(F.lds, g, S, E);
    }
    SEAM(1);
#ifndef REP2
#define REP2 1
#endif
#ifndef REP0
#define REP0 1
#endif
#ifndef REP3
#define REP3 1
#endif
#ifndef REP4
#define REP4 1
#endif
#ifndef REP2A
#define REP2A 1
#endif
#ifndef REP2B
#define REP2B 1
#endif
#ifndef REP2C
#define REP2C 1
#endif
#ifndef REP2D
#define REP2D 1
#endif
    if (IN(2)) { for (int rep = 0; rep < REP2A; ++rep) { attn_sample(F); __syncthreads(); } for (int rep = 0; rep < REP2B; ++rep) { ssd_sample(F); __syncthreads(); }
                 for (int rep = 0; rep < REP2C; ++rep) { ssd_phase_a_mfma(F); __syncthreads(); } for (int rep = 0; rep < REP2D; ++rep) { attn_prompt_mfma(F); __syncthreads(); } }
    SEAM(2);
    if (IN(3)) { scan_and_attnorm(F); }
    SEAM(3);
    if (IN(4)) { ssd_phase_b_mfma(F); }
    SEAM(4);
    if (IN(5)) {
        pg8::Gemm g{WSP(const pg8::bf16_t, WS_MIX), WSP(const pg8::bf16_t, WS_WOUT), MTOT, DM, MIXW}; pg8::StaticOrder S; S.init(MTOT, DM, F.G, (int)blockIdx.x);
        EpiOut E{F.in[0], F.in[1], WSP(float, WS_X1), WSP(bf16, WS_X1B), (float*)(F.ws + CTL_SS2)};
        pg8::gemm_phase<EpiOut, pg8::StaticOrder, true, true>(F.lds, g, S, E);
    }
    SEAM(5);
    if (IN(6)) {
        pg8::Gemm g{WSP(const pg8::bf16_t, WS_X1B), WSP(const pg8::bf16_t, WS_WGU), MTOT, 2 * DFF, DM}; pg8::StaticOrder S; S.init(MTOT, 2 * DFF, F.G, (int)blockIdx.x);
        EpiGU E{WSP(bf16, WS_ACT), (const float*)(F.ws + CTL_SS2)};
        pg8::gemm_phase<EpiGU, pg8::StaticOrder, true, true>(F.lds, g, S, E);
    }
    SEAM(6);
    if (IN(7)) {
        pg8::Gemm g{WSP(const pg8::bf16_t, WS_ACT), WSP(const pg8::bf16_t, WS_WDN), MTOT, DM, DFF}; pg8::StaticOrder S; S.init(MTOT, DM, F.G, (int)blockIdx.x);
        EpiDown E{WSP(const float, WS_X1), F.out, (float*)(F.ws + CTL_SS3)};
        pg8::gemm_phase<EpiDown, pg8::StaticOrder, true, true>(F.lds, g, S, E);
    }
    SEAM(7);
    if (IN(8)) { final_norm(F); }
#undef IN
#undef SEAM
}

extern "C" void kernel_launch(void* const* d_in, const int* in_sizes, int n_in, void* d_out, int out_size, void* d_ws, size_t ws_size, hipStream_t stream) {
    static int grid = 0;
    if (grid == 0) {
        if (n_in != 22 || (size_t)out_size != O_END || ws_size < WS_END) fprintf(stderr, "kernel_launch: unexpected shapes (n_in %d, out %d, ws %zu)\n", n_in, out_size, ws_size);
        int dev = 0, cus = 0, per_cu = 0;
        if (hipGetDevice(&dev) != hipSuccess || hipDeviceGetAttribute(&cus, hipDeviceAttributeMultiprocessorCount, dev) != hipSuccess) { grid = -1; return; }
        if (hipFuncSetAttribute((const void*)fwd, hipFuncAttributeMaxDynamicSharedMemorySize, LDS_BYTES) != hipSuccess) { fprintf(stderr, "kernel_launch: hipFuncSetAttribute failed\n"); grid = -1; return; }
        if (hipOccupancyMaxActiveBlocksPerMultiprocessor(&per_cu, (const void*)fwd, NTHR, LDS_BYTES) != hipSuccess || per_cu < 1) fprintf(stderr, "kernel_launch: occupancy query says %d\n", per_cu);
        (void)hipGetLastError();
        grid = cus;
    }
    if (grid < 0) return;
    if (hipMemsetAsync((char*)d_ws + WS_CTL, 0, CTL_ZERO_BYTES, stream) != hipSuccess) return;
    Args a{};
    for (int i = 0; i < 22; ++i) a.in[i] = (const float*)d_in[i];
    a.out = (float*)d_out; a.ws = (unsigned char*)d_ws;
    if (MK_N_LAUNCHES == 1) { a.ph_lo = 0; a.ph_hi = N_PHASES; hipLaunchKernelGGL(fwd, dim3(grid), dim3(NTHR), LDS_BYTES, stream, a); }
    else { for (int p = 0; p < N_PHASES; ++p) { a.ph_lo = p; a.ph_hi = p + 1; hipLaunchKernelGGL(fwd, dim3(grid), dim3(NTHR), LDS_BYTES, stream, a); } }
}
```
